# Optimizing an MI355X kernel written in HIP

```python
import math
import jax, jax.numpy as jnp
from jax import lax
import numpy as np

D_MODEL = 1024
BATCH = 16
SEQ = 2048
DEPTH = 2

ATT_HEADS = 8
HEAD_DIM = 64
ATT_WIDTH = ATT_HEADS * HEAD_DIM
MOBA_BLOCK = 256
MOBA_TOPK = 3
MOBA_QCHUNK = 32
REL_BUCKETS = 32
REL_MAX_DIST = 128
SSM_WIDTH = D_MODEL // 2
SSM_GROUP = 16
SSM_GROUPS = SSM_WIDTH // SSM_GROUP
SSM_STATE = 64
DT_MIN = 1e-3
DT_MAX = 1e-1
N_BRANCH = 2
IN_WIDTH = 3 * ATT_WIDTH + SSM_WIDTH + N_BRANCH * D_MODEL
N_EXPERTS = 32
TOP_K = 4
D_FF = D_MODEL
SWIGLU_ALPHA = 1.702
SWIGLU_LIMIT = 7.0
MOE_BLOCK = 256
RMS_EPS = 1e-6
N_MOD = 6

kernel_name = "hybrid_s5_moba_moe_adaln_block"


def rms_norm(x, g):
    xf = x.astype(jnp.float32)
    y = xf * lax.rsqrt(jnp.mean(xf * xf, axis=-1, keepdims=True) + RMS_EPS)
    return (y * g.astype(jnp.float32)).astype(x.dtype)


def rel_bucket(dist):
    n = jnp.maximum(dist, 0)
    max_exact = REL_BUCKETS // 2
    nf = jnp.maximum(n, 1).astype(jnp.float32)
    large = max_exact + (jnp.log(nf / max_exact) / math.log(REL_MAX_DIST / max_exact)
                         * (REL_BUCKETS - max_exact)).astype(jnp.int32)
    large = jnp.minimum(large, REL_BUCKETS - 1)
    return jnp.where(n < max_exact, n, large)


def s5_ssm(u, a_re, a_im, log_dt, b_re, b_im, c_re, c_im, d_skip):
    bsz, s, _ = u.shape
    f32 = jnp.float32
    uf = u.astype(f32).reshape(bsz, s, SSM_GROUPS, SSM_GROUP)
    lam_re = jnp.minimum(a_re.astype(f32), -1e-4)
    lam_im = a_im.astype(f32)
    dt = jnp.exp(log_dt.astype(f32))[:, None]
    mag = jnp.exp(lam_re * dt)
    lb_re = mag * jnp.cos(lam_im * dt)
    lb_im = mag * jnp.sin(lam_im * dt)
    n_re = lb_re - 1.0
    n_im = lb_im
    den = lam_re * lam_re + lam_im * lam_im
    z_re = ((n_re * lam_re + n_im * lam_im) / den)[..., None]
    z_im = ((n_im * lam_re - n_re * lam_im) / den)[..., None]
    br = b_re.astype(f32)
    bi = b_im.astype(f32)
    bb_re = z_re * br - z_im * bi
    bb_im = z_re * bi + z_im * br
    bu_re = jnp.einsum('bsgc,gpc->bsgp', uf, bb_re)
    bu_im = jnp.einsum('bsgc,gpc->bsgp', uf, bb_im)
    a_re_s = jnp.broadcast_to(lb_re, (1, s, SSM_GROUPS, SSM_STATE))
    a_im_s = jnp.broadcast_to(lb_im, (1, s, SSM_GROUPS, SSM_STATE))

    def combine(e1, e2):
        ar1, ai1, br1, bi1 = e1
        ar2, ai2, br2, bi2 = e2
        return (ar2 * ar1 - ai2 * ai1,
                ar2 * ai1 + ai2 * ar1,
                ar2 * br1 - ai2 * bi1 + br2,
                ar2 * bi1 + ai2 * br1 + bi2)

    _, _, x_re, x_im = lax.associative_scan(combine, (a_re_s, a_im_s, bu_re, bu_im), axis=1)
    y = (jnp.einsum('bsgp,gcp->bsgc', x_re, c_re.astype(f32))
         - jnp.einsum('bsgp,gcp->bsgc', x_im, c_im.astype(f32)))
    y = y.reshape(bsz, s, SSM_WIDTH) + d_skip.astype(f32) * uf.reshape(bsz, s, SSM_WIDTH)
    return y.astype(u.dtype)


def moba_attention(q, k, v, rel_bias):
    bsz, s, h, hd = q.shape
    f32 = jnp.float32
    nb = -(-s // MOBA_BLOCK)
    sp = nb * MOBA_BLOCK
    pad = ((0, 0), (0, sp - s), (0, 0), (0, 0))
    qh = jnp.pad(q, pad).transpose(0, 2, 1, 3) * (hd ** -0.5)
    kb = jnp.pad(k, pad).transpose(0, 2, 1, 3).reshape(bsz, h, nb, MOBA_BLOCK, hd)
    vb = jnp.pad(v, pad).transpose(0, 2, 1, 3).reshape(bsz, h, nb, MOBA_BLOCK, hd)
    k_mean = jnp.mean(kb.astype(f32), axis=3)
    gate = jnp.einsum('bhsd,bhnd->bhsn', qh.astype(f32), k_mean)
    q_blk = jnp.arange(sp) // MOBA_BLOCK
    gate = jnp.where(jnp.arange(nb)[None, :] < q_blk[:, None], gate, -jnp.inf)
    n_sel = min(MOBA_TOPK, nb)
    _, sel = lax.top_k(gate, n_sel)
    n_chunks = sp // MOBA_QCHUNK
    q_c = qh.reshape(bsz, h, n_chunks, MOBA_QCHUNK, hd).transpose(2, 0, 1, 3, 4)
    sel_c = sel.reshape(bsz, h, n_chunks, MOBA_QCHUNK, n_sel).transpose(2, 0, 1, 3, 4)
    b_ix = jnp.arange(bsz)[:, None, None, None]
    h_ix = jnp.arange(h)[None, :, None, None]
    h_ix5 = jnp.arange(h)[None, :, None, None, None]
    offs = jnp.arange(MOBA_BLOCK)

    def chunk(args):
        ci, qc, sc = args
        q_pos = ci * MOBA_QCHUNK + jnp.arange(MOBA_QCHUNK)
        own = (ci * MOBA_QCHUNK) // MOBA_BLOCK
        k_sel = kb[b_ix, h_ix, sc]
        v_sel = vb[b_ix, h_ix, sc]
        s_sel = jnp.einsum('bhqd,bhqnjd->bhqnj', qc, k_sel).astype(f32)
        kpos = sc[..., None] * MOBA_BLOCK + offs
        bias_sel = rel_bias[rel_bucket(q_pos[:, None, None] - kpos), h_ix5]
        s_sel = jnp.where((sc < own)[..., None], s_sel + bias_sel, -jnp.inf)
        k_own = lax.dynamic_index_in_dim(kb, own, axis=2, keepdims=False)
        v_own = lax.dynamic_index_in_dim(vb, own, axis=2, keepdims=False)
        kpos_own = own * MOBA_BLOCK + offs
        bias_own = rel_bias[rel_bucket(q_pos[:, None] - kpos_own[None, :])].transpose(2, 0, 1)
        s_own = jnp.einsum('bhqd,bhjd->bhqj', qc, k_own).astype(f32) + bias_own
        s_own = jnp.where(kpos_own[None, :] <= q_pos[:, None], s_own, -jnp.inf)
        logits = jnp.concatenate(
            [s_sel.reshape(bsz, h, MOBA_QCHUNK, n_sel * MOBA_BLOCK), s_own], axis=-1)
        p = jax.nn.softmax(logits, axis=-1)
        p_sel = p[..., :n_sel * MOBA_BLOCK].reshape(bsz, h, MOBA_QCHUNK, n_sel, MOBA_BLOCK)
        p_own = p[..., n_sel * MOBA_BLOCK:]
        out = (jnp.einsum('bhqnj,bhqnjd->bhqd', p_sel.astype(v_sel.dtype), v_sel)
               + jnp.einsum('bhqj,bhjd->bhqd', p_own.astype(v_own.dtype), v_own))
        return out

    out = lax.map(chunk, (jnp.arange(n_chunks), q_c, sel_c))
    out = out.transpose(1, 0, 3, 2, 4).reshape(bsz, sp, h, hd)
    return out[:, :s]


def hybrid_mixer(h, rel_bias, w_in, a_re, a_im, log_dt, b_re, b_im, c_re, c_im, d_skip,
                 w_glu, w_ssm_out, w_att_out, w_out):
    bsz, s, d = h.shape
    proj = h @ w_in
    q, k, v, u, g_att, g_ssm = jnp.split(
        proj, [ATT_WIDTH, 2 * ATT_WIDTH, 3 * ATT_WIDTH, 3 * ATT_WIDTH + SSM_WIDTH,
               3 * ATT_WIDTH + SSM_WIDTH + D_MODEL], axis=-1)
    heads = (bsz, s, ATT_HEADS, HEAD_DIM)
    att = moba_attention(q.reshape(heads), k.reshape(heads), v.reshape(heads), rel_bias)
    att = att.reshape(bsz, s, ATT_WIDTH) @ w_att_out
    y = jax.nn.gelu(s5_ssm(u, a_re, a_im, log_dt, b_re, b_im, c_re, c_im, d_skip))
    glu_v, glu_g = jnp.split(y @ w_glu, 2, axis=-1)
    ssm = (glu_v * jax.nn.sigmoid(glu_g)) @ w_ssm_out
    merged = jax.nn.sigmoid(g_att) * att + jax.nn.sigmoid(g_ssm) * ssm
    return merged @ w_out


def moe_ffn(h, w_router, b_router, w1, b1, w2, b2):
    bsz, s, d = h.shape
    t = bsz * s
    xt = h.reshape(t, d)
    logits = (xt @ w_router + b_router).astype(jnp.float32)
    top_val, top_idx = lax.top_k(logits, TOP_K)
    gates = jax.nn.softmax(top_val, axis=-1)
    tk = t * TOP_K
    e_flat = top_idx.reshape(tk)
    tok_flat = jnp.arange(tk, dtype=jnp.int32) // TOP_K
    w_flat = gates.reshape(tk)
    order = jnp.argsort(e_flat)
    e_sorted = e_flat[order]
    tok_sorted = tok_flat[order]
    w_sorted = w_flat[order]
    counts = jnp.bincount(e_flat, length=N_EXPERTS)
    starts = jnp.cumsum(counts) - counts
    padded = (counts + MOE_BLOCK - 1) // MOE_BLOCK * MOE_BLOCK
    pad_ends = jnp.cumsum(padded)
    pad_starts = pad_ends - padded
    dest = pad_starts[e_sorted] + (jnp.arange(tk) - starts[e_sorted])
    n_blocks = tk // MOE_BLOCK + N_EXPERTS
    p_rows = n_blocks * MOE_BLOCK
    buf_tok = jnp.zeros((p_rows,), jnp.int32).at[dest].set(tok_sorted)
    buf_w = jnp.zeros((p_rows,), jnp.float32).at[dest].set(w_sorted)
    block_e = jnp.minimum(
        jnp.searchsorted(pad_ends, jnp.arange(n_blocks) * MOE_BLOCK, side='right'), N_EXPERTS - 1)
    xb = xt[buf_tok].reshape(n_blocks, MOE_BLOCK, d)

    def expert_block(args):
        xblk, e = args
        gu = xblk @ w1[e] + b1[e]
        g, up = gu[:, :D_FF], gu[:, D_FF:]
        g = jnp.minimum(g, SWIGLU_LIMIT)
        up = jnp.clip(up, -SWIGLU_LIMIT, SWIGLU_LIMIT)
        act = (up + 1.0) * g * jax.nn.sigmoid(SWIGLU_ALPHA * g)
        return act @ w2[e] + b2[e]

    yb = lax.map(expert_block, (xb, block_e)).reshape(p_rows, d)
    out = jnp.zeros((t, d), yb.dtype).at[buf_tok].add(yb * buf_w[:, None].astype(yb.dtype))
    return out.reshape(bsz, s, d)


def setup_inputs(seed: int = 0) -> dict:
    key = jax.random.key(seed)
    ks = iter(jax.random.split(key, 32))
    f32 = jnp.float32
    L, D, G, P, C = DEPTH, D_MODEL, SSM_GROUPS, SSM_STATE, SSM_GROUP

    def nrm(shape, scale):
        return jax.random.normal(next(ks), shape, f32) * scale

    return {
        "x": nrm((BATCH, SEQ, D), 1.0),
        "c": nrm((BATCH, D), 1.0),
        "rel_bias": nrm((REL_BUCKETS, ATT_HEADS), 0.5),
        "w_ada": nrm((L, D, N_MOD * D), 0.5 * D ** -0.5),
        "b_ada": nrm((L, N_MOD * D), 0.02),
        "g_pre_mix": 1.0 + nrm((L, D), 0.05),
        "g_post_mix": 1.0 + nrm((L, D), 0.05),
        "g_pre_ffn": 1.0 + nrm((L, D), 0.05),
        "g_post_ffn": 1.0 + nrm((L, D), 0.05),
        "w_in": nrm((L, D, IN_WIDTH), D ** -0.5),
        "ssm_a_re": -0.5 + nrm((L, G, P), 0.01),
        "ssm_a_im": math.pi * jnp.arange(P, dtype=f32)[None, None, :] + nrm((L, G, P), 0.01),
        "ssm_log_dt": jax.random.uniform(next(ks), (L, G), f32,
                                         minval=math.log(DT_MIN), maxval=math.log(DT_MAX)),
        "ssm_b_re": nrm((L, G, P, C), (2 * C) ** -0.5),
        "ssm_b_im": nrm((L, G, P, C), (2 * C) ** -0.5),
        "ssm_c_re": nrm((L, G, C, P), (2 * P) ** -0.5 * 4.0),
        "ssm_c_im": nrm((L, G, C, P), (2 * P) ** -0.5 * 4.0),
        "ssm_d": nrm((L, SSM_WIDTH), 1.0),
        "w_glu": nrm((L, SSM_WIDTH, 2 * SSM_WIDTH), SSM_WIDTH ** -0.5),
        "w_ssm_out": nrm((L, SSM_WIDTH, D), SSM_WIDTH ** -0.5),
        "w_att_out": nrm((L, ATT_WIDTH, D), ATT_WIDTH ** -0.5),
        "w_out": nrm((L, D, D), D ** -0.5),
        "w_router": nrm((L, D, N_EXPERTS), D ** -0.5),
        "b_router": nrm((L, N_EXPERTS), 0.01),
        "w_exp_in": nrm((L, N_EXPERTS, D, 2 * D_FF), D ** -0.5),
        "b_exp_in": nrm((L, N_EXPERTS, 2 * D_FF), 0.01),
        "w_exp_out": nrm((L, N_EXPERTS, D_FF, D), D_FF ** -0.5),
        "b_exp_out": nrm((L, N_EXPERTS, D), 0.01),
    }


def reference(x, c, rel_bias, w_ada, b_ada, g_pre_mix, g_post_mix, g_pre_ffn, g_post_ffn,
              w_in, ssm_a_re, ssm_a_im, ssm_log_dt, ssm_b_re, ssm_b_im, ssm_c_re, ssm_c_im,
              ssm_d, w_glu, w_ssm_out, w_att_out, w_out, w_router, b_router,
              w_exp_in, b_exp_in, w_exp_out, b_exp_out):
    cond = jax.nn.silu(c)
    for l in range(DEPTH):
        mod = cond @ w_ada[l] + b_ada[l]
        sh1, sc1, gt1, sh2, sc2, gt2 = [m[:, None, :] for m in jnp.split(mod, N_MOD, axis=-1)]
        h = rms_norm(x, g_pre_mix[l]) * (1.0 + sc1) + sh1
        y = hybrid_mixer(h, rel_bias, w_in[l], ssm_a_re[l], ssm_a_im[l], ssm_log_dt[l],
                         ssm_b_re[l], ssm_b_im[l], ssm_c_re[l], ssm_c_im[l], ssm_d[l],
                         w_glu[l], w_ssm_out[l], w_att_out[l], w_out[l])
        x = x + gt1 * rms_norm(y, g_post_mix[l])
        h = rms_norm(x, g_pre_ffn[l]) * (1.0 + sc2) + sh2
        y = moe_ffn(h, w_router[l], b_router[l], w_exp_in[l], b_exp_in[l],
                    w_exp_out[l], b_exp_out[l])
        x = x + gt2 * rms_norm(y, g_post_ffn[l])
    return x
```

```cpp
#include <hip/hip_runtime.h>
#include <cstdio>
#include <cstdint>

#define LAS __attribute__((address_space(3)))
#define GAS __attribute__((address_space(1)))
typedef unsigned short bf16_t;
typedef short bf16x8 __attribute__((ext_vector_type(8)));
typedef short s16x4 __attribute__((ext_vector_type(4)));
typedef float f32x4 __attribute__((ext_vector_type(4)));
typedef float f32x2 __attribute__((ext_vector_type(2)));
typedef float f32x16 __attribute__((ext_vector_type(16)));
typedef unsigned u32x4 __attribute__((ext_vector_type(4)));
typedef unsigned u32x2 __attribute__((ext_vector_type(2)));
typedef __bf16 bf16x2v __attribute__((ext_vector_type(2)));
typedef int i32x4 __attribute__((ext_vector_type(4)));
typedef int i32x8 __attribute__((ext_vector_type(8)));
#define DI __device__ __forceinline__

#define PROBE_KREP 1
constexpr int D = 1024, NB = 16, SEQ = 2048, T = NB * SEQ, DEPTH = 2;
constexpr int AW = 512, NH = 8, HD = 64, MBLK = 256, NBLK = SEQ / MBLK;
constexpr int SW = 512, SG = 16, NG = 32, SP = 64, CH = 32  , NCH = SEQ / CH  ;
constexpr int INW = 4096, NE = 32, TOPK = 4, DFF = 1024, NMOD = 6;
constexpr int UAK = 640;
constexpr int CROWS = NB * NCH;
constexpr float RMS_EPS = 1e-6f, LOG2E_C = 1.4426950408889634f;

constexpr size_t MiB = 1u << 20;
constexpr size_t WS_CTL = 0;
constexpr size_t WS_KMEAN = 1 * MiB;
constexpr size_t WS_ZERO_BYTES = 2 * MiB;
constexpr size_t WS_MOD = 2 * MiB;
constexpr size_t WS_L32 = 3 * MiB;
constexpr size_t WS_LISTS = 4 * MiB;
constexpr size_t WS_WIN = 12 * MiB;
constexpr size_t WS_WGLU = 28 * MiB;
constexpr size_t WS_WATT = 30 * MiB;
constexpr size_t WS_WSSM = 32 * MiB;
constexpr size_t WS_WOUT = 34 * MiB;
constexpr size_t WS_BSSM = 38 * MiB;
constexpr size_t WS_BE = 80 * MiB;
constexpr size_t WS_W1 = 98 * MiB;
constexpr size_t WS_W2 = 354 * MiB;
constexpr size_t WS_H = 482 * MiB;
constexpr size_t WS_Q = 546 * MiB, WS_K = 578 * MiB, WS_V = 610 * MiB;
constexpr size_t WS_H8 = WS_Q;
constexpr size_t WS_UA = 642 * MiB;
constexpr size_t WS_GATT = 684 * MiB, WS_GSSM = 748 * MiB;
constexpr size_t WS_ATT = 812 * MiB;
constexpr size_t WS_E = 844 * MiB;
constexpr size_t WS_Y = 860 * MiB;
constexpr size_t WS_Z = 892 * MiB;
constexpr size_t WS_MRG = 924 * MiB;
constexpr size_t WS_YMIX = 988 * MiB;
constexpr size_t WS_ACT = 1052 * MiB;
constexpr size_t WS_YSLOT = 1338 * MiB;
constexpr size_t WS_XB = 1594 * MiB;
constexpr size_t WS_HF8 = 1658 * MiB;
constexpr size_t WS_WIN8 = 1690 * MiB;
constexpr size_t WS_AZ = 1696 * MiB;
constexpr size_t WS_WCAT = 1760 * MiB;
constexpr size_t WS_END = 1764 * MiB;
constexpr int LIST_CAP = T;

constexpr int CW_BAR = 4096;
constexpr int CW_QUEUE = 8192;
constexpr int CW_CNT = 16384;

constexpr int RING_BYTES = 131072;
constexpr int LDS_MISC = RING_BYTES;
constexpr int LDS_BYTES = RING_BYTES + 4096;

DI unsigned pk2(float lo, float hi) { f32x2 v = {lo, hi}; bf16x2v r = __builtin_convertvector(v, bf16x2v); return __builtin_bit_cast(unsigned, r); }
DI float sat8(float x) { return __builtin_amdgcn_fmed3f(x, -448.0f, 448.0f); }
DI unsigned pk4_fp8(float a, float b, float c, float d) { int r = 0; r = __builtin_amdgcn_cvt_pk_fp8_f32(sat8(a), sat8(b), r, false); r = __builtin_amdgcn_cvt_pk_fp8_f32(sat8(c), sat8(d), r, true); return (unsigned)r; }
constexpr float W8_SCALE = 64.0f, H8_SCALE = 16.0f, ACT8_SCALE = 8.0f, GATE8_SCALE = 16.0f, YS8_SCALE = 64.0f, MRG8_SCALE = 32.0f, AZ8_SCALE = 8.0f;
DI void unpack8_fp8(const u32x2& w, f32x4& a, f32x4& b) { const f32x2 p0 = __builtin_amdgcn_cvt_pk_f32_fp8((int)w.x, false), p1 = __builtin_amdgcn_cvt_pk_f32_fp8((int)w.x, true), p2 = __builtin_amdgcn_cvt_pk_f32_fp8((int)w.y, false), p3 = __builtin_amdgcn_cvt_pk_f32_fp8((int)w.y, true);
    a = (f32x4){p0[0], p0[1], p1[0], p1[1]}; b = (f32x4){p2[0], p2[1], p3[0], p3[1]}; }
DI float bflo(unsigned w) { return __uint_as_float(w << 16); }
DI float bfhi(unsigned w) { return __uint_as_float(w & 0xffff0000u); }
DI float sigmoidf_(float x) { return __builtin_amdgcn_rcpf(1.0f + __builtin_amdgcn_exp2f(-1.4426950408889634f * x)); }
DI float gelu_tanh(float x) { const float u = 0.7978845608028654f * (x + 0.044715f * x * x * x); return x * __builtin_amdgcn_rcpf(1.0f + __builtin_amdgcn_exp2f(-2.8853900817779268f * u)); }
DI float shx(float v, int m, int lane) { return __int_as_float(__builtin_amdgcn_ds_bpermute((lane ^ m) << 2, __float_as_int(v))); }
DI int shxi(int v, int m, int lane) { return __builtin_amdgcn_ds_bpermute((lane ^ m) << 2, v); }
DI float half_max(float v) { const auto rr = __builtin_amdgcn_permlane32_swap(__float_as_uint(v), __float_as_uint(v), false, false); return fmaxf(__uint_as_float(rr[0]), __uint_as_float(rr[1])); }
DI float half_sum(float v) { const auto rr = __builtin_amdgcn_permlane32_swap(__float_as_uint(v), __float_as_uint(v), false, false); return __uint_as_float(rr[0]) + __uint_as_float(rr[1]); }
DI float wave_sum(float v, int lane) {
#pragma unroll
    for (int o = 1; o < 64; o <<= 1) v += shx(v, o, lane);
    return v;
}
#define LDS_WAIT() asm volatile("s_waitcnt lgkmcnt(0)" ::: "memory")
#define VM_WAIT() asm volatile("s_waitcnt vmcnt(0)" ::: "memory")

#define XB_TMO      128
#define XB_XCNT(j)  (256  + 64 * (j))
#define XB_XSUB(j)  (1280 + 64 * (j))
#define XB_XGEN(j)  (2304 + 64 * (j))
#define XB_TOP      3328
#define XB_TOPGEN   3392
#define XCD_BAR_WORDS 3456
#define XB_SPIN_CAP (1u << 18)
__device__ __forceinline__ unsigned xb_ld(unsigned* p)              { return __hip_atomic_load(p, __ATOMIC_RELAXED, __HIP_MEMORY_SCOPE_AGENT); }
__device__ __forceinline__ unsigned xb_add(unsigned* p, unsigned v) { return __hip_atomic_fetch_add(p, v, __ATOMIC_RELAXED, __HIP_MEMORY_SCOPE_AGENT); }
__device__ __forceinline__ unsigned xb_xcc_id() { return (unsigned)__builtin_amdgcn_s_getreg((3 << 11) | 20) & 0xFu; }
#define XB_SPIN(cond, bar) do { unsigned _sp = 0; while (cond) { __builtin_amdgcn_s_sleep(1); \
    if ((++_sp & 255u) == 0u) { if (xb_ld(&(bar)[XB_TMO])) break; if (_sp > XB_SPIN_CAP) { atomicAdd(&(bar)[XB_TMO], 1u); break; } } } } while (0)
struct XcdBarrier { unsigned* bar; unsigned x; volatile LAS unsigned* st; };
__device__ __forceinline__ XcdBarrier xcd_barrier_post(unsigned* bar, volatile LAS unsigned* st, bool t0) {
    XcdBarrier b; b.bar = bar; b.x = xb_xcc_id(); b.st = st;
    if (t0) (void)xb_add(&bar[XB_XCNT(b.x)], 1u);
    return b;
}
__device__ __forceinline__ void xcd_barrier_complete(unsigned* bar, unsigned x, unsigned& nloc, unsigned& nx) {
    const unsigned G = gridDim.x * gridDim.y * gridDim.z;
    unsigned sum, cnt, mine, sp = 0u;
    for (;;) {
        sum = 0u; cnt = 0u; mine = 0u;
#pragma unroll
        for (unsigned j = 0; j < 16; ++j) { const unsigned c = xb_ld(&bar[XB_XCNT(j)]); sum += c; cnt += (c > 0u) ? 1u : 0u; mine = (j == x) ? c : mine; }
        if (sum == G) break;
        __builtin_amdgcn_s_sleep(1);
        if ((++sp & 255u) == 0u) { if (xb_ld(&bar[XB_TMO])) break; if (sp > XB_SPIN_CAP) { atomicAdd(&bar[XB_TMO], 1u); break; } }
    }
    nloc = mine > 0u ? mine : 1u; nx = cnt > 0u ? cnt : 1u;
}
__device__ __forceinline__ void xcd_barrier(const XcdBarrier& b, bool t0) {
    asm volatile("s_waitcnt vmcnt(0)" ::: "memory");
    __syncthreads();
    if (t0) {
        unsigned* bar = b.bar;
        __builtin_amdgcn_s_waitcnt(0);
        unsigned nloc = b.st[0], nx = b.st[1];
        if (nloc == 0u) { xcd_barrier_complete(bar, b.x, nloc, nx); b.st[0] = nloc; b.st[1] = nx; }
        const unsigned old = xb_add(&bar[XB_XSUB(b.x)], 1u);
        const unsigned gen = old / nloc;
        if (old + 1u == (gen + 1u) * nloc) {
            __builtin_amdgcn_fence(__ATOMIC_RELEASE, "agent");
            asm volatile("s_waitcnt vmcnt(0)" ::: "memory");
            const unsigned og = xb_add(&bar[XB_TOP], 1u);
            const unsigned tg = og / nx;
            if (og + 1u == (tg + 1u) * nx) xb_add(&bar[XB_TOPGEN], 1u);
            else XB_SPIN(xb_ld(&bar[XB_TOPGEN]) == tg, bar);
            __builtin_amdgcn_fence(__ATOMIC_ACQUIRE, "agent");
            xb_add(&bar[XB_XGEN(b.x)], 1u);
            asm volatile("s_waitcnt vmcnt(0)" ::: "memory");
        } else {
            XB_SPIN(xb_ld(&bar[XB_XGEN(b.x)]) == gen, bar);
            __builtin_amdgcn_fence(__ATOMIC_ACQUIRE, "agent");
            asm volatile("s_waitcnt vmcnt(0)" ::: "memory");
        }
    }
    __syncthreads();
}

namespace pg8 {
constexpr int BM = 256, BK = 64, HALF = 128, HTB = HALF * BK * 2, STAGE_BYTES = 8 * HTB;
__host__ __device__ __forceinline__ int lds_byte(int r, int c) { const int st = (r >> 4) * 2 + (c >> 5), rr = r & 15, cc = c & 31, ob = rr * 64 + cc * 2; return st * 1024 + (ob ^ (((ob >> 9) & 1) << 5)); }
__host__ __device__ __forceinline__ void stage_rc(int b, int& R, int& C) { const int st = b / 1024, sb = b % 1024, swz = sb ^ (((sb >> 9) & 1) << 5); R = (st >> 1) * 16 + swz / 64; C = (st & 1) * 32 + (swz % 64) / 2; }
__host__ __device__ __forceinline__ int perm32(int rho) { const int n = rho >> 4, i = rho & 15; return 8 * (i >> 2) + 4 * n + (i & 3); }

struct Unit { int pm, pn, e, j, n, half; const char* A; const char* B; };
template <class...> struct voider { typedef void type; };
template <class E, class = void> struct MidT { static constexpr int v = -1; };
template <class E> struct MidT<E, typename voider<decltype(E::MID_T)>::type> { static constexpr int v = E::MID_T; };

template <class Epi, class Sched, bool GATHER, bool F8 = false>
__device__ __forceinline__ void gemm_phase(LAS unsigned char* lds, const Sched& S, const Epi& E, const int nt, const int lda, const int ldb, int wave_s, const int kmod = 0) {
    unsigned ones_ = ~0u; asm volatile("" : "+s"(wave_s), "+s"(ones_)); int tid = wave_s * 64 + (int)__builtin_amdgcn_mbcnt_hi(ones_, __builtin_amdgcn_mbcnt_lo(ones_, 0u)); asm volatile("" : "+v"(tid));
    const int wid = __builtin_amdgcn_readfirstlane(tid >> 6), lane = tid & 63, wr = wid >> 2, wc = wid & 3, fr = lane & 15, fq = lane >> 4;
    unsigned voffA, voffB;
    { int R, C; stage_rc(tid * 16, R, C); const int Rb = Epi::PERM ? ((R & ~31) + perm32(R & 31)) : R;
        voffA = (unsigned)(R * lda + C) * 2u; voffB = (unsigned)(Rb * ldb + C) * 2u; }
    const size_t qstepA = (size_t)64 * lda * 2, qstepB = (size_t)64 * ldb * 2;
    const size_t kstep = (size_t)(BK * 2);
    const size_t hstepA = (size_t)HALF * lda * 2, hstepB = (size_t)HALF * ldb * 2;
    const unsigned ldsw = (unsigned)wid * 1024u;
    const int aoff = lds_byte(wr * 64 + fr, fq * 8), boff = lds_byte(wc * 32 + fr, fq * 8);
#define PG8_SA(b, h) (((b) * 2 + (h)) * HTB)
#define PG8_SB(b, h) ((4 + (b) * 2 + (h)) * HTB)
#define PG8_STAGE(bufoff, gbase, voff) do { _Pragma("unroll") for (int _i = 0; _i < 2; ++_i) { unsigned _vo = (voff)[_i]; asm volatile("" : "+v"(_vo));     \
        __builtin_amdgcn_global_load_lds((const unsigned*)((const char*)(gbase) + _vo), (LAS unsigned*)(lds + (bufoff) + ldsw + _i * 8192), 16, 0, 0); } } while (0)
#define PG8_STAGE_U(bufoff, gbase, voff, qstep) do { _Pragma("unroll") for (int _i = 0; _i < 2; ++_i) { unsigned _vo = (voff); asm volatile("" : "+v"(_vo)); \
        __builtin_amdgcn_global_load_lds((const unsigned*)((const char*)(gbase) + _i * (qstep) + _vo), (LAS unsigned*)(lds + (bufoff) + ldsw + _i * 8192), 16, 0, 0); } } while (0)
#define PG8_STAGE_B(bufoff, gbase) PG8_STAGE_U(bufoff, gbase, voffB, qstepB)
#define PG8_STAGE_A(bufoff, gbase, h, GO) do { if constexpr (GATHER) { PG8_STAGE(bufoff, gbase, (GO)[h]); } else { PG8_STAGE_U(bufoff, (const char*)(gbase) + (h) * hstepA, voffA, qstepA); } } while (0)
#define PG8_LDA(dst, b, h) do { _Pragma("unroll") for (int m = 0; m < 4; ++m) _Pragma("unroll") for (int k = 0; k < 2; ++k) dst[m][k] = *(const LAS bf16x8*)(lds + PG8_SA(b, h) + aoff + m * 2048 + k * 1024); } while (0)
#define PG8_LDB(dst, b, h) do { _Pragma("unroll") for (int n = 0; n < 2; ++n) _Pragma("unroll") for (int k = 0; k < 2; ++k) dst[n][k] = *(const LAS bf16x8*)(lds + PG8_SB(b, h) + boff + n * 2048 + k * 1024); } while (0)
#define PG8_MMA(ai, bj, At, Bt) do { __builtin_amdgcn_s_setprio(1); if constexpr (F8) { _Pragma("unroll") for (int m = 0; m < 4; ++m) _Pragma("unroll") for (int n = 0; n < 2; ++n) { \
            const i32x8 a8 = __builtin_shufflevector(__builtin_bit_cast(i32x4, Bt[n][0]), __builtin_bit_cast(i32x4, Bt[n][1]), 0, 1, 2, 3, 4, 5, 6, 7); \
            const i32x8 b8 = __builtin_shufflevector(__builtin_bit_cast(i32x4, At[m][0]), __builtin_bit_cast(i32x4, At[m][1]), 0, 1, 2, 3, 4, 5, 6, 7); \
            acc[ai][bj][m][n] = __builtin_amdgcn_mfma_scale_f32_16x16x128_f8f6f4(a8, b8, acc[ai][bj][m][n], 0, 0, 0, 0, 0, 0); } } \
        else { _Pragma("unroll") for (int m = 0; m < 4; ++m) _Pragma("unroll") for (int n = 0; n < 2; ++n) _Pragma("unroll") for (int k = 0; k < 2; ++k) \
        acc[ai][bj][m][n] = __builtin_amdgcn_mfma_f32_16x16x32_bf16(Bt[n][k], At[m][k], acc[ai][bj][m][n], 0, 0, 0); } __builtin_amdgcn_s_setprio(0); } while (0)
#define PG8_WAIT_V(n) asm volatile("s_waitcnt vmcnt(" #n ")" ::: "memory")
#define PG8_WAIT_L(n) asm volatile("s_waitcnt lgkmcnt(" #n ")" ::: "memory")
#define PG8_BAR __builtin_amdgcn_s_barrier()
#define PG8_SCHED __builtin_amdgcn_sched_barrier(0)
    Unit cur, nxt; int ui = 0;
    if (!S.next(0, cur)) return;
    f32x4 acc[2][2][4][2];
#pragma unroll
    for (int a = 0; a < 2; ++a)
#pragma unroll
        for (int b = 0; b < 2; ++b)
#pragma unroll
            for (int m = 0; m < 4; ++m)
#pragma unroll
                for (int n = 0; n < 2; ++n) acc[a][b][m][n] = (f32x4){0.f, 0.f, 0.f, 0.f};
    bf16x8 At[4][2], B0[2][2], B1[2][2];
    const char* cA = cur.A; const char* cB = cur.B;
    unsigned gc[2][2], gn[2][2];
#define PG8_GOFF(dst, U) do { _Pragma("unroll") for (int _h = 0; _h < 2; ++_h) _Pragma("unroll") for (int _i = 0; _i < 2; ++_i) { int _R, _C; stage_rc(tid * 16 + _i * 8192, _R, _C); dst[_h][_i] = (unsigned)S.gather_row(U, _h * HALF + _R); } } while (0)
#define PG8_GCVT(dst) do { _Pragma("unroll") for (int _h = 0; _h < 2; ++_h) _Pragma("unroll") for (int _i = 0; _i < 2; ++_i) { int _R, _C; stage_rc(tid * 16 + _i * 8192, _R, _C); dst[_h][_i] = dst[_h][_i] * (unsigned)(lda * 2) + (unsigned)(_C * 2); } } while (0)
#pragma unroll
    for (int h = 0; h < 2; ++h)
#pragma unroll
        for (int i = 0; i < 2; ++i) { gc[h][i] = 0; gn[h][i] = 0; }
    if constexpr (GATHER) { PG8_GOFF(gc, cur); PG8_GCVT(gc); }
    PG8_STAGE_B(PG8_SB(0, 0), cB); PG8_STAGE_B(PG8_SB(0, 1), cB + hstepB); PG8_STAGE_A(PG8_SA(0, 0), cA, 0, gc); PG8_STAGE_A(PG8_SA(0, 1), cA, 1, gc);
    if (wr == 1) PG8_BAR;
    PG8_WAIT_V(2); PG8_BAR;
    PG8_STAGE_B(PG8_SB(1, 0), cB + kstep); PG8_STAGE_A(PG8_SA(1, 0), cA + kstep, 0, gc); PG8_STAGE_B(PG8_SB(1, 1), cB + hstepB + kstep);
    PG8_WAIT_V(6); PG8_BAR;
    for (;;) {
        const bool has_next = S.next(ui + 1, nxt);
        const char* nA = has_next ? nxt.A : cA; const char* nB = has_next ? nxt.B : cB;
        if constexpr (GATHER) { if (has_next) PG8_GOFF(gn, nxt); }
#pragma unroll 1
        for (int t = 0; t < nt; t += 2) {
            const bool last = (t == nt - 2);
            const int t1 = kmod ? (t + 1) % kmod : t + 1, t2 = kmod ? (t + 2) % kmod : t + 2;
            const char* a1 = cA + (size_t)t1 * kstep;
            const char* a2 = last ? nA : cA + (size_t)t2 * kstep; const char* b2 = last ? nB : cB + (size_t)t2 * kstep;
            const char* a3 = a2 + kstep; const char* b3 = b2 + kstep;
            if constexpr (MidT<Epi>::v >= 0) { if (t == MidT<Epi>::v) { unsigned o2 = ~0u; int w2 = wave_s; asm volatile("" : "+s"(w2), "+s"(o2)); int l2 = (int)__builtin_amdgcn_mbcnt_hi(o2, __builtin_amdgcn_mbcnt_lo(o2, 0u)); asm volatile("" : "+v"(l2));
                E.mid(acc, cur, w2 >> 2, w2 & 3, l2 & 15, l2 >> 4); } }
            PG8_LDB(B0, 0, 0); PG8_LDB(B1, 0, 1); PG8_SCHED; PG8_LDA(At, 0, 0); PG8_STAGE_A(PG8_SA(1, 1), a1, 1, gc);
            if constexpr (GATHER) { if (last && has_next) {
#pragma unroll
                for (int h = 0; h < 2; ++h)
#pragma unroll
                    for (int i = 0; i < 2; ++i) { int _R, _C; stage_rc(tid * 16 + i * 8192, _R, _C); gc[h][i] = gn[h][i] * (unsigned)(lda * 2) + (unsigned)(_C * 2); } } }
            PG8_WAIT_V(8); PG8_WAIT_L(0); PG8_BAR; if (cur.half != 2) { PG8_MMA(0, 0, At, B0); PG8_MMA(0, 1, At, B1); } PG8_BAR; PG8_SCHED;
            PG8_LDA(At, 0, 1); PG8_STAGE_B(PG8_SB(0, 0), b2); PG8_STAGE_B(PG8_SB(0, 1), b2 + hstepB); PG8_STAGE_A(PG8_SA(0, 0), a2, 0, gc);
            PG8_WAIT_V(8); PG8_WAIT_L(0); PG8_BAR; if (cur.half != 1) { PG8_MMA(1, 0, At, B0); PG8_MMA(1, 1, At, B1); } PG8_BAR; PG8_SCHED;
            PG8_LDB(B0, 1, 0); PG8_LDB(B1, 1, 1); PG8_SCHED; PG8_LDA(At, 1, 0); PG8_STAGE_A(PG8_SA(0, 1), a2, 1, gc);
            PG8_WAIT_V(8); PG8_WAIT_L(0); PG8_BAR; if (cur.half != 2) { PG8_MMA(0, 0, At, B0); PG8_MMA(0, 1, At, B1); } PG8_BAR; PG8_SCHED;
            PG8_LDA(At, 1, 1); PG8_STAGE_B(PG8_SB(1, 0), b3); PG8_STAGE_B(PG8_SB(1, 1), b3 + hstepB); PG8_STAGE_A(PG8_SA(1, 0), a3, 0, gc);
            PG8_WAIT_V(8); PG8_WAIT_L(0); PG8_BAR; if (cur.half != 1) { PG8_MMA(1, 0, At, B0); PG8_MMA(1, 1, At, B1); } PG8_BAR; PG8_SCHED;
        }
        if (wr == 0) PG8_BAR;
        { unsigned o2 = ~0u; int w2 = wave_s; asm volatile("" : "+s"(w2), "+s"(o2)); int l2 = (int)__builtin_amdgcn_mbcnt_hi(o2, __builtin_amdgcn_mbcnt_lo(o2, 0u)); asm volatile("" : "+v"(l2));
          E(acc, cur, w2 >> 2, w2 & 3, l2 & 15, l2 >> 4); }
        if (!has_next) break;
#pragma unroll
        for (int a = 0; a < 2; ++a)
#pragma unroll
            for (int b = 0; b < 2; ++b)
#pragma unroll
                for (int m = 0; m < 4; ++m)
#pragma unroll
                    for (int n = 0; n < 2; ++n) acc[a][b][m][n] = (f32x4){0.f, 0.f, 0.f, 0.f};
        cur = nxt; cA = nA; cB = nB; ++ui;
        if (wr == 1) PG8_BAR;
    }
    PG8_WAIT_V(0);
    PG8_BAR;
#undef PG8_SA
#undef PG8_SB
#undef PG8_STAGE
#undef PG8_STAGE_A
#undef PG8_STAGE_U
#undef PG8_STAGE_B
#undef PG8_GOFF
#undef PG8_GCVT
#undef PG8_LDA
#undef PG8_LDB
#undef PG8_MMA
#undef PG8_WAIT_V
#undef PG8_WAIT_L
#undef PG8_BAR
#undef PG8_SCHED
}
}
using pg8::Unit;

struct PlainSched {
    const char* A; const char* B; int nM, nN, nwg, G, c; size_t tA, tB;
    DI void init(const void* A_, const void* B_, int M, int N, int lda, int ldb, int G_, int c_) { A = (const char*)A_; B = (const char*)B_; nM = M / 256; nN = N / 256; nwg = nM * nN; G = G_; c = c_; tA = (size_t)256 * lda * 2; tB = (size_t)256 * ldb * 2; }
    DI bool next(int i, Unit& u) const {
        const long L = (long)i * G + c; if (L >= nwg) return false;
        int wgid = (int)L; { const int q = nwg / 8, r = nwg % 8, xcd = wgid % 8, off = wgid / 8; wgid = (xcd < r ? xcd * (q + 1) : r * (q + 1) + (xcd - r) * q) + off; }
        const int nig = 8 * nN, gid = wgid / nig, fm = gid * 8, gsz = (nM - fm) < 8 ? (nM - fm) : 8;
        u.pm = fm + ((wgid % nig) % gsz); u.pn = (wgid % nig) / gsz; u.e = 0; u.j = 0; u.n = 0; u.half = 0;
        u.A = A + (size_t)u.pm * tA; u.B = B + (size_t)u.pn * tB; return true;
    }
    DI int gather_row(const Unit&, int) const { return 0; }
};
struct GroupSched {
    const char* A; const char* B; int nM, nN, G, c; size_t gA, gB, tA, tB;
    DI void init(const void* A_, const void* B_, int nM_, int nN_, int lda, int ldb, int brows, int G_, int c_) { A = (const char*)A_; B = (const char*)B_; nM = nM_; nN = nN_; G = G_; c = c_;
        gA = (size_t)CROWS * lda * 2; gB = (size_t)brows * ldb * 2; tA = (size_t)256 * lda * 2; tB = (size_t)256 * ldb * 2; }
    DI bool next(int i, Unit& u) const {
        const int L = i * G + c; const int per = nM * nN; if (L >= NG * per) return false;
        const int g = L / per, r = L % per; u.e = g; u.pm = r % nM; u.pn = r / nM; u.j = 0; u.n = 0; u.half = 0;
        u.A = A + (size_t)g * gA + (size_t)u.pm * tA; u.B = B + (size_t)g * gB + (size_t)u.pn * tB; return true;
    }
    DI int gather_row(const Unit&, int) const { return 0; }
};
struct MoeSched {
    const char* A; const char* B; const int2* lists; const LAS int* tb; const LAS int* cnt;
    int nN, GM, G, c; size_t eB, tB, tA; bool gather;
    const LAS int* ul;
    DI void build(volatile LAS int* ulw, int tid) const {
        if (tid < 32) { const int L = tid * G + c; const int xcd = L & 7, q = L >> 3; const int sr = (q >> 5) * 8 + xcd, slot = q & 31;
            int mt = sr * GM + (slot % GM), nt_ = slot / GM; const int Mt = tb[32];
            bool ok = mt < Mt; int half = 0;
            const int rl = (Mt + 8 * GM - 1) / (8 * GM) - 1, m0 = rl * 8 * GM, Vm = Mt - m0, V = Vm * nN;
            if (tid == rl && 2 * V <= G) { ok = c < 2 * V; const int v = c >> 1; mt = m0 + (ok ? v % Vm : 0); nt_ = ok ? v / Vm : 0; half = 1 + (c & 1); }
            int e = 0; for (int k = 1; k < 32; ++k) e += (tb[k] <= mt) ? 1 : 0;
            ulw[tid * 8 + 0] = ok ? mt : -1; ulw[tid * 8 + 1] = e; ulw[tid * 8 + 2] = mt - tb[e]; ulw[tid * 8 + 3] = cnt[e]; ulw[tid * 8 + 4] = nt_; ulw[tid * 8 + 5] = half; }
    }
    DI bool next(int i, Unit& u) const {
        if (i >= 32) return false;
        const int mt = __builtin_amdgcn_readfirstlane(ul[i * 8 + 0]);
        if (mt < 0) return false;
        const int e = __builtin_amdgcn_readfirstlane(ul[i * 8 + 1]), nt_ = __builtin_amdgcn_readfirstlane(ul[i * 8 + 4]);
        u.e = e; u.pm = mt; u.pn = nt_; u.j = __builtin_amdgcn_readfirstlane(ul[i * 8 + 2]); u.n = __builtin_amdgcn_readfirstlane(ul[i * 8 + 3]); u.half = __builtin_amdgcn_readfirstlane(ul[i * 8 + 5]);
        u.A = gather ? A : A + (size_t)mt * tA;
        u.B = B + (size_t)e * eB + (size_t)nt_ * tB; return true;
    }
    DI int gather_row(const Unit& u, int r) const {
        const int li = u.j * 256 + r; const int n = u.n;
        const char* lb = (const char*)lists + (size_t)u.e * LIST_CAP * 8;
        int tok = 0; if (li < n) tok = *(const int*)(lb + (unsigned)li * 8u) >> 2;
        return tok;
    }
};

#define EPI_ROWS_BEGIN _Pragma("unroll") for (int ai = 0; ai < 2; ++ai) _Pragma("unroll") for (int m = 0; m < 4; ++m) { const int rt = 128 * ai + 64 * wr + 16 * m + fr;
#define EPI_ROWS_END }
DI u32x4 pack8(const f32x4& a, const f32x4& b) { u32x4 w; w.x = pk2(a[0], a[1]); w.y = pk2(a[2], a[3]); w.z = pk2(b[0], b[1]); w.w = pk2(b[2], b[3]); return w; }
DI void unpack8(const u32x4& w, f32x4& a, f32x4& b) { a[0] = bflo(w.x); a[1] = bfhi(w.x); a[2] = bflo(w.y); a[3] = bfhi(w.y); b[0] = bflo(w.z); b[1] = bfhi(w.z); b[2] = bflo(w.w); b[3] = bfhi(w.w); }

struct EpiScaled {
    static constexpr bool PERM = true;
    bf16_t* o; int ldc; float sc;
    DI void operator()(const f32x4 (&acc)[2][2][4][2], const Unit& u, int wr, int wc, int fr, int fq) const {
        EPI_ROWS_BEGIN
            const size_t row = (size_t)u.pm * 256 + rt;
#pragma unroll
            for (int bj = 0; bj < 2; ++bj) *(u32x4*)(o + row * ldc + u.pn * 256 + bj * 128 + 32 * wc + 8 * fq) = pack8(acc[ai][bj][m][0] * sc, acc[ai][bj][m][1] * sc);
        EPI_ROWS_END
    }
};
struct EpiK {
    static constexpr bool PERM = true;
    bf16_t* k; float* kmean; float sc;
    DI void operator()(const f32x4 (&acc)[2][2][4][2], const Unit& u, int wr, int wc, int fr, int fq) const {
        const int c0 = u.pn * 256 + 32 * wc + 8 * fq; const int ln = fq * 16 + fr;
        EPI_ROWS_BEGIN
            const size_t row = (size_t)u.pm * 256 + rt;
#pragma unroll
            for (int bj = 0; bj < 2; ++bj) *(u32x4*)(k + row * AW + c0 + bj * 128) = pack8(acc[ai][bj][m][0] * sc, acc[ai][bj][m][1] * sc);
        EPI_ROWS_END
#pragma unroll
        for (int bj = 0; bj < 2; ++bj)
#pragma unroll
            for (int n = 0; n < 2; ++n) { f32x4 s = (f32x4){0.f, 0.f, 0.f, 0.f};
#pragma unroll
                for (int ai = 0; ai < 2; ++ai)
#pragma unroll
                    for (int m = 0; m < 4; ++m) s += acc[ai][bj][m][n];
#pragma unroll
                for (int j = 0; j < 4; ++j) { float x = s[j]; x += shx(x, 1, ln); x += shx(x, 2, ln); x += shx(x, 4, ln); x += shx(x, 8, ln); s[j] = x; }
                if (fr == 0) { float* dst = kmean + (size_t)u.pm * AW + c0 + bj * 128 + 4 * n;
#pragma unroll
                    for (int j = 0; j < 4; ++j) unsafeAtomicAdd(dst + j, s[j] * sc); }
                asm volatile("" ::: "memory"); }
    }
};
struct EpiU {
    static constexpr bool PERM = true;
    bf16_t* ua; float sc;
    DI void operator()(const f32x4 (&acc)[2][2][4][2], const Unit& u, int wr, int wc, int fr, int fq) const {
        EPI_ROWS_BEGIN
            const int row = u.pm * 256 + rt;
#pragma unroll
            for (int bj = 0; bj < 2; ++bj) { const int ch = u.pn * 256 + bj * 128 + 32 * wc + 8 * fq; const int g = ch >> 4, c0 = ch & 15;
                *(u32x4*)(ua + ((size_t)g * CROWS + (row >> 5)) * UAK + (row & 31) * 16 + c0) = pack8(acc[ai][bj][m][0] * sc, acc[ai][bj][m][1] * sc); }
        EPI_ROWS_END
    }
};
struct EpiSig {
    static constexpr bool PERM = true;
    unsigned char* o; float sc;
    DI void operator()(const f32x4 (&acc)[2][2][4][2], const Unit& u, int wr, int wc, int fr, int fq) const {
        const float s2 = sc * GATE8_SCALE;
        EPI_ROWS_BEGIN
            const size_t row = (size_t)u.pm * 256 + rt;
#pragma unroll
            for (int bj = 0; bj < 2; ++bj) { const f32x4 a = acc[ai][bj][m][0] * s2, b = acc[ai][bj][m][1] * s2;
                u32x2 w; w.x = pk4_fp8(a[0], a[1], a[2], a[3]); w.y = pk4_fp8(b[0], b[1], b[2], b[3]);
                *(u32x2*)(o + row * D + u.pn * 256 + bj * 128 + 32 * wc + 8 * fq) = w; }
        EPI_ROWS_END
    }
};
struct EpiQK {
    static constexpr bool PERM = true;
    bf16_t *q, *k; float* kmean; float sc;
    DI void operator()(const f32x4 (&acc)[2][2][4][2], const Unit& u, int wr, int wc, int fr, int fq) const {
        Unit u2 = u; u2.pn = u.pn & 1;
        if (u.pn < 2) { EpiScaled E{q, AW, sc * (0.125f * LOG2E_C)}; E(acc, u2, wr, wc, fr, fq); }
        else { EpiK E{k, kmean, sc}; E(acc, u2, wr, wc, fr, fq); }
    }
};
struct EpiVUG {
    static constexpr bool PERM = true;
    bf16_t *v, *ua; unsigned char *ga, *gs; float sc;
    DI void operator()(const f32x4 (&acc)[2][2][4][2], const Unit& u, int wr, int wc, int fr, int fq) const {
        Unit u2 = u;
        if (u.pn < 2) { EpiScaled E{v, AW, sc}; E(acc, u2, wr, wc, fr, fq); }
        else if (u.pn < 4) { u2.pn = u.pn - 2; EpiU E{ua, sc}; E(acc, u2, wr, wc, fr, fq); }
        else { u2.pn = (u.pn - 4) & 3; EpiSig E{u.pn < 8 ? ga : gs, sc}; E(acc, u2, wr, wc, fr, fq); }
    }
};
struct EpiG1 {
    static constexpr bool PERM = true;
    EpiQK a; EpiVUG b;
    DI void operator()(const f32x4 (&acc)[2][2][4][2], const Unit& u, int wr, int wc, int fr, int fq) const {
        if (u.pn < 4) a(acc, u, wr, wc, fr, fq); else { Unit u2 = u; u2.pn = u.pn - 4; b(acc, u2, wr, wc, fr, fq); }
    }
};
struct EpiState {
    static constexpr bool PERM = false;
    float* e;
    DI void operator()(const f32x4 (&acc)[2][2][4][2], const Unit& u, int wr, int wc, int fr, int fq) const {
        EPI_ROWS_BEGIN
            float* rowp = e + ((size_t)u.e * CROWS + u.pm * 256 + rt) * 128 + 32 * wc + 4 * fq;
#pragma unroll
            for (int n = 0; n < 2; ++n) *(f32x4*)(rowp + 16 * n) = acc[ai][0][m][n];
        EPI_ROWS_END
    }
};
struct EpiSsmOut {
    static constexpr bool PERM = true;
    bf16_t* y;
    DI void operator()(const f32x4 (&acc)[2][2][4][2], const Unit& u, int wr, int wc, int fr, int fq) const {
        EPI_ROWS_BEGIN
            const int R = u.pm * 256 + rt;
#pragma unroll
            for (int bj = 0; bj < 2; ++bj) { const int col = u.pn * 256 + bj * 128 + 32 * wc + 8 * fq; const int j = col >> 4, c0 = col & 15;
                f32x4 a = acc[ai][bj][m][0], b = acc[ai][bj][m][1];
#pragma unroll
                for (int q = 0; q < 4; ++q) { a[q] = gelu_tanh(a[q]); b[q] = gelu_tanh(b[q]); }
                *(u32x4*)(y + ((size_t)R * 32 + j) * SW + u.e * 16 + c0) = pack8(a, b); }
        EPI_ROWS_END
    }
};
struct EpiGlu {
    static constexpr bool PERM = true;
    unsigned char* z;
    DI void operator()(const f32x4 (&acc)[2][2][4][2], const Unit& u, int wr, int wc, int fr, int fq) const {
        EPI_ROWS_BEGIN
            const size_t row = (size_t)u.pm * 256 + rt; f32x4 a = acc[ai][0][m][0], b = acc[ai][0][m][1]; const f32x4 ga = acc[ai][1][m][0], gb = acc[ai][1][m][1];
#pragma unroll
            for (int q = 0; q < 4; ++q) { a[q] *= AZ8_SCALE * sigmoidf_(ga[q]); b[q] *= AZ8_SCALE * sigmoidf_(gb[q]); }
            u32x2 w; w.x = pk4_fp8(a[0], a[1], a[2], a[3]); w.y = pk4_fp8(b[0], b[1], b[2], b[3]);
            *(u32x2*)(z + row * D + AW + u.pn * 128 + 32 * wc + 8 * fq) = w;
        EPI_ROWS_END
    }
};
struct EpiMerge {
    static constexpr bool PERM = true; static constexpr int MID_T = 4;
    unsigned char* mrg; const unsigned char* gatt; const unsigned char* gssm;
    DI void mid(f32x4 (&acc)[2][2][4][2], const Unit& u, int wr, int wc, int fr, int fq) const {
        constexpr float c2 = -1.4426950408889634f / GATE8_SCALE;
#pragma unroll
        for (int ai = 0; ai < 2; ++ai) {
            u32x2 ga[4][2], gs[4][2];
#pragma unroll
            for (int m = 0; m < 4; ++m) { const size_t row = (size_t)u.pm * 256 + 128 * ai + 64 * wr + 16 * m + fr;
#pragma unroll
                for (int bj = 0; bj < 2; ++bj) { const size_t off = row * D + u.pn * 256 + bj * 128 + 32 * wc + 8 * fq; ga[m][bj] = *(const u32x2*)(gatt + off); gs[m][bj] = *(const u32x2*)(gssm + off); } }
            asm volatile("" ::: "memory");
#pragma unroll
            for (int m = 0; m < 4; ++m)
#pragma unroll
                for (int bj = 0; bj < 2; ++bj) { f32x4 xa, xb, sa, sb; unpack8_fp8(ga[m][bj], xa, xb); unpack8_fp8(gs[m][bj], sa, sb);
#pragma unroll
                    for (int q = 0; q < 4; ++q) {
                        acc[ai][bj][m][0][q] *= (1.0f + __builtin_amdgcn_exp2f(sa[q] * c2)) * __builtin_amdgcn_rcpf(1.0f + __builtin_amdgcn_exp2f(xa[q] * c2));
                        acc[ai][bj][m][1][q] *= (1.0f + __builtin_amdgcn_exp2f(sb[q] * c2)) * __builtin_amdgcn_rcpf(1.0f + __builtin_amdgcn_exp2f(xb[q] * c2)); } }
            asm volatile("" ::: "memory"); }
    }
    DI void operator()(const f32x4 (&acc)[2][2][4][2], const Unit& u, int wr, int wc, int fr, int fq) const {
        constexpr float c2 = -1.4426950408889634f / GATE8_SCALE;
#pragma unroll
        for (int ai = 0; ai < 2; ++ai) {
            u32x2 gs[4][2];
#pragma unroll
            for (int m = 0; m < 4; ++m) { const size_t row = (size_t)u.pm * 256 + 128 * ai + 64 * wr + 16 * m + fr;
#pragma unroll
                for (int bj = 0; bj < 2; ++bj) gs[m][bj] = *(const u32x2*)(gssm + row * D + u.pn * 256 + bj * 128 + 32 * wc + 8 * fq); }
            asm volatile("" ::: "memory");
#pragma unroll
            for (int m = 0; m < 4; ++m) { const size_t row = (size_t)u.pm * 256 + 128 * ai + 64 * wr + 16 * m + fr;
#pragma unroll
                for (int bj = 0; bj < 2; ++bj) { const size_t off = row * D + u.pn * 256 + bj * 128 + 32 * wc + 8 * fq;
                    f32x4 sa, sb; unpack8_fp8(gs[m][bj], sa, sb);
#pragma unroll
                    for (int q = 0; q < 4; ++q) { sa[q] = (MRG8_SCALE / (W8_SCALE * AZ8_SCALE)) * __builtin_amdgcn_rcpf(1.0f + __builtin_amdgcn_exp2f(sa[q] * c2)); sb[q] = (MRG8_SCALE / (W8_SCALE * AZ8_SCALE)) * __builtin_amdgcn_rcpf(1.0f + __builtin_amdgcn_exp2f(sb[q] * c2)); }
                    const f32x4 va = acc[ai][bj][m][0] * sa, vb = acc[ai][bj][m][1] * sb;
                    u32x2 w; w.x = pk4_fp8(va[0], va[1], va[2], va[3]); w.y = pk4_fp8(vb[0], vb[1], vb[2], vb[3]);
                    *(u32x2*)(mrg + off) = w; } }
            asm volatile("" ::: "memory"); }
    }
};
template <bool ADD> struct EpiGate {
    static constexpr bool PERM = true;
    bf16_t* mrg; const bf16_t* gate;
    DI void operator()(const f32x4 (&acc)[2][2][4][2], const Unit& u, int wr, int wc, int fr, int fq) const {
        EPI_ROWS_BEGIN
            const size_t row = (size_t)u.pm * 256 + rt;
#pragma unroll
            for (int bj = 0; bj < 2; ++bj) { const size_t off = row * D + u.pn * 256 + bj * 128 + 32 * wc + 8 * fq;
                f32x4 ga, gb; unpack8(*(const u32x4*)(gate + off), ga, gb);
                f32x4 a = acc[ai][bj][m][0] * ga, b = acc[ai][bj][m][1] * gb;
                if (ADD) { f32x4 pa, pb; unpack8(*(const u32x4*)(mrg + off), pa, pb); a += pa; b += pb; }
                *(u32x4*)(mrg + off) = pack8(a, b); }
        EPI_ROWS_END
    }
};
struct EpiPlain {
    static constexpr bool PERM = true;
    bf16_t* o; int ldc; float sc;
    DI void operator()(const f32x4 (&acc)[2][2][4][2], const Unit& u, int wr, int wc, int fr, int fq) const {
        EPI_ROWS_BEGIN
            const size_t row = (size_t)u.pm * 256 + rt;
#pragma unroll
            for (int bj = 0; bj < 2; ++bj) *(u32x4*)(o + row * ldc + u.pn * 256 + bj * 128 + 32 * wc + 8 * fq) = pack8(acc[ai][bj][m][0] * sc, acc[ai][bj][m][1] * sc);
        EPI_ROWS_END
    }
};
struct EpiSwiglu {
    static constexpr bool PERM = true;
    unsigned char* act; const float* b1;
    DI void operator()(const f32x4 (&acc)[2][2][4][2], const Unit& u, int wr, int wc, int fr, int fq) const {
        int lrow = 64 * wr + fr; asm volatile("" : "+v"(lrow));
        const int cj = u.pn * 128 + 32 * wc + 8 * fq; const float* bb = b1 + (size_t)u.e * 2048 + cj;
        const f32x4 bg0 = *(const f32x4*)(bb), bg1 = *(const f32x4*)(bb + 4), bu0 = *(const f32x4*)(bb + 1024), bu1 = *(const f32x4*)(bb + 1028);
        unsigned char* abase = act + (size_t)u.pm * 256 * DFF;
        constexpr float dq = 1.0f / (W8_SCALE * H8_SCALE * PROBE_KREP);
#pragma unroll
        for (int ai = 0; ai < 2; ++ai) { if (u.half == 2 - ai) continue;
#pragma unroll
            for (int m = 0; m < 4; ++m) { const unsigned off = (unsigned)((128 * ai + 16 * m + lrow) * DFF + cj);
            f32x4 g0 = acc[ai][0][m][0] * dq + bg0, g1 = acc[ai][0][m][1] * dq + bg1, u0 = acc[ai][1][m][0] * dq + bu0, u1 = acc[ai][1][m][1] * dq + bu1;
            unsigned wv[2];
#pragma unroll
            for (int hv = 0; hv < 2; ++hv) { const f32x4 gq = hv ? g1 : g0, uq = hv ? u1 : u0; int r = 0;
#pragma unroll
                for (int q = 0; q < 4; q += 2) {
                    f32x2 g = {fminf(gq[q], 7.0f), fminf(gq[q + 1], 7.0f)};
                    const f32x2 up = {fminf(fmaxf(uq[q], -7.0f), 7.0f), fminf(fmaxf(uq[q + 1], -7.0f), 7.0f)};
                    f32x2 t = __builtin_elementwise_fma(up, (f32x2){ACT8_SCALE, ACT8_SCALE}, (f32x2){ACT8_SCALE, ACT8_SCALE}) * g;
                    const f32x2 a = g * (f32x2){-1.702f * 1.4426950408889634f, -1.702f * 1.4426950408889634f};
                    f32x2 e = {__builtin_amdgcn_exp2f(a[0]), __builtin_amdgcn_exp2f(a[1])}; e = e + (f32x2){1.0f, 1.0f};
                    const f32x2 rc = {__builtin_amdgcn_rcpf(e[0]), __builtin_amdgcn_rcpf(e[1])};
                    t = t * rc;
                    r = q ? __builtin_amdgcn_cvt_pk_fp8_f32(t[0], t[1], r, true) : __builtin_amdgcn_cvt_pk_fp8_f32(t[0], t[1], r, false); }
                wv[hv] = (unsigned)r; }
            u32x2 w; w.x = wv[0]; w.y = wv[1];
            *(u32x2*)(abase + off) = w;
            asm volatile("" ::: "memory"); } }
    }
};
struct EpiMoeOut {
    static constexpr bool PERM = true;
    bf16_t* yslot; const float* b2; const int2* lists;
    DI void operator()(const f32x4 (&acc)[2][2][4][2], const Unit& u, int wr, int wc, int fr, int fq) const {
        int lrow = 64 * wr + fr, cwl = 32 * wc + 8 * fq; asm volatile("" : "+v"(lrow), "+v"(cwl));
        const int n = u.n; const int cw = u.pn * 256 + cwl;
        const char* lb = (const char*)lists + (size_t)u.e * LIST_CAP * 8;
        f32x4 bv[2][2];
#pragma unroll
        for (int bj = 0; bj < 2; ++bj) { const float* bb = b2 + (size_t)u.e * D + cw + bj * 128; bv[bj][0] = *(const f32x4*)bb; bv[bj][1] = *(const f32x4*)(bb + 4); }
        constexpr float dq = 1.0f / (W8_SCALE * ACT8_SCALE);
#pragma unroll
        for (int ai = 0; ai < 2; ++ai) { if (u.half == 2 - ai) continue;
            int2 ent[4];
#pragma unroll
            for (int m = 0; m < 4; ++m) { const int li = u.j * 256 + 128 * ai + 16 * m + lrow; ent[m] = *(const int2*)(lb + (unsigned)(li < n ? li : 0) * 8u); }
#pragma unroll
            for (int m = 0; m < 4; ++m) { const int li = u.j * 256 + 128 * ai + 16 * m + lrow; const float gw = __int_as_float(ent[m].y);
                char* dst = (char*)yslot + ((unsigned)ent[m].x * (unsigned)D + (unsigned)cw);
                const float gs = gw * YS8_SCALE;
                const f32x4 a0 = (acc[ai][0][m][0] * dq + bv[0][0]) * gs, a1 = (acc[ai][0][m][1] * dq + bv[0][1]) * gs, b0 = (acc[ai][1][m][0] * dq + bv[1][0]) * gs, b1 = (acc[ai][1][m][1] * dq + bv[1][1]) * gs;
                u32x2 w0, w1; w0.x = pk4_fp8(a0[0], a0[1], a0[2], a0[3]); w0.y = pk4_fp8(a1[0], a1[1], a1[2], a1[3]); w1.x = pk4_fp8(b0[0], b0[1], b0[2], b0[3]); w1.y = pk4_fp8(b1[0], b1[1], b1[2], b1[3]);
                if (li < n) { *(u32x2*)dst = w0; *(u32x2*)(dst + 128) = w1; } }
            asm volatile("" ::: "memory"); }
    }
};

struct Frame {
    LAS unsigned char* lds; volatile LAS unsigned* MISC; unsigned* ctl;
    int tid, lane, wave, G, bid;
    float* out; unsigned char* ws;
};
enum { I_X = 0, I_C, I_RELB, I_WADA, I_BADA, I_GPREMIX, I_GPOSTMIX, I_GPREFFN, I_GPOSTFFN, I_WIN, I_ARE, I_AIM, I_LOGDT, I_BRE, I_BIM, I_CRE, I_CIM, I_DSKIP,
       I_WGLU, I_WSSMO, I_WATTO, I_WOUT, I_WROUTER, I_BROUTER, I_WEXPIN, I_BEXPIN, I_WEXPOUT, I_BEXPOUT };
typedef const GAS float* __attribute__((address_space(4))) * kptr_t;
DI kptr_t kargs_now() { kptr_t p = (kptr_t)__builtin_amdgcn_kernarg_segment_ptr(); asm volatile("" : "+s"(p)); return p; }
DI const float* inp(kptr_t k, int i) { return (const float*)k[i]; }
DI unsigned char* opaque_ws(Frame& F) { GAS unsigned char* w = (GAS unsigned char*)F.ws; asm volatile("" : "+s"(w)); return (unsigned char*)w; }
DI void refresh(Frame& F) { int w = F.wave; unsigned ones_ = ~0u; asm volatile("" : "+s"(w), "+s"(ones_)); int ln = (int)__builtin_amdgcn_mbcnt_hi(ones_, __builtin_amdgcn_mbcnt_lo(ones_, 0u)); asm volatile("" : "+v"(ln)); F.tid = w * 64 + ln; F.lane = ln; F.wave = w; int b = blockIdx.x; asm volatile("" : "+s"(b)); F.bid = b; }

struct TItem { const float* W; unsigned char* WT; int N, Kd, kofs, drow0, k0, n0; bool f8, valid; };
DI void item_load(const TItem& d, f32x4 (&v)[16], int lane) {
    const int r4 = lane >> 4, c4 = lane & 15;
    const char* base = (const char*)(d.W + (size_t)d.k0 * d.N + d.n0);
    unsigned voff = (unsigned)(r4 * d.N + 4 * c4) * 4u; asm volatile("" : "+v"(voff));
    const size_t rstep = (size_t)d.N * 16;
#pragma unroll
    for (int i = 0; i < 16; ++i) v[i] = *(const f32x4*)(base + i * rstep + voff);
}
DI void item_scatter(const f32x4 (&v)[16], LAS float* scr, int lane) {
    const int r4 = lane >> 4, c4 = lane & 15;
#pragma unroll
    for (int i = 0; i < 16; ++i) { const int k = 4 * i + r4;
#pragma unroll
        for (int j = 0; j < 4; ++j) scr[(4 * c4 + j) * 64 + (k ^ (4 * (c4 ^ j)))] = v[i][j]; }
    LDS_WAIT(); asm volatile("" ::: "memory");
}
template <bool F8> DI void item_gather(const TItem& d, LAS float* scr, int lane) {
    if constexpr (F8) {
        const int nl = lane >> 2, kc = lane & 3;
        unsigned char* base = d.WT + (size_t)d.drow0 * d.Kd + d.kofs + d.k0;
        unsigned voff = (unsigned)(nl * d.Kd + 16 * kc); asm volatile("" : "+v"(voff));
        f32x4 x[16];
#pragma unroll
        for (int t = 0; t < 4; ++t) { const int n = nl + 16 * t; const int sw = 4 * (((n >> 2) & 15) ^ (n & 3));
#pragma unroll
            for (int q = 0; q < 4; ++q) { const int kq = 16 * kc + 4 * q; x[t * 4 + q] = *(const LAS f32x4*)(scr + n * 64 + (kq ^ sw)); } }
        asm volatile("s_waitcnt lgkmcnt(0)" : "+v"(x[0]), "+v"(x[1]), "+v"(x[2]), "+v"(x[3]), "+v"(x[4]), "+v"(x[5]), "+v"(x[6]), "+v"(x[7]),
                     "+v"(x[8]), "+v"(x[9]), "+v"(x[10]), "+v"(x[11]), "+v"(x[12]), "+v"(x[13]), "+v"(x[14]), "+v"(x[15]) :: "memory");
#pragma unroll
        for (int t = 0; t < 4; ++t) { u32x4 o;
#pragma unroll
            for (int q = 0; q < 4; ++q) { const f32x4 y = x[t * 4 + q]; o[q] = pk4_fp8(y[0] * W8_SCALE, y[1] * W8_SCALE, y[2] * W8_SCALE, y[3] * W8_SCALE); }
            *(u32x4*)(base + (size_t)t * 16 * d.Kd + voff) = o; }
    } else {
        const int nl = lane >> 3, kc = lane & 7;
        unsigned char* base = d.WT + ((size_t)d.drow0 * d.Kd + d.kofs + d.k0) * 2;
        unsigned voff = (unsigned)(nl * d.Kd + 8 * kc) * 2u; asm volatile("" : "+v"(voff));
        f32x4 x[16];
#pragma unroll
        for (int t = 0; t < 8; ++t) { const int n = nl + 8 * t; const int sw = 4 * (((n >> 2) & 15) ^ (n & 3));
#pragma unroll
            for (int q = 0; q < 2; ++q) { const int kq = 8 * kc + 4 * q; x[t * 2 + q] = *(const LAS f32x4*)(scr + n * 64 + (kq ^ sw)); } }
        asm volatile("s_waitcnt lgkmcnt(0)" : "+v"(x[0]), "+v"(x[1]), "+v"(x[2]), "+v"(x[3]), "+v"(x[4]), "+v"(x[5]), "+v"(x[6]), "+v"(x[7]),
                     "+v"(x[8]), "+v"(x[9]), "+v"(x[10]), "+v"(x[11]), "+v"(x[12]), "+v"(x[13]), "+v"(x[14]), "+v"(x[15]) :: "memory");
#pragma unroll
        for (int t = 0; t < 8; ++t) { u32x4 o;
#pragma unroll
            for (int q = 0; q < 2; ++q) { const f32x4 y = x[t * 2 + q]; o[2 * q] = pk2(y[0], y[1]); o[2 * q + 1] = pk2(y[2], y[3]); }
            *(u32x4*)(base + (size_t)t * 8 * d.Kd * 2 + voff) = o; }
    }
    LDS_WAIT(); asm volatile("" ::: "memory");
}
DI int imap(int n, int H) { return ((n % H) / 128) * 256 + (n / H) * 128 + (n % 128); }
constexpr int IT_IN = 16 * 64, IT_GLU = 8 * 16, IT_ATT = 8 * 16, IT_SSMO = 8 * 16, IT_OUT = 16 * 16, IT_W1 = 16 * 32, IT_W2 = 16 * 16;
constexpr int IT_LAYER = IT_IN + IT_GLU + IT_ATT + IT_SSMO + IT_OUT + NE * (IT_W1 + IT_W2);
constexpr int IT_SMALL = IT_IN + IT_GLU + IT_ATT + IT_SSMO + IT_OUT, IT_EXP = NE * (IT_W1 + IT_W2);
DI TItem decode_item(kptr_t KA, unsigned char* ws, int kind, int it) {
    TItem d; d.valid = it < (kind == 0 ? DEPTH * IT_SMALL : IT_EXP); if (!d.valid) it = 0;
    const int l = kind == 0 ? it / IT_SMALL : kind - 1; int r = kind == 0 ? it % IT_SMALL : IT_SMALL + it;
    const float* W; unsigned char* WT; int K, N, H = 0; bool f8 = false;
    int nsub = 0, Kd = 0, kofs = 0;
    if (r < IT_IN) { W = inp(KA, I_WIN) + (size_t)l * D * INW; K = D; N = INW;
        WT = ws + WS_WIN + (size_t)l * INW * D; f8 = true; }
    else if ((r -= IT_IN) < IT_GLU) { W = inp(KA, I_WGLU) + (size_t)l * SW * 1024; WT = ws + WS_WGLU + (size_t)l * 1024 * SW * 2; K = SW; N = 1024; H = 512; }
    else if ((r -= IT_GLU) < IT_ATT) { W = inp(KA, I_WATTO) + (size_t)l * AW * D; WT = ws + WS_WCAT + (size_t)l * D * D; K = AW; N = D; Kd = D; f8 = true; }
    else if ((r -= IT_ATT) < IT_SSMO) { W = inp(KA, I_WSSMO) + (size_t)l * SW * D; WT = ws + WS_WCAT + (size_t)l * D * D; K = SW; N = D; Kd = D; kofs = AW; f8 = true; }
    else if ((r -= IT_SSMO) < IT_OUT) { W = inp(KA, I_WOUT) + (size_t)l * D * D; WT = ws + WS_WOUT + (size_t)l * D * D; K = D; N = D; f8 = true; }
    else if ((r -= IT_OUT) < NE * IT_W1) { const int e = r / IT_W1; r %= IT_W1; W = inp(KA, I_WEXPIN) + ((size_t)l * NE + e) * D * 2048; WT = ws + WS_W1 + ((size_t)l * NE + e) * 2048 * D; K = D; N = 2048; H = 1024; f8 = true; }
    else { r -= NE * IT_W1; const int e = r / IT_W2; r %= IT_W2; W = inp(KA, I_WEXPOUT) + ((size_t)l * NE + e) * DFF * D; WT = ws + WS_W2 + ((size_t)l * NE + e) * D * DFF; K = DFF; N = D; f8 = true; }
    const int nblk = N / 64, kb = r / nblk, nb = r % nblk, n0 = nb * 64;
    d.W = W; d.WT = WT; d.N = N; d.Kd = Kd ? Kd : K; d.kofs = kofs; d.drow0 = (H ? imap(n0, H) : n0) - nsub; d.k0 = kb * 64; d.n0 = n0; d.f8 = f8;
    return d;
}
struct QState { int base, cnt; };
DI void run_items1(Frame& F, int kind, int quota, QState& q) {
    const kptr_t KA = kargs_now();
    LAS float* scr = (LAS float*)(F.lds + F.wave * 16384);
    unsigned* qctr = F.ctl + CW_QUEUE + 64 * kind;
#define RI_NEXT(D_) do { if (q.cnt == 8) { int b_ = 0; if (F.lane == 0) b_ = (int)__hip_atomic_fetch_add(qctr, 8u, __ATOMIC_RELAXED, __HIP_MEMORY_SCOPE_AGENT); q.base = __builtin_amdgcn_readfirstlane(b_); q.cnt = 0; } \
        D_ = decode_item(KA, F.ws, kind, q.base + q.cnt); ++q.cnt; } while (0)
    if (quota == 0) return;
    TItem d; RI_NEXT(d); if (!d.valid) return;
    f32x4 v[16]; item_load(d, v, F.lane);
    for (int n = 1; ; ++n) {
        item_scatter(v, scr, F.lane);
        TItem dn; dn.valid = false;
        if (quota < 0 || n < quota) { RI_NEXT(dn); if (dn.valid) item_load(dn, v, F.lane); }
        if (d.f8) item_gather<true>(d, scr, F.lane); else item_gather<false>(d, scr, F.lane);
        if (!dn.valid) break;
        d = dn;
    }
#undef RI_NEXT
}
DI void p_transposes(Frame& F) { refresh(F); QState q; q.base = 0; q.cnt = 8; run_items1(F, 0, -1, q); }
DI void p_adaln_unit(Frame& F, int unit) {
    refresh(F);
    const kptr_t KA = kargs_now();
    const int l = unit / 96, cb = unit % 96;
    LAS float* condT = (LAS float*)F.lds;
    LAS float* part = (LAS float*)(F.lds + 65536);
    for (int i = F.tid; i < NB * D; i += 512) { const int b = i / D, k = i % D; const float v = inp(KA, I_C)[i]; condT[k * 16 + b] = v / (1.0f + __expf(-v)); }
    __syncthreads();
    float acc[16];
#pragma unroll
    for (int b = 0; b < 16; ++b) acc[b] = 0.f;
    const float* wp = inp(KA, I_WADA) + (size_t)l * D * (NMOD * D) + cb * 64 + F.lane;
    for (int k0 = 0; k0 < 128; k0 += 32) {
        float wv[32];
#pragma unroll
        for (int kk = 0; kk < 32; ++kk) wv[kk] = wp[(size_t)(F.wave * 128 + k0 + kk) * (NMOD * D)];
#pragma unroll
        for (int kk = 0; kk < 32; ++kk) { const int k = F.wave * 128 + k0 + kk; const float w = wv[kk];
            const LAS f32x4* cp = (const LAS f32x4*)(condT + k * 16);
#pragma unroll
            for (int q = 0; q < 4; ++q) { const f32x4 cv = cp[q]; acc[4 * q] += cv[0] * w; acc[4 * q + 1] += cv[1] * w; acc[4 * q + 2] += cv[2] * w; acc[4 * q + 3] += cv[3] * w; } } }
#pragma unroll
    for (int b = 0; b < 16; ++b) part[(F.wave * 16 + b) * 64 + F.lane] = acc[b];
    __syncthreads();
    float* mod = (float*)(F.ws + WS_MOD);
    for (int o = F.tid; o < 1024; o += 512) { const int b = o >> 6, col = o & 63; float s = inp(KA, I_BADA)[(size_t)l * NMOD * D + cb * 64 + col];
#pragma unroll
        for (int w = 0; w < 8; ++w) s += part[(w * 16 + b) * 64 + col];
        mod[((size_t)l * NB + b) * (NMOD * D) + cb * 64 + col] = s; }
    __syncthreads();
}
DI double exp_d(double x) {
    const double kf = __builtin_rint(x * 1.4426950408889634); const double r = x - kf * 0.6931471805599453094;
    double t = 1.0, s = 1.0;
#pragma unroll
    for (int i = 1; i <= 16; ++i) { t *= r * (1.0 / (double)i); s += t; }
    const int k = (int)kf;
    return __builtin_ldexp(s, k);
}
DI void sincos_d(double a, double& sn, double& cs) {
    const double k = __builtin_rint(a * 0.15915494309189535); double r = __builtin_fma(-k, 6.283185307179586, a); r = __builtin_fma(-k, 2.4492935982947064e-16, r);
    const double x = r * 0.0625, x2 = x * x;
    double st = x, ct = 1.0, s = x, c = 1.0;
#pragma unroll
    for (int i = 1; i <= 9; ++i) { ct *= -x2 * (1.0 / (double)((2 * i - 1) * (2 * i))); c += ct; st *= -x2 * (1.0 / (double)((2 * i) * (2 * i + 1))); s += st; }
#pragma unroll
    for (int i = 0; i < 4; ++i) { const double s2 = 2.0 * s * c, c2 = c * c - s * s; s = s2; c = c2; }
    sn = s; cs = c;
}
DI void p_ssm_unit(Frame& F, int unit) {
    refresh(F);
    const kptr_t KA = kargs_now();
    const int l = unit / NG, g = unit % NG;
    LAS double* Lp = (LAS double*)F.lds;
    LAS float* Bb = (LAS float*)(F.lds + 33792);
    LAS float* Cc = (LAS float*)(F.lds + 50176);
    LAS float* Kt = (LAS float*)(F.lds + 66560);
    const int lg = l * NG + g;
    const double dt = exp_d((double)inp(KA, I_LOGDT)[lg]);
    for (int i = F.tid; i < 33 * 64; i += 512) { const int tau = i >> 6, p = i & 63;
        const double lre = fmin((double)inp(KA, I_ARE)[lg * SP + p], -1e-4), lim = (double)inp(KA, I_AIM)[lg * SP + p];
        const double mag = exp_d(lre * dt * (double)tau); double sn, cs; sincos_d(lim * dt * (double)tau, sn, cs);
        Lp[i * 2] = mag * cs; Lp[i * 2 + 1] = mag * sn; }
    __syncthreads();
    for (int i = F.tid; i < SP * SG; i += 512) { const int p = i >> 4, cc = i & 15;
        const double lre = fmin((double)inp(KA, I_ARE)[lg * SP + p], -1e-4), lim = (double)inp(KA, I_AIM)[lg * SP + p];
        const double nre = Lp[(64 + p) * 2] - 1.0, nim = Lp[(64 + p) * 2 + 1], den = lre * lre + lim * lim;
        const double zre = (nre * lre + nim * lim) / den, zim = (nim * lre - nre * lim) / den;
        const double br = (double)inp(KA, I_BRE)[((size_t)lg * SP + p) * SG + cc], bi = (double)inp(KA, I_BIM)[((size_t)lg * SP + p) * SG + cc];
        Bb[i * 2] = (float)(zre * br - zim * bi); Bb[i * 2 + 1] = (float)(zre * bi + zim * br); }
    for (int i = F.tid; i < SG * SP; i += 512) { Cc[i * 2] = inp(KA, I_CRE)[(size_t)lg * SG * SP + i]; Cc[i * 2 + 1] = inp(KA, I_CIM)[(size_t)lg * SG * SP + i]; }
    __syncthreads();
    LAS f32x2* Lf = (LAS f32x2*)(F.lds + 99328);
    for (int i = F.tid; i < 33 * 64; i += 512) Lf[i] = (f32x2){(float)Lp[i * 2], (float)Lp[i * 2 + 1]};
    __syncthreads();
    { const int pair = F.tid & 255, cc = pair >> 4, c2 = pair & 15, t0 = (F.tid >> 8) * 16; float acc[16];
#pragma unroll
      for (int q = 0; q < 16; ++q) acc[q] = 0.f;
      for (int p = 0; p < SP; ++p) { const float cr = Cc[(cc * 64 + p) * 2], ci = Cc[(cc * 64 + p) * 2 + 1], br = Bb[(p * 16 + c2) * 2], bi = Bb[(p * 16 + c2) * 2 + 1];
          const float gr = cr * br - ci * bi, gi = cr * bi + ci * br;
#pragma unroll
          for (int q = 0; q < 16; ++q) { const f32x2 lv = Lf[(t0 + q) * 64 + p]; acc[q] += gr * lv[0] - gi * lv[1]; } }
      if (t0 == 0 && cc == c2) acc[0] += inp(KA, I_DSKIP)[l * SW + g * 16 + cc];
#pragma unroll
      for (int q = 0; q < 16; ++q) Kt[((t0 + q) * 16 + cc) * 16 + c2] = acc[q]; }
    __syncthreads();
    bf16_t* bs = (bf16_t*)(F.ws + WS_BSSM) + (size_t)lg * 512 * UAK;
    for (int o = F.tid; o < 512 * (UAK / 8); o += 512) { const int n = o / (UAK / 8), k8 = (o % (UAK / 8)) * 8; const int j = n >> 4, cc = n & 15; float v[8];
        if (k8 < 512) { const int i = k8 >> 4, c0 = k8 & 15;
#pragma unroll
            for (int q = 0; q < 8; ++q) v[q] = (i <= j) ? Kt[((j - i) * 16 + cc) * 16 + c0 + q] : 0.f; }
        else { const int p0 = (k8 - 512) >> 1;
#pragma unroll
            for (int q = 0; q < 4; ++q) { const int p = p0 + q; const float cr = Cc[(cc * 64 + p) * 2], ci = Cc[(cc * 64 + p) * 2 + 1]; const f32x2 lv = Lf[(j + 1) * 64 + p];
                v[2 * q] = cr * lv[0] - ci * lv[1]; v[2 * q + 1] = -(cr * lv[1] + ci * lv[0]); } }
        u32x4 w; w.x = pk2(v[0], v[1]); w.y = pk2(v[2], v[3]); w.z = pk2(v[4], v[5]); w.w = pk2(v[6], v[7]);
        *(u32x4*)(bs + (size_t)n * UAK + k8) = w; }
    bf16_t* be = (bf16_t*)(F.ws + WS_BE) + (size_t)lg * 256 * 512;
    for (int o = F.tid; o < 256 * 64; o += 512) { const int n = o >> 6, k8 = (o & 63) * 8; float v[8];
        if (n < 128) { const int p = n >> 1, ri = n & 1, i = k8 >> 4, c0 = k8 & 15; const f32x2 lv = Lf[(31 - i) * 64 + p]; const float lr = lv[0], li = lv[1];
#pragma unroll
            for (int q = 0; q < 8; ++q) { const float br = Bb[(p * 16 + c0 + q) * 2], bi = Bb[(p * 16 + c0 + q) * 2 + 1]; v[q] = ri ? (lr * bi + li * br) : (lr * br - li * bi); } }
        else {
#pragma unroll
            for (int q = 0; q < 8; ++q) v[q] = 0.f; }
        u32x4 w; w.x = pk2(v[0], v[1]); w.y = pk2(v[2], v[3]); w.z = pk2(v[4], v[5]); w.w = pk2(v[6], v[7]);
        *(u32x4*)(be + (size_t)n * 512 + k8) = w; }
    float* l32 = (float*)(F.ws + WS_L32) + (size_t)lg * SP * 2;
    if (F.tid < SP) { l32[F.tid * 2] = (float)Lp[(32 * 64 + F.tid) * 2]; l32[F.tid * 2 + 1] = (float)Lp[(32 * 64 + F.tid) * 2 + 1]; }
    __syncthreads();
}

DI void load_row_f32(const float* p, int lane, f32x4 (&v)[4]) {
#pragma unroll
    for (int j = 0; j < 4; ++j) v[j] = *(const f32x4*)(p + 4 * lane + 256 * j);
}
DI float wave_sum_dpp(float v) {
#define DPP_ADD_(ctrl, rmask, bc) v += __int_as_float(__builtin_amdgcn_update_dpp(0, __float_as_int(v), ctrl, rmask, 0xf, bc))
    DPP_ADD_(0x111, 0xf, true); DPP_ADD_(0x112, 0xf, true); DPP_ADD_(0x114, 0xf, true); DPP_ADD_(0x118, 0xf, true);
    DPP_ADD_(0x142, 0xa, false); DPP_ADD_(0x143, 0xc, false);
#undef DPP_ADD_
    return __int_as_float(__builtin_amdgcn_readlane(__float_as_int(v), 63)); }
DI float sumsq(const f32x4 (&v)[4], int lane) { float s = 0.f; (void)lane;
#pragma unroll
    for (int j = 0; j < 4; ++j) s += (v[j][0] * v[j][0] + v[j][1] * v[j][1]) + (v[j][2] * v[j][2] + v[j][3] * v[j][3]);
    return wave_sum_dpp(s); }
struct ModP { f32x4 g[4], sc[4], sh[4]; };
DI void load_modp(ModP& m, const float* g, const float* sc, const float* sh, int lane) {
#pragma unroll
    for (int j = 0; j < 4; ++j) { const int o = 4 * lane + 256 * j; m.g[j] = *(const f32x4*)(g + o); m.sc[j] = *(const f32x4*)(sc + o); m.sh[j] = *(const f32x4*)(sh + o); } }
DI void mod_norm_store(const f32x4 (&xv)[4], float rstd, const ModP& m, bf16_t* orow, unsigned char* orow8, int lane, f32x4 (&hv)[4]) {
#pragma unroll
    for (int j = 0; j < 4; ++j) { const int o = 4 * lane + 256 * j; const f32x4 gv = m.g[j], scv = m.sc[j], shv = m.sh[j];
        hv[j] = xv[j] * rstd * gv * (1.0f + scv) + shv;
        u32x2 w; w.x = pk2(hv[j][0], hv[j][1]); w.y = pk2(hv[j][2], hv[j][3]); *(u32x2*)(orow + o) = w;
        *(unsigned*)(orow8 + o) = pk4_fp8(hv[j][0] * H8_SCALE, hv[j][1] * H8_SCALE, hv[j][2] * H8_SCALE, hv[j][3] * H8_SCALE); }
}
DI void mod_norm_store8(const f32x4 (&xv)[4], float rstd, const ModP& m, unsigned char* orow, int lane, f32x4 (&hv)[4]) {
#pragma unroll
    for (int j = 0; j < 4; ++j) { const int o = 4 * lane + 256 * j; const f32x4 gv = m.g[j], scv = m.sc[j], shv = m.sh[j];
        hv[j] = xv[j] * rstd * gv * (1.0f + scv) + shv;
        *(unsigned*)(orow + o) = pk4_fp8(hv[j][0] * H8_SCALE, hv[j][1] * H8_SCALE, hv[j][2] * H8_SCALE, hv[j][3] * H8_SCALE); }
}
DI void phase_n0(Frame& F, int l) {
    refresh(F);
    const kptr_t KA = kargs_now();
    const float* mod = (const float*)(F.ws + WS_MOD) + (size_t)l * NB * NMOD * D;
    const int gw = F.bid * 8 + F.wave, NGW = F.G * 8;
    for (int r0 = gw * 2; r0 < T; r0 += NGW * 2) {
        f32x4 xa[2][4], hv[4];
#pragma unroll
        for (int rr = 0; rr < 2; ++rr) load_row_f32(inp(KA, I_X) + (size_t)(r0 + rr) * D, F.lane, xa[rr]);
        ModP mp; { const int b = r0 / SEQ; load_modp(mp, inp(KA, I_GPREMIX) + l * D, mod + (size_t)b * NMOD * D + 1 * D, mod + (size_t)b * NMOD * D + 0 * D, F.lane); }
#pragma unroll
        for (int rr = 0; rr < 2; ++rr) { const int r = r0 + rr; const float rstd = rsqrtf(sumsq(xa[rr], F.lane) * (1.0f / D) + RMS_EPS);
            mod_norm_store8(xa[rr], rstd, mp, F.ws + WS_HF8 + (size_t)r * D, F.lane, hv); }
    }
}
DI void load_row_bf16(const bf16_t* p, int lane, f32x4 (&v)[4]) {
#pragma unroll
    for (int j = 0; j < 4; ++j) { const u32x2 w = *(const u32x2*)(p + 4 * lane + 256 * j); v[j][0] = bflo(w.x); v[j][1] = bfhi(w.x); v[j][2] = bflo(w.y); v[j][3] = bfhi(w.y); }
}
DI void phase_n1(Frame& F, int l) {
    refresh(F);
    const kptr_t KA = kargs_now();
    constexpr int RP = 2064;
    LAS unsigned char* WTl = F.lds; LAS unsigned char* HTl = F.lds + 32 * RP; LAS float* PS = (LAS float*)(F.lds + 48 * RP);
    volatile LAS int* hist = (volatile LAS int*)(F.MISC + 64); volatile LAS int* basew = (volatile LAS int*)(F.MISC + 96);
    const float* wr_ = inp(KA, I_WROUTER) + (size_t)l * D * NE;
    for (int idx = F.tid; idx < D * 8; idx += 512) { const int k = idx >> 3, c = idx & 7; const f32x4 v = *(const f32x4*)(wr_ + k * 32 + 4 * c);
#pragma unroll
        for (int q = 0; q < 4; ++q) *(LAS bf16_t*)(WTl + (4 * c + q) * RP + k * 2) = (bf16_t)(pk2(v[q], 0.f) & 0xffffu); }
    __syncthreads();
    const float* mod = (const float*)(F.ws + WS_MOD) + (size_t)l * NB * NMOD * D;
    const bf16_t* ymix = (const bf16_t*)(F.ws + WS_YMIX); unsigned char* h8 = F.ws + WS_H8;
    const float* xin = inp(KA, I_X); bf16_t* xb = (bf16_t*)(F.ws + WS_XB);
    int2* lists = (int2*)(F.ws + WS_LISTS); unsigned* cntg = F.ctl + CW_CNT + l * NE * 64;
    const float brt = inp(KA, I_BROUTER)[l * NE + (F.lane & 31)];
    for (int blk = F.bid; blk < T / 16; blk += F.G) {
        if (F.tid < 32) hist[F.tid] = 0;
        f32x4 hv[2][4], yv2[2][4], xv2[2][4];
#pragma unroll
        for (int rr = 0; rr < 2; ++rr) { const int r = blk * 16 + F.wave * 2 + rr;
            load_row_bf16(ymix + (size_t)r * D, F.lane, yv2[rr]); if (l == 0) load_row_f32(xin + (size_t)r * D, F.lane, xv2[rr]); else load_row_bf16(xb + (size_t)r * D, F.lane, xv2[rr]); }
        const float* mb = mod + (size_t)((blk * 16) / SEQ) * NMOD * D;
        f32x4 gpm[4], gtm[4]; ModP mp;
#pragma unroll
        for (int j = 0; j < 4; ++j) { const int o = 4 * F.lane + 256 * j; gpm[j] = *(const f32x4*)(inp(KA, I_GPOSTMIX) + l * D + o); gtm[j] = *(const f32x4*)(mb + 2 * D + o); }
        load_modp(mp, inp(KA, I_GPREFFN) + l * D, mb + 4 * D, mb + 3 * D, F.lane);
#pragma unroll
        for (int rr = 0; rr < 2; ++rr) { const int r = blk * 16 + F.wave * 2 + rr;
            f32x4 (&yv)[4] = yv2[rr]; f32x4 (&xv)[4] = xv2[rr];
            const float rstd_y = rsqrtf(sumsq(yv, F.lane) * (1.0f / D) + RMS_EPS);
#pragma unroll
            for (int j = 0; j < 4; ++j) { const int o = 4 * F.lane + 256 * j; const f32x4 gv = gpm[j], gt = gtm[j];
                xv[j] = xv[j] + gt * (yv[j] * rstd_y * gv); u32x2 w; w.x = pk2(xv[j][0], xv[j][1]); w.y = pk2(xv[j][2], xv[j][3]); *(u32x2*)(xb + (size_t)r * D + o) = w; }
            const float rstd_x = rsqrtf(sumsq(xv, F.lane) * (1.0f / D) + RMS_EPS);
            mod_norm_store8(xv, rstd_x, mp, h8 + (size_t)r * D, F.lane, hv[rr]); }
#pragma unroll
        for (int rr = 0; rr < 2; ++rr)
#pragma unroll
            for (int j = 0; j < 4; ++j) { u32x2 w; w.x = pk2(hv[rr][j][0], hv[rr][j][1]); w.y = pk2(hv[rr][j][2], hv[rr][j][3]); *(LAS u32x2*)(HTl + (F.wave * 2 + rr) * RP + (4 * F.lane + 256 * j) * 2) = w; }
        __syncthreads();
        { const int r16 = F.lane & 15, kg = F.lane >> 4; f32x4 c0 = (f32x4){0.f, 0.f, 0.f, 0.f}, c1 = c0;
#pragma unroll
          for (int st = 0; st < 4; ++st) { const int kb2 = (128 * F.wave + 32 * st + 8 * kg) * 2;
              const bf16x8 af = *(const LAS bf16x8*)(HTl + r16 * RP + kb2), b0 = *(const LAS bf16x8*)(WTl + r16 * RP + kb2), b1 = *(const LAS bf16x8*)(WTl + (16 + r16) * RP + kb2);
              c0 = __builtin_amdgcn_mfma_f32_16x16x32_bf16(af, b0, c0, 0, 0, 0); c1 = __builtin_amdgcn_mfma_f32_16x16x32_bf16(af, b1, c1, 0, 0, 0); }
#pragma unroll
          for (int i = 0; i < 4; ++i) { PS[(F.wave * 16 + 4 * kg + i) * 32 + r16] = c0[i]; PS[(F.wave * 16 + 4 * kg + i) * 32 + 16 + r16] = c1[i]; } }
        __syncthreads();
        float lgs = 0.f;
#pragma unroll
        for (int w = 0; w < 8; ++w) lgs += PS[(w * 16 + F.wave * 2 + (F.lane >> 5)) * 32 + (F.lane & 31)];
        float lg = lgs + brt; const int e_me = F.lane & 31;
        float topv[4]; int tope[4];
#pragma unroll
        for (int k = 0; k < 4; ++k) { float mv = lg; int mi = e_me;
#pragma unroll
            for (int st = 0; st < 4; ++st) {
                float ov; int oi;
                if (st == 0) { ov = __int_as_float(__builtin_amdgcn_update_dpp(0, __float_as_int(mv), 0x121, 0xf, 0xf, false)); oi = __builtin_amdgcn_update_dpp(0, mi, 0x121, 0xf, 0xf, false); }
                else if (st == 1) { ov = __int_as_float(__builtin_amdgcn_update_dpp(0, __float_as_int(mv), 0x122, 0xf, 0xf, false)); oi = __builtin_amdgcn_update_dpp(0, mi, 0x122, 0xf, 0xf, false); }
                else if (st == 2) { ov = __int_as_float(__builtin_amdgcn_update_dpp(0, __float_as_int(mv), 0x124, 0xf, 0xf, false)); oi = __builtin_amdgcn_update_dpp(0, mi, 0x124, 0xf, 0xf, false); }
                else { ov = __int_as_float(__builtin_amdgcn_update_dpp(0, __float_as_int(mv), 0x128, 0xf, 0xf, false)); oi = __builtin_amdgcn_update_dpp(0, mi, 0x128, 0xf, 0xf, false); }
                if (ov > mv || (ov == mv && oi < mi)) { mv = ov; mi = oi; } }
            { const float ov = shx(mv, 16, F.lane); const int oi = shxi(mi, 16, F.lane); if (ov > mv || (ov == mv && oi < mi)) { mv = ov; mi = oi; } }
            topv[k] = mv; tope[k] = mi; if (e_me == mi) lg = -INFINITY; }
        const float e1 = __expf(topv[1] - topv[0]), e2 = __expf(topv[2] - topv[0]), e3 = __expf(topv[3] - topv[0]); const float inv = 1.0f / (1.0f + e1 + e2 + e3);
        const int ks = F.lane & 31; const bool slot = ks < 4;
        const int my_e = ks == 0 ? tope[0] : (ks == 1 ? tope[1] : (ks == 2 ? tope[2] : tope[3]));
        const float my_g = (ks == 0 ? 1.0f : (ks == 1 ? e1 : (ks == 2 ? e2 : e3))) * inv;
        const int row = blk * 16 + F.wave * 2 + (F.lane >> 5);
        __syncthreads();
        int lrank = 0; if (slot) lrank = atomicAdd((int*)(hist + my_e), 1);
        __syncthreads();
        if (F.tid < 32) { const int n = hist[F.tid]; basew[F.tid] = n ? (int)atomicAdd(cntg + F.tid * 64, (unsigned)n) : 0; }
        __syncthreads();
        if (slot) { const int pos = basew[my_e] + lrank; int2 ent; ent.x = row * 4 + ks; ent.y = __float_as_int(my_g); lists[(size_t)my_e * LIST_CAP + pos] = ent; }
    }
    __syncthreads();
}
DI void load_row_fp8(const unsigned char* p, int lane, f32x4 (&v)[4]) {
#pragma unroll
    for (int j = 0; j < 4; ++j) { const unsigned w = *(const unsigned*)(p + 4 * lane + 256 * j); const f32x2 lo = __builtin_amdgcn_cvt_pk_f32_fp8((int)w, false), hi = __builtin_amdgcn_cvt_pk_f32_fp8((int)w, true); v[j] = (f32x4){lo[0], lo[1], hi[0], hi[1]}; }
}
DI void phase_n2(Frame& F, int l) {
    refresh(F);
    const kptr_t KA = kargs_now();
    const float* mod = (const float*)(F.ws + WS_MOD) + (size_t)l * NB * NMOD * D; const unsigned char* ys = F.ws + WS_YSLOT; bf16_t* xb = (bf16_t*)(F.ws + WS_XB);
    const int gw = F.bid * 8 + F.wave, NGW = F.G * 8;
    for (int r0 = gw * 2; r0 < T; r0 += NGW * 2) {
        f32x4 ya[2][4][4], xa[2][4];
#pragma unroll
        for (int rr = 0; rr < 2; ++rr) { const int r = r0 + rr;
#pragma unroll
            for (int k = 0; k < 4; ++k) load_row_fp8(ys + ((size_t)r * 4 + k) * D, F.lane, ya[rr][k]);
            load_row_bf16(xb + (size_t)r * D, F.lane, xa[rr]); }
        const float* mb = mod + (size_t)(r0 / SEQ) * NMOD * D;
        f32x4 gpf[4], gtf[4]; ModP mp;
#pragma unroll
        for (int j = 0; j < 4; ++j) { const int o = 4 * F.lane + 256 * j; gpf[j] = *(const f32x4*)(inp(KA, I_GPOSTFFN) + l * D + o); gtf[j] = *(const f32x4*)(mb + 5 * D + o); }
        if (l + 1 < DEPTH) { const float* mb2 = mb + (size_t)NB * NMOD * D; load_modp(mp, inp(KA, I_GPREMIX) + (l + 1) * D, mb2 + 1 * D, mb2 + 0 * D, F.lane); }
#pragma unroll
        for (int rr = 0; rr < 2; ++rr) { const int r = r0 + rr;
            f32x4 yv[4], hv[4]; f32x4 (&xv)[4] = xa[rr];
#pragma unroll
            for (int j = 0; j < 4; ++j) yv[j] = ((ya[rr][0][j] + ya[rr][1][j]) + (ya[rr][2][j] + ya[rr][3][j])) * (1.0f / YS8_SCALE);
            const float rstd_y = rsqrtf(sumsq(yv, F.lane) * (1.0f / D) + RMS_EPS);
#pragma unroll
            for (int j = 0; j < 4; ++j) { const int o = 4 * F.lane + 256 * j; const f32x4 gv = gpf[j], gt = gtf[j];
                xv[j] = xv[j] + gt * (yv[j] * rstd_y * gv);
                if (l + 1 < DEPTH) { u32x2 w; w.x = pk2(xv[j][0], xv[j][1]); w.y = pk2(xv[j][2], xv[j][3]); *(u32x2*)(xb + (size_t)r * D + o) = w; } else *(f32x4*)(F.out + (size_t)r * D + o) = xv[j]; }
            if (l + 1 < DEPTH) { const float rstd_x = rsqrtf(sumsq(xv, F.lane) * (1.0f / D) + RMS_EPS);
                mod_norm_store8(xv, rstd_x, mp, F.ws + WS_HF8 + (size_t)r * D, F.lane, hv); } }
    }
}
DI void phase_scan(Frame& F, int l) {
    refresh(F);
    const float* E = (const float*)(F.ws + WS_E); bf16_t* ua = (bf16_t*)(F.ws + WS_UA); const float* l32 = (const float*)(F.ws + WS_L32) + (size_t)l * NG * SP * 2;
    for (int u = F.bid; u < NG * 2; u += F.G) { const int g = u >> 1, b = (u & 1) * 8 + (F.tid >> 6), p = F.tid & 63;
        const float lr = l32[(g * SP + p) * 2], li = l32[(g * SP + p) * 2 + 1];
        const size_t row0 = (size_t)g * CROWS + b * NCH; float sr = 0.f, si = 0.f;
        f32x2 ev[NCH];
#pragma unroll
        for (int k = 0; k < NCH; ++k) ev[k] = *(const f32x2*)(E + (row0 + k) * 128 + 2 * p);
        asm volatile("" ::: "memory");
#pragma unroll
        for (int k = 0; k < NCH; ++k) {
            *(unsigned*)(ua + (row0 + k) * UAK + 512 + 2 * p) = pk2(sr, si);
            const float nr = lr * sr - li * si + ev[k][0], ni = lr * si + li * sr + ev[k][1]; sr = nr; si = ni; }
    }
}
constexpr float LOG2E = 1.4426950408889634f;
DI int t5_bucket(int n) { return n < 16 ? n : 16 + (n >= 19) + (n >= 21) + (n >= 24) + (n >= 27) + (n >= 31) + (n >= 35) + (n >= 40) + (n >= 46) + (n >= 52) + (n >= 59) + (n >= 67) + (n >= 77) + (n >= 87) + (n >= 99) + (n >= 113); }
#define MFMA32(a, b, c) __builtin_amdgcn_mfma_f32_32x32x16_bf16((a), (b), (c), 0, 0, 0)
DI void phase_attn(Frame& F, int l) {
    refresh(F);
    const kptr_t KA = kargs_now();
    const bf16_t* qb = (const bf16_t*)(F.ws + WS_Q); const bf16_t* kb = (const bf16_t*)(F.ws + WS_K); const bf16_t* vb = (const bf16_t*)(F.ws + WS_V);
    const float* kmean = (const float*)(F.ws + WS_KMEAN) + (size_t)l * NB * NBLK * AW; unsigned char* att = F.ws + WS_AZ;
    constexpr int ATT_BUF = 9216;
    LAS unsigned char* KS = F.lds; LAS unsigned char* VS = F.lds + 2 * ATT_BUF; LAS float* BIAS = (LAS float*)(F.lds + 4 * ATT_BUF); LAS float* KM = (LAS float*)(F.lds + 4 * ATT_BUF + 512); LAS int* OVF = (LAS int*)(F.lds + 4 * ATT_BUF + 512 + 2048);
    constexpr int ATT_RC = 208, ATT_RN = 280; LAS float* RT = (LAS float*)(F.lds + 4 * ATT_BUF + 512 + 2048 + 64);
    QState cq; cq.base = 0; cq.cnt = 8;
    constexpr int SLOT_ITEMS = 3;
    if (F.bid & 1) { __syncthreads(); run_items1(F, 1 + l, SLOT_ITEMS, cq); }
    for (int U = F.bid; U < NB * NH * NBLK; U += F.G) {
        refresh(F);
        const int lane = F.lane, wave = F.wave, qi = lane & 31, hh = lane >> 5;
        const int srow = F.tid >> 3, sch = F.tid & 7;
        const int c = U & 255, it = U >> 8, bh = c >> 1, set = c & 1;
        const int qblk = set ? (it == 0 ? 6 : (it == 1 ? 1 : (it == 2 ? 5 : 2))) : (it == 0 ? 7 : (it == 1 ? 0 : (it == 2 ? 4 : 3)));
        const int b = bh >> 3, h = bh & 7;
        const size_t qtok = (size_t)b * SEQ + qblk * 256 + 32 * wave + qi;
        bf16x8 qf[4];
#pragma unroll
        for (int s = 0; s < 4; ++s) qf[s] = *(const bf16x8*)(qb + qtok * AW + h * HD + 16 * s + 8 * hh);
        u32x4 kreg, vreg;
        { const size_t tok = (size_t)b * SEQ + qblk * 256 + srow; kreg = *(const u32x4*)(kb + tok * AW + h * HD + sch * 8); vreg = *(const u32x4*)(vb + tok * AW + h * HD + sch * 8); }
        const float km_v = kmean[((size_t)(b * NBLK + (F.tid >> 6))) * AW + h * HD + (F.tid & 63)] * (1.0f / 256.0f);
        const float bias_v = inp(KA, I_RELB)[t5_bucket(F.tid & 127) * NH + h] * LOG2E;
        __syncthreads();
        if (F.tid < 128) BIAS[F.tid] = bias_v;
        if (F.tid == 0) OVF[0] = 0;
        KM[F.tid] = km_v;
        *(LAS u32x4*)(KS + srow * 144 + sch * 16) = kreg; *(LAS u32x4*)(VS + srow * 144 + sch * 16) = vreg;
        { const size_t tok = (size_t)b * SEQ + qblk * 256 + 64 + srow; kreg = *(const u32x4*)(kb + tok * AW + h * HD + sch * 8); vreg = *(const u32x4*)(vb + tok * AW + h * HD + sch * 8); }
        __syncthreads();
        for (int e = F.tid; e < 4 * ATT_RN; e += 512) { const int cpy = e / ATT_RN, dist = ATT_RC - (e - cpy * ATT_RN + cpy); RT[e] = dist < 0 ? -1.0e30f : BIAS[dist > 127 ? 127 : dist]; }
        const float bfar = BIAS[127];
        unsigned selmask = 0;
        {
            float gsc[8];
#pragma unroll
            for (int j = 0; j < 8; ++j) { float a = 0.f;
#pragma unroll
                for (int s = 0; s < 4; ++s)
#pragma unroll
                    for (int e = 0; e < 8; ++e) a += __uint_as_float(((unsigned)(unsigned short)qf[s][e]) << 16) * KM[j * 64 + 16 * s + 8 * hh + e];
                a = half_sum(a); gsc[j] = (j < qblk) ? a : -INFINITY; }
#pragma unroll
            for (int rnd = 0; rnd < 3; ++rnd) { float bv = -INFINITY; int bi = -1;
#pragma unroll
                for (int j = 0; j < 8; ++j) if (gsc[j] > bv) { bv = gsc[j]; bi = j; }
                if (bi >= 0) selmask |= 1u << bi;
#pragma unroll
                for (int j = 0; j < 8; ++j) if (j == bi) gsc[j] = -INFINITY; }
        }
        f32x16 o[2]; float l_run;
        const int n_tiles = 4 * (qblk + 1);
        const int pv_q = (lane & 15) >> 2, pv_p = lane & 3, pv_c = (lane >> 4) & 1;
#define ATT_JB(T) ((T) < 4 ? qblk : qblk - 1 - (((T) - 4) >> 2))
#define ATT_KT(T) ((T) < 4 ? (T) : ((T) < 6 ? 7 - (T) : ((T) < 8 ? (T) - 6 : ((T) & 3))))
#define ATT_TOK(T) ((size_t)b * SEQ + ATT_JB(T) * 256 + ATT_KT(T) * 64 + srow)
#define ATT_PV_STEP(S_) do { const int ks_ = (S_) >> 1, r0_ = 8 * ((S_) & 1); u32x4 w_; \
            w_.x = pk2(st[ks_][r0_], st[ks_][r0_ + 1]); w_.y = pk2(st[ks_][r0_ + 2], st[ks_][r0_ + 3]); w_.z = pk2(st[ks_][r0_ + 4], st[ks_][r0_ + 5]); w_.w = pk2(st[ks_][r0_ + 6], st[ks_][r0_ + 7]); \
            const bf16x8 pfs_ = __builtin_bit_cast(bf16x8, w_); \
            _Pragma("unroll") for (int ds_ = 0; ds_ < 2; ++ds_) { const LAS unsigned char* base_ = VSb + (16 * (S_) + 4 * hh + pv_q) * 144 + (32 * ds_ + 16 * pv_c + 4 * pv_p) * 2; \
                const s16x4 lo_ = __builtin_amdgcn_ds_read_tr16_b64_v4i16((LAS s16x4*)base_), hi_ = __builtin_amdgcn_ds_read_tr16_b64_v4i16((LAS s16x4*)(base_ + 8 * 144)); \
                bf16x8 vf_; vf_[0] = lo_[0]; vf_[1] = lo_[1]; vf_[2] = lo_[2]; vf_[3] = lo_[3]; vf_[4] = hi_[0]; vf_[5] = hi_[1]; vf_[6] = hi_[2]; vf_[7] = hi_[3]; \
                o[ds_] = MFMA32(vf_, pfs_, o[ds_]); } } while (0)
#define ATT_BODY(NEAR_, RP_) do { \
            bf16x8 kf[8]; f32x16 st[2];                                                  \
            _Pragma("unroll") for (int ks_ = 0; ks_ < 2; ++ks_) _Pragma("unroll") for (int s_ = 0; s_ < 4; ++s_) kf[ks_ * 4 + s_] = *(const LAS bf16x8*)(KSb + (32 * ks_ + qi) * 144 + 32 * s_ + 16 * hh); \
            if (NEAR_) { \
                _Pragma("unroll") for (int ks_ = 0; ks_ < 2; ++ks_) _Pragma("unroll") for (int g_ = 0; g_ < 4; ++g_) { const f32x4 t_ = *(const LAS f32x4*)((RP_) + (32 * ks_ + 8 * g_) * 4); \
                    st[ks_][4 * g_] = t_[0]; st[ks_][4 * g_ + 1] = t_[1]; st[ks_][4 * g_ + 2] = t_[2]; st[ks_][4 * g_ + 3] = t_[3]; } \
                asm volatile("s_waitcnt lgkmcnt(0)" : "+v"(kf[0]), "+v"(kf[1]), "+v"(kf[2]), "+v"(kf[3]), "+v"(kf[4]), "+v"(kf[5]), "+v"(kf[6]), "+v"(kf[7]), "+v"(st[0]), "+v"(st[1]) :: "memory"); \
                _Pragma("unroll") for (int s_ = 0; s_ < 4; ++s_) _Pragma("unroll") for (int ks_ = 0; ks_ < 2; ++ks_) st[ks_] = MFMA32(kf[ks_ * 4 + s_], qf[s_], st[ks_]); \
            } else { \
                const float cbm = lane_sel ? bfar : -1.0e30f;                             \
                f32x16 negm; _Pragma("unroll") for (int i_ = 0; i_ < 16; ++i_) negm[i_] = cbm; \
                asm volatile("s_waitcnt lgkmcnt(0)" : "+v"(kf[0]), "+v"(kf[1]), "+v"(kf[2]), "+v"(kf[3]), "+v"(kf[4]), "+v"(kf[5]), "+v"(kf[6]), "+v"(kf[7]) :: "memory"); \
                _Pragma("unroll") for (int s_ = 0; s_ < 4; ++s_) _Pragma("unroll") for (int ks_ = 0; ks_ < 2; ++ks_) st[ks_] = MFMA32(kf[ks_ * 4 + s_], qf[s_], s_ == 0 ? negm : st[ks_]); } \
            s16x4 vlo[8], vhi[8];                                                        \
            _Pragma("unroll") for (int s_ = 0; s_ < 4; ++s_) _Pragma("unroll") for (int ds_ = 0; ds_ < 2; ++ds_) { const LAS unsigned char* base_ = VSb + (16 * s_ + 4 * hh + pv_q) * 144 + (32 * ds_ + 16 * pv_c + 4 * pv_p) * 2; \
                vlo[s_ * 2 + ds_] = __builtin_amdgcn_ds_read_tr16_b64_v4i16((LAS s16x4*)base_); vhi[s_ * 2 + ds_] = __builtin_amdgcn_ds_read_tr16_b64_v4i16((LAS s16x4*)(base_ + 8 * 144)); } \
            asm volatile("" ::: "memory"); \
            f32x2 ls2 = {0.f, 0.f}; \
            _Pragma("unroll") for (int s4_ = 0; s4_ < 4; ++s4_) { const int ks_ = s4_ >> 1, r0_ = 8 * (s4_ & 1);        \
                _Pragma("unroll") for (int j_ = 0; j_ < 8; j_ += 2) { const float p0_ = __builtin_amdgcn_exp2f(st[ks_][r0_ + j_]), p1_ = __builtin_amdgcn_exp2f(st[ks_][r0_ + j_ + 1]); st[ks_][r0_ + j_] = p0_; st[ks_][r0_ + j_ + 1] = p1_; ls2 += (f32x2){p0_, p1_}; } \
                if (s4_ == 0) asm volatile("s_waitcnt lgkmcnt(0)" : "+v"(vlo[0]), "+v"(vlo[1]), "+v"(vlo[2]), "+v"(vlo[3]), "+v"(vlo[4]), "+v"(vlo[5]), "+v"(vlo[6]), "+v"(vlo[7]), \
                         "+v"(vhi[0]), "+v"(vhi[1]), "+v"(vhi[2]), "+v"(vhi[3]), "+v"(vhi[4]), "+v"(vhi[5]), "+v"(vhi[6]), "+v"(vhi[7]) :: "memory"); \
                u32x4 w_; w_.x = pk2(st[ks_][r0_], st[ks_][r0_ + 1]); w_.y = pk2(st[ks_][r0_ + 2], st[ks_][r0_ + 3]); w_.z = pk2(st[ks_][r0_ + 4], st[ks_][r0_ + 5]); w_.w = pk2(st[ks_][r0_ + 6], st[ks_][r0_ + 7]); \
                const bf16x8 pfs_ = __builtin_bit_cast(bf16x8, w_); \
                _Pragma("unroll") for (int ds_ = 0; ds_ < 2; ++ds_) { const s16x4 lo_ = vlo[s4_ * 2 + ds_], hi_ = vhi[s4_ * 2 + ds_]; \
                    bf16x8 vf_; vf_[0] = lo_[0]; vf_[1] = lo_[1]; vf_[2] = lo_[2]; vf_[3] = lo_[3]; vf_[4] = hi_[0]; vf_[5] = hi_[1]; vf_[6] = hi_[2]; vf_[7] = hi_[3]; \
                    o[ds_] = MFMA32(vf_, pfs_, o[ds_]); } } \
            l_run += ls2[0] + ls2[1]; } while (0)
#define ATT_ADVANCE(T) do { if ((T) + 1 < n_tiles) { \
                LAS unsigned char* KSn = KS + (((T) + 1) & 1) * ATT_BUF; LAS unsigned char* VSn = VS + (((T) + 1) & 1) * ATT_BUF; \
                *(LAS u32x4*)(KSn + srow * 144 + sch * 16) = kreg; *(LAS u32x4*)(VSn + srow * 144 + sch * 16) = vreg; \
                if ((T) + 2 < n_tiles) { const int t2_ = (T) + 2; const size_t tok_ = ATT_TOK(t2_); \
                    kreg = *(const u32x4*)(kb + tok_ * AW + h * HD + sch * 8); vreg = *(const u32x4*)(vb + tok_ * AW + h * HD + sch * 8); } } \
            __syncthreads(); } while (0)
#define ATT_PRIME() \
            u32x4 kreg, vreg; \
            { const size_t tok = ATT_TOK(0); kreg = *(const u32x4*)(kb + tok * AW + h * HD + sch * 8); vreg = *(const u32x4*)(vb + tok * AW + h * HD + sch * 8); } \
            *(LAS u32x4*)(KS + srow * 144 + sch * 16) = kreg; *(LAS u32x4*)(VS + srow * 144 + sch * 16) = vreg; \
            { const size_t tok = ATT_TOK(1); kreg = *(const u32x4*)(kb + tok * AW + h * HD + sch * 8); vreg = *(const u32x4*)(vb + tok * AW + h * HD + sch * 8); } \
            __syncthreads();
        {
#pragma unroll
            for (int i = 0; i < 16; ++i) { o[0][i] = 0.f; o[1][i] = 0.f; }
            l_run = 0.f;
            __syncthreads();
            const int nA = n_tiles < 6 ? n_tiles : 6;
            int ti = 0;
            for (; ti < nA; ++ti) {
                LAS unsigned char* KSb = KS + (ti & 1) * ATT_BUF; LAS unsigned char* VSb = VS + (ti & 1) * ATT_BUF;
                const bool own = ti < 4; const int jb = ATT_JB(ti), kt = ATT_KT(ti);
                const bool lane_sel = own || (((selmask >> jb) & 1u) != 0u);
                const bool active = own ? (kt <= (wave >> 1)) : (__ballot(lane_sel) != 0ull);
                if (active) {
                    const int toff = (qblk - jb) * 256 + 32 * wave - 64 * kt;
                    if (toff - 63 < 113) {
                        const int y0 = ATT_RC - toff - qi + 4 * hh;
                        const LAS unsigned char* rp = (const LAS unsigned char*)RT + (lane_sel ? (y0 & 3) * (ATT_RN * 4) + (y0 & ~3) * 4 : (ATT_RC + 4) * 4);
                        ATT_BODY(1, rp);
                    } else { ATT_BODY(0, (const LAS unsigned char*)RT); }
                }
                ATT_ADVANCE(ti);
            }
            for (; ti < n_tiles; ++ti) {
                LAS unsigned char* KSb = KS + (ti & 1) * ATT_BUF; LAS unsigned char* VSb = VS + (ti & 1) * ATT_BUF;
                const int jb = ATT_JB(ti);
                const bool lane_sel = ((selmask >> jb) & 1u) != 0u;
                if (__ballot(lane_sel) != 0ull) ATT_BODY(0, (const LAS unsigned char*)RT);
                ATT_ADVANCE(ti);
            }
            { const float lchk = half_sum(l_run);
              if (__ballot(!(lchk > 5.5e-20f && lchk < 1.8e19f)) != 0ull && lane == 0) *(volatile LAS int*)OVF = 1; }
            __syncthreads();
        }
        if (*(volatile LAS int*)OVF != 0) {
            __syncthreads();
#pragma unroll
            for (int i = 0; i < 16; ++i) { o[0][i] = 0.f; o[1][i] = 0.f; }
            l_run = 0.f; float m_run = -INFINITY;
            ATT_PRIME()
            for (int ti = 0; ti < n_tiles; ++ti) {
                LAS unsigned char* KSb = KS + (ti & 1) * ATT_BUF; LAS unsigned char* VSb = VS + (ti & 1) * ATT_BUF;
                const bool own = ti < 4; const int jb = ATT_JB(ti), kt = ATT_KT(ti);
                const bool lane_sel = own || (((selmask >> jb) & 1u) != 0u);
                const bool active = own ? (kt <= (wave >> 1)) : (__ballot(lane_sel) != 0ull);
                if (active) {
                    f32x16 st[2]; float ls = 0.f;
#pragma unroll
                    for (int ks = 0; ks < 2; ++ks) {
#pragma unroll
                        for (int i = 0; i < 16; ++i) st[ks][i] = 0.f;
#pragma unroll
                        for (int s = 0; s < 4; ++s) { const bf16x8 a = *(const LAS bf16x8*)(KSb + (32 * ks + qi) * 144 + 32 * s + 16 * hh); st[ks] = MFMA32(a, qf[s], st[ks]); } }
                    const int dbase = (qblk - jb) * 256 + 32 * wave + qi - 64 * kt - 4 * hh;
                    float mx = -INFINITY;
#pragma unroll
                    for (int ks = 0; ks < 2; ++ks)
#pragma unroll
                        for (int i = 0; i < 16; ++i) { const int dist = dbase - (32 * ks + (i & 3) + 8 * (i >> 2));
                            const float bias = ((volatile LAS float*)BIAS)[dist < 0 ? 0 : (dist > 127 ? 127 : dist)];
                            const bool valid = lane_sel && (!own || dist >= 0);
                            const float sv = valid ? st[ks][i] + bias : -INFINITY; st[ks][i] = sv; mx = fmaxf(mx, sv); }
                    mx = half_max(mx);
                    const float m_new = fmaxf(m_run, mx);
                    const float m_use = (m_new > -1.0e37f) ? m_new : 0.f;
                    const float alpha = __builtin_amdgcn_exp2f(m_run - m_use); m_run = m_new;
#pragma unroll
                    for (int ks = 0; ks < 2; ++ks)
#pragma unroll
                        for (int i = 0; i < 16; ++i) { const float p = __builtin_amdgcn_exp2f(st[ks][i] - m_use); st[ks][i] = p; ls += p; }
                    l_run = l_run * alpha + ls;
#pragma unroll
                    for (int i = 0; i < 16; ++i) { o[0][i] *= alpha; o[1][i] *= alpha; }
#pragma unroll
                    for (int s4 = 0; s4 < 4; ++s4) ATT_PV_STEP(s4);
                }
                ATT_ADVANCE(ti);
            }
        }
#undef ATT_PV_STEP
#undef ATT_BODY
#undef ATT_ADVANCE
#undef ATT_PRIME
#undef ATT_JB
#undef ATT_KT
#undef ATT_TOK
        const float ltot = half_sum(l_run); const float inv = AZ8_SCALE / ltot;
#pragma unroll
        for (int ds = 0; ds < 2; ++ds)
#pragma unroll
            for (int g4 = 0; g4 < 4; ++g4)
                *(unsigned*)(att + qtok * D + h * HD + 32 * ds + 8 * g4 + 4 * hh) = pk4_fp8(o[ds][4 * g4] * inv, o[ds][4 * g4 + 1] * inv, o[ds][4 * g4 + 2] * inv, o[ds][4 * g4 + 3] * inv);
        if (!((F.bid & 1) && it == 3)) { __syncthreads(); run_items1(F, 1 + l, SLOT_ITEMS, cq); }
    }
    __syncthreads();
    run_items1(F, 1 + l, -1, cq);
    __syncthreads();
}

#define DUP_PHASE 0
#define REP(k) for (int _r = 0; _r < ((DUP_PHASE == (k)) ? 2 : 1); ++_r)
struct Args { const float* in[28]; float* out; unsigned char* ws; };
__global__ void __launch_bounds__(512, 2) fwd_kernel(Args args) {
    extern __shared__ __attribute__((aligned(16))) unsigned char lds_raw[];
    Frame F;
    F.lds = (LAS unsigned char*)lds_raw; F.MISC = (volatile LAS unsigned*)(F.lds + LDS_MISC);
    F.tid = threadIdx.x; F.lane = F.tid & 63; F.wave = __builtin_amdgcn_readfirstlane(F.tid >> 6); F.G = gridDim.x; F.bid = blockIdx.x;
    F.ws = (unsigned char*)(GAS unsigned char*)args.ws; F.ctl = (unsigned*)(GAS unsigned*)(args.ws + WS_CTL); F.out = (float*)(GAS float*)args.out;
    for (int u = F.tid; u < (LDS_BYTES - LDS_MISC) / 4; u += 512) F.MISC[u] = 0u;
    __syncthreads();
    XcdBarrier bar = xcd_barrier_post(F.ctl + CW_BAR, F.MISC + 0, F.tid == 0);
#define GRID_BAR() do { XcdBarrier _b = bar; asm volatile("" : "+s"(_b.bar), "+s"(_b.x)); refresh(F); xcd_barrier(_b, F.tid == 0); } while (0)

    REP(1) { for (int u = F.bid; u < 256; u += F.G) { if (u < 64) p_ssm_unit(F, u); else p_adaln_unit(F, u - 64); }
    p_transposes(F); __syncthreads(); }
    GRID_BAR();
    REP(2) phase_n0(F, 0);
    GRID_BAR();

    for (int l = 0; l < DEPTH; ++l) {
        REP(3) { unsigned char* ws = opaque_ws(F); constexpr float dq8 = 1.0f / (W8_SCALE * H8_SCALE);
          { PlainSched S; S.init(ws + WS_HF8, ws + WS_WIN + (size_t)l * INW * D, T, INW, D / 2, D / 2, F.G, F.bid);
            EpiG1 E{EpiQK{(bf16_t*)(ws + WS_Q), (bf16_t*)(ws + WS_K), (float*)(ws + WS_KMEAN) + (size_t)l * NB * NBLK * AW, dq8}, EpiVUG{(bf16_t*)(ws + WS_V), (bf16_t*)(ws + WS_UA), ws + WS_GATT, ws + WS_GSSM, dq8}};
            pg8::gemm_phase<EpiG1, PlainSched, false, true>(F.lds, S, E, D / 128, D / 2, D / 2, F.wave); } }
        GRID_BAR();
        REP(4) { unsigned char* ws = opaque_ws(F); GroupSched S; S.init(ws + WS_UA, (bf16_t*)(ws + WS_BE) + (size_t)l * NG * 256 * 512, 4, 1, UAK, 512, 256, F.G, F.bid);
          EpiState E{(float*)(ws + WS_E)};
          pg8::gemm_phase<EpiState, GroupSched, false>(F.lds, S, E, 512 / 64, UAK, 512, F.wave); }
        GRID_BAR();
        REP(5) { phase_scan(F, l);
        phase_attn(F, l); }
        GRID_BAR();
        REP(6) { unsigned char* ws = opaque_ws(F); GroupSched S; S.init(ws + WS_UA, (bf16_t*)(ws + WS_BSSM) + (size_t)l * NG * 512 * UAK, 4, 2, UAK, UAK, 512, F.G, F.bid);
          EpiSsmOut E{(bf16_t*)(ws + WS_Y)};
          pg8::gemm_phase<EpiSsmOut, GroupSched, false>(F.lds, S, E, UAK / 64, UAK, UAK, F.wave); }
        GRID_BAR();
        REP(7) { unsigned char* ws = opaque_ws(F); PlainSched S; S.init(ws + WS_Y, (bf16_t*)(ws + WS_WGLU) + (size_t)l * 1024 * SW, T, 1024, SW, SW, F.G, F.bid);
          EpiGlu E{ws + WS_AZ};
          pg8::gemm_phase<EpiGlu, PlainSched, false>(F.lds, S, E, SW / 64, SW, SW, F.wave); }
        GRID_BAR();
        REP(8) { unsigned char* ws = opaque_ws(F); PlainSched S; S.init(ws + WS_AZ, ws + WS_WCAT + (size_t)l * D * D, T, D, D / 2, D / 2, F.G, F.bid);
          EpiMerge E{ws + WS_MRG, ws + WS_GATT, ws + WS_GSSM};
          pg8::gemm_phase<EpiMerge, PlainSched, false, true>(F.lds, S, E, D / 128, D / 2, D / 2, F.wave); }
        GRID_BAR();
        REP(10) { unsigned char* ws = opaque_ws(F); PlainSched S; S.init(ws + WS_MRG, ws + WS_WOUT + (size_t)l * D * D, T, D, D / 2, D / 2, F.G, F.bid);
          EpiPlain E{(bf16_t*)(ws + WS_YMIX), D, 1.0f / (W8_SCALE * MRG8_SCALE)};
          pg8::gemm_phase<EpiPlain, PlainSched, false, true>(F.lds, S, E, D / 128, D / 2, D / 2, F.wave); }
        GRID_BAR();
        phase_n1(F, l);
        GRID_BAR();
        volatile LAS int* tbw = (volatile LAS int*)(F.MISC + 16); volatile LAS int* cntw = (volatile LAS int*)(F.MISC + 128);
        if (F.tid < 32) cntw[F.tid] = (int)__hip_atomic_load(F.ctl + CW_CNT + (l * NE + F.tid) * 64, __ATOMIC_RELAXED, __HIP_MEMORY_SCOPE_AGENT);
        __syncthreads();
        if (F.tid == 0) { int s = 0; for (int e = 0; e < NE; ++e) { tbw[e] = s; s += (cntw[e] + 255) >> 8; } tbw[32] = s; }
        __syncthreads();
        REP(12) { unsigned char* ws = opaque_ws(F); const kptr_t KA = kargs_now(); MoeSched S; S.A = (const char*)(ws + WS_H8); S.B = (const char*)(ws + WS_W1 + (size_t)l * NE * 2048 * D); S.lists = (const int2*)(ws + WS_LISTS);
          S.tb = (const LAS int*)(F.MISC + 16); S.cnt = (const LAS int*)(F.MISC + 128); S.nN = 8; S.GM = 4; S.G = F.G; S.c = F.bid; S.eB = (size_t)2048 * D; S.tB = (size_t)256 * D; S.tA = 0; S.gather = true; S.ul = (const LAS int*)(F.MISC + 192);
          refresh(F); __syncthreads(); S.build((volatile LAS int*)(F.MISC + 192), F.tid); __syncthreads();
          EpiSwiglu E{ws + WS_ACT, inp(KA, I_BEXPIN) + (size_t)l * NE * 2048};
          pg8::gemm_phase<EpiSwiglu, MoeSched, true, true>(F.lds, S, E, (D / 128) * PROBE_KREP, D / 2, D / 2, F.wave, PROBE_KREP > 1 ? D / 128 : 0); }
        GRID_BAR();
        REP(13) { unsigned char* ws = opaque_ws(F); const kptr_t KA = kargs_now(); MoeSched S; S.A = (const char*)(ws + WS_ACT); S.B = (const char*)(ws + WS_W2 + (size_t)l * NE * D * DFF); S.lists = (const int2*)(ws + WS_LISTS);
          S.tb = (const LAS int*)(F.MISC + 16); S.cnt = (const LAS int*)(F.MISC + 128); S.nN = 4; S.GM = 8; S.G = F.G; S.c = F.bid; S.eB = (size_t)D * DFF; S.tB = (size_t)256 * DFF; S.tA = (size_t)256 * DFF; S.gather = false; S.ul = (const LAS int*)(F.MISC + 192);
          refresh(F); __syncthreads(); S.build((volatile LAS int*)(F.MISC + 192), F.tid); __syncthreads();
          EpiMoeOut E{(bf16_t*)(ws + WS_YSLOT), inp(KA, I_BEXPOUT) + (size_t)l * NE * D, (const int2*)(ws + WS_LISTS)};
          pg8::gemm_phase<EpiMoeOut, MoeSched, false, true>(F.lds, S, E, DFF / 128, DFF / 2, DFF / 2, F.wave); }
        GRID_BAR();
        phase_n2(F, l);
        GRID_BAR();
    }
}

extern "C" void kernel_launch(void* const* d_in, const int* in_sizes, int n_in, void* d_out, int out_size, void* d_ws, size_t ws_size, hipStream_t stream) {
    static int grid = 0;
    if (grid == 0) {
        if (n_in != 28 || out_size != T * D || ws_size < WS_END) { fprintf(stderr, "kernel_launch: unexpected shapes (n_in %d, out %d, ws %zu < %zu)\n", n_in, out_size, ws_size, (size_t)WS_END); grid = -1; return; }
        int dev = 0, cus = 0, per_cu = 0;
        if (hipGetDevice(&dev) != hipSuccess || hipDeviceGetAttribute(&cus, hipDeviceAttributeMultiprocessorCount, dev) != hipSuccess) { grid = -1; return; }
        if (hipFuncSetAttribute((const void*)fwd_kernel, hipFuncAttributeMaxDynamicSharedMemorySize, LDS_BYTES) != hipSuccess) { fprintf(stderr, "kernel_launch: hipFuncSetAttribute failed\n"); grid = -1; return; }
        if (hipOccupancyMaxActiveBlocksPerMultiprocessor(&per_cu, (const void*)fwd_kernel, 512, LDS_BYTES) != hipSuccess || per_cu < 1) { fprintf(stderr, "kernel_launch: occupancy query says %d\n", per_cu); }
        (void)hipGetLastError();
        grid = cus;
    }
    if (grid < 0) return;
    if (hipMemsetAsync(d_ws, 0, WS_ZERO_BYTES, stream) != hipSuccess) { fprintf(stderr, "kernel_launch: memset failed\n"); return; }
    Args a{};
    for (int i = 0; i < 28; ++i) a.in[i] = (const float*)d_in[i];
    a.out = (float*)d_out; a.ws = (unsigned char*)d_ws;
    hipLaunchKernelGGL(fwd_kernel, dim3(grid), dim3(512), LDS_BYTES, stream, a);
    const hipError_t le = hipPeekAtLastError();
    if (le != hipSuccess) fprintf(stderr, "kernel_launch: launch failed: %s\n", hipGetErrorName(le));
}
```

```cpp
#include <hip/hip_runtime.h>
#include <cstdio>
#include <cstdint>

#define LAS __attribute__((address_space(3)))
#define GAS __attribute__((address_space(1)))
typedef unsigned short bf16_t;
typedef short bf16x8 __attribute__((ext_vector_type(8)));
typedef short s16x4 __attribute__((ext_vector_type(4)));
typedef float f32x4 __attribute__((ext_vector_type(4)));
typedef float f32x2 __attribute__((ext_vector_type(2)));
typedef float f32x16 __attribute__((ext_vector_type(16)));
typedef unsigned u32x4 __attribute__((ext_vector_type(4)));
typedef unsigned u32x2 __attribute__((ext_vector_type(2)));
typedef __bf16 bf16x2v __attribute__((ext_vector_type(2)));
typedef int i32x4 __attribute__((ext_vector_type(4)));
typedef int i32x8 __attribute__((ext_vector_type(8)));
#define DI __device__ __forceinline__

#define PROBE_KREP 1
constexpr int D = 1024, NB = 16, SEQ = 2048, T = NB * SEQ, DEPTH = 2;
constexpr int AW = 512, NH = 8, HD = 64, MBLK = 256, NBLK = SEQ / MBLK;
constexpr int SW = 512, SG = 16, NG = 32, SP = 64, CH = 32  , NCH = SEQ / CH  ;
constexpr int INW = 4096, NE = 32, TOPK = 4, DFF = 1024, NMOD = 6;
constexpr int UAK = 640;
constexpr int CROWS = NB * NCH;
constexpr float RMS_EPS = 1e-6f, LOG2E_C = 1.4426950408889634f;

constexpr size_t MiB = 1u << 20;
constexpr size_t WS_CTL = 0;
constexpr size_t WS_KMEAN = 1 * MiB;
constexpr size_t WS_ZERO_BYTES = 2 * MiB;
constexpr size_t WS_MOD = 2 * MiB;
constexpr size_t WS_L32 = 3 * MiB;
constexpr size_t WS_LISTS = 4 * MiB;
constexpr size_t WS_WIN = 12 * MiB;
constexpr size_t WS_WGLU = 28 * MiB;
constexpr size_t WS_WATT = 30 * MiB;
constexpr size_t WS_WSSM = 32 * MiB;
constexpr size_t WS_WOUT = 34 * MiB;
constexpr size_t WS_BSSM = 38 * MiB;
constexpr size_t WS_BE = 80 * MiB;
constexpr size_t WS_W1 = 98 * MiB;
constexpr size_t WS_W2 = 354 * MiB;
constexpr size_t WS_H = 482 * MiB;
constexpr size_t WS_Q = 546 * MiB, WS_K = 578 * MiB, WS_V = 610 * MiB;
constexpr size_t WS_H8 = WS_Q;
constexpr size_t WS_UA = 642 * MiB;
constexpr size_t WS_GATT = 684 * MiB, WS_GSSM = 748 * MiB;
constexpr size_t WS_ATT = 812 * MiB;
constexpr size_t WS_E = 844 * MiB;
constexpr size_t WS_Y = 860 * MiB;
constexpr size_t WS_Z = 892 * MiB;
constexpr size_t WS_MRG = 924 * MiB;
constexpr size_t WS_YMIX = 988 * MiB;
constexpr size_t WS_ACT = 1052 * MiB;
constexpr size_t WS_YSLOT = 1338 * MiB;
constexpr size_t WS_XB = 1594 * MiB;
constexpr size_t WS_HF8 = 1658 * MiB;
constexpr size_t WS_WIN8 = 1690 * MiB;
constexpr size_t WS_AZ = 1696 * MiB;
constexpr size_t WS_WCAT = 1760 * MiB;
constexpr size_t WS_END = 1764 * MiB;
constexpr int LIST_CAP = T;

constexpr int CW_BAR = 4096;
constexpr int CW_QUEUE = 8192;
constexpr int CW_CNT = 16384;

constexpr int RING_BYTES = 131072;
constexpr int LDS_MISC = RING_BYTES;
constexpr int LDS_BYTES = RING_BYTES + 4096;

DI unsigned pk2(float lo, float hi) { f32x2 v = {lo, hi}; bf16x2v r = __builtin_convertvector(v, bf16x2v); return __builtin_bit_cast(unsigned, r); }
DI float sat8(float x) { return __builtin_amdgcn_fmed3f(x, -448.0f, 448.0f); }
DI unsigned pk4_fp8(float a, float b, float c, float d) { int r = 0; r = __builtin_amdgcn_cvt_pk_fp8_f32(sat8(a), sat8(b), r, false); r = __builtin_amdgcn_cvt_pk_fp8_f32(sat8(c), sat8(d), r, true); return (unsigned)r; }
constexpr float W8_SCALE = 64.0f, H8_SCALE = 16.0f, ACT8_SCALE = 8.0f, GATE8_SCALE = 16.0f, YS8_SCALE = 64.0f, MRG8_SCALE = 32.0f, AZ8_SCALE = 8.0f;
DI void unpack8_fp8(const u32x2& w, f32x4& a, f32x4& b) { const f32x2 p0 = __builtin_amdgcn_cvt_pk_f32_fp8((int)w.x, false), p1 = __builtin_amdgcn_cvt_pk_f32_fp8((int)w.x, true), p2 = __builtin_amdgcn_cvt_pk_f32_fp8((int)w.y, false), p3 = __builtin_amdgcn_cvt_pk_f32_fp8((int)w.y, true);
    a = (f32x4){p0[0], p0[1], p1[0], p1[1]}; b = (f32x4){p2[0], p2[1], p3[0], p3[1]}; }
DI float bflo(unsigned w) { return __uint_as_float(w << 16); }
DI float bfhi(unsigned w) { return __uint_as_float(w & 0xffff0000u); }
DI float sigmoidf_(float x) { return __builtin_amdgcn_rcpf(1.0f + __builtin_amdgcn_exp2f(-1.4426950408889634f * x)); }
DI float gelu_tanh(float x) { const float u = 0.7978845608028654f * (x + 0.044715f * x * x * x); return x * __builtin_amdgcn_rcpf(1.0f + __builtin_amdgcn_exp2f(-2.8853900817779268f * u)); }
DI float shx(float v, int m, int lane) { return __int_as_float(__builtin_amdgcn_ds_bpermute((lane ^ m) << 2, __float_as_int(v))); }
DI int shxi(int v, int m, int lane) { return __builtin_amdgcn_ds_bpermute((lane ^ m) << 2, v); }
DI float half_max(float v) { const auto rr = __builtin_amdgcn_permlane32_swap(__float_as_uint(v), __float_as_uint(v), false, false); return fmaxf(__uint_as_float(rr[0]), __uint_as_float(rr[1])); }
DI float half_sum(float v) { const auto rr = __builtin_amdgcn_permlane32_swap(__float_as_uint(v), __float_as_uint(v), false, false); return __uint_as_float(rr[0]) + __uint_as_float(rr[1]); }
DI float wave_sum(float v, int lane) {
#pragma unroll
    for (int o = 1; o < 64; o <<= 1) v += shx(v, o, lane);
    return v;
}
#define LDS_WAIT() asm volatile("s_waitcnt lgkmcnt(0)" ::: "memory")
#define VM_WAIT() asm volatile("s_waitcnt vmcnt(0)" ::: "memory")

#define XB_TMO      128
#define XB_XCNT(j)  (256  + 64 * (j))
#define XB_XSUB(j)  (1280 + 64 * (j))
#define XB_XGEN(j)  (2304 + 64 * (j))
#define XB_TOP      3328
#define XB_TOPGEN   3392
#define XCD_BAR_WORDS 3456
#define XB_SPIN_CAP (1u << 18)
__device__ __forceinline__ unsigned xb_ld(unsigned* p)              { return __hip_atomic_load(p, __ATOMIC_RELAXED, __HIP_MEMORY_SCOPE_AGENT); }
__device__ __forceinline__ unsigned xb_add(unsigned* p, unsigned v) { return __hip_atomic_fetch_add(p, v, __ATOMIC_RELAXED, __HIP_MEMORY_SCOPE_AGENT); }
__device__ __forceinline__ unsigned xb_xcc_id() { return (unsigned)__builtin_amdgcn_s_getreg((3 << 11) | 20) & 0xFu; }
#define XB_SPIN(cond, bar) do { unsigned _sp = 0; while (cond) { __builtin_amdgcn_s_sleep(1); \
    if ((++_sp & 255u) == 0u) { if (xb_ld(&(bar)[XB_TMO])) break; if (_sp > XB_SPIN_CAP) { atomicAdd(&(bar)[XB_TMO], 1u); break; } } } } while (0)
struct XcdBarrier { unsigned* bar; unsigned x; volatile LAS unsigned* st; };
__device__ __forceinline__ XcdBarrier xcd_barrier_post(unsigned* bar, volatile LAS unsigned* st, bool t0) {
    XcdBarrier b; b.bar = bar; b.x = xb_xcc_id(); b.st = st;
    if (t0) (void)xb_add(&bar[XB_XCNT(b.x)], 1u);
    return b;
}
__device__ __forceinline__ void xcd_barrier_complete(unsigned* bar, unsigned x, unsigned& nloc, unsigned& nx) {
    const unsigned G = gridDim.x * gridDim.y * gridDim.z;
    unsigned sum, cnt, mine, sp = 0u;
    for (;;) {
        sum = 0u; cnt = 0u; mine = 0u;
#pragma unroll
        for (unsigned j = 0; j < 16; ++j) { const unsigned c = xb_ld(&bar[XB_XCNT(j)]); sum += c; cnt += (c > 0u) ? 1u : 0u; mine = (j == x) ? c : mine; }
        if (sum == G) break;
        __builtin_amdgcn_s_sleep(1);
        if ((++sp & 255u) == 0u) { if (xb_ld(&bar[XB_TMO])) break; if (sp > XB_SPIN_CAP) { atomicAdd(&bar[XB_TMO], 1u); break; } }
    }
    nloc = mine > 0u ? mine : 1u; nx = cnt > 0u ? cnt : 1u;
}
__device__ __forceinline__ void xcd_barrier(const XcdBarrier& b, bool t0) {
    asm volatile("s_waitcnt vmcnt(0)" ::: "memory");
    __syncthreads();
    if (t0) {
        unsigned* bar = b.bar;
        __builtin_amdgcn_s_waitcnt(0);
        unsigned nloc = b.st[0], nx = b.st[1];
        if (nloc == 0u) { xcd_barrier_complete(bar, b.x, nloc, nx); b.st[0] = nloc; b.st[1] = nx; }
        const unsigned old = xb_add(&bar[XB_XSUB(b.x)], 1u);
        const unsigned gen = old / nloc;
        if (old + 1u == (gen + 1u) * nloc) {
            __builtin_amdgcn_fence(__ATOMIC_RELEASE, "agent");
            asm volatile("s_waitcnt vmcnt(0)" ::: "memory");
            const unsigned og = xb_add(&bar[XB_TOP], 1u);
            const unsigned tg = og / nx;
            if (og + 1u == (tg + 1u) * nx) xb_add(&bar[XB_TOPGEN], 1u);
            else XB_SPIN(xb_ld(&bar[XB_TOPGEN]) == tg, bar);
            __builtin_amdgcn_fence(__ATOMIC_ACQUIRE, "agent");
            xb_add(&bar[XB_XGEN(b.x)], 1u);
            asm volatile("s_waitcnt vmcnt(0)" ::: "memory");
        } else {
            XB_SPIN(xb_ld(&bar[XB_XGEN(b.x)]) == gen, bar);
            __builtin_amdgcn_fence(__ATOMIC_ACQUIRE, "agent");
            asm volatile("s_waitcnt vmcnt(0)" ::: "memory");
        }
    }
    __syncthreads();
}

namespace pg8 {
constexpr int BM = 256, BK = 64, HALF = 128, HTB = HALF * BK * 2, STAGE_BYTES = 8 * HTB;
__host__ __device__ __forceinline__ int lds_byte(int r, int c) { const int st = (r >> 4) * 2 + (c >> 5), rr = r & 15, cc = c & 31, ob = rr * 64 + cc * 2; return st * 1024 + (ob ^ (((ob >> 9) & 1) << 5)); }
__host__ __device__ __forceinline__ void stage_rc(int b, int& R, int& C) { const int st = b / 1024, sb = b % 1024, swz = sb ^ (((sb >> 9) & 1) << 5); R = (st >> 1) * 16 + swz / 64; C = (st & 1) * 32 + (swz % 64) / 2; }
__host__ __device__ __forceinline__ int perm32(int rho) { const int n = rho >> 4, i = rho & 15; return 8 * (i >> 2) + 4 * n + (i & 3); }

struct Unit { int pm, pn, e, j, n, half; const char* A; const char* B; };
template <class...> struct voider { typedef void type; };
template <class E, class = void> struct MidT { static constexpr int v = -1; };
template <class E> struct MidT<E, typename voider<decltype(E::MID_T)>::type> { static constexpr int v = E::MID_T; };

template <class Epi, class Sched, bool GATHER, bool F8 = false>
__device__ __forceinline__ void gemm_phase(LAS unsigned char* lds, const Sched& S, const Epi& E, const int nt, const int lda, const int ldb, int wave_s, const int kmod = 0) {
    unsigned ones_ = ~0u; asm volatile("" : "+s"(wave_s), "+s"(ones_)); int tid = wave_s * 64 + (int)__builtin_amdgcn_mbcnt_hi(ones_, __builtin_amdgcn_mbcnt_lo(ones_, 0u)); asm volatile("" : "+v"(tid));
    const int wid = __builtin_amdgcn_readfirstlane(tid >> 6), lane = tid & 63, wr = wid >> 2, wc = wid & 3, fr = lane & 15, fq = lane >> 4;
    unsigned voffA, voffB;
    { int R, C; stage_rc(tid * 16, R, C); const int Rb = Epi::PERM ? ((R & ~31) + perm32(R & 31)) : R;
        voffA = (unsigned)(R * lda + C) * 2u; voffB = (unsigned)(Rb * ldb + C) * 2u; }
    const size_t qstepA = (size_t)64 * lda * 2, qstepB = (size_t)64 * ldb * 2;
    const size_t kstep = (size_t)(BK * 2);
    const size_t hstepA = (size_t)HALF * lda * 2, hstepB = (size_t)HALF * ldb * 2;
    const unsigned ldsw = (unsigned)wid * 1024u;
    const int aoff = lds_byte(wr * 64 + fr, fq * 8), boff = lds_byte(wc * 32 + fr, fq * 8);
#define PG8_SA(b, h) (((b) * 2 + (h)) * HTB)
#define PG8_SB(b, h) ((4 + (b) * 2 + (h)) * HTB)
#define PG8_STAGE(bufoff, gbase, voff) do { _Pragma("unroll") for (int _i = 0; _i < 2; ++_i) { unsigned _vo = (voff)[_i]; asm volatile("" : "+v"(_vo));     \
        __builtin_amdgcn_global_load_lds((const unsigned*)((const char*)(gbase) + _vo), (LAS unsigned*)(lds + (bufoff) + ldsw + _i * 8192), 16, 0, 0); } } while (0)
#define PG8_STAGE_U(bufoff, gbase, voff, qstep) do { _Pragma("unroll") for (int _i = 0; _i < 2; ++_i) { unsigned _vo = (voff); asm volatile("" : "+v"(_vo)); \
        __builtin_amdgcn_global_load_lds((const unsigned*)((const char*)(gbase) + _i * (qstep) + _vo), (LAS unsigned*)(lds + (bufoff) + ldsw + _i * 8192), 16, 0, 0); } } while (0)
#define PG8_STAGE_B(bufoff, gbase) PG8_STAGE_U(bufoff, gbase, voffB, qstepB)
#define PG8_STAGE_A(bufoff, gbase, h, GO) do { if constexpr (GATHER) { PG8_STAGE(bufoff, gbase, (GO)[h]); } else { PG8_STAGE_U(bufoff, (const char*)(gbase) + (h) * hstepA, voffA, qstepA); } } while (0)
#define PG8_LDA(dst, b, h) do { _Pragma("unroll") for (int m = 0; m < 4; ++m) _Pragma("unroll") for (int k = 0; k < 2; ++k) dst[m][k] = *(const LAS bf16x8*)(lds + PG8_SA(b, h) + aoff + m * 2048 + k * 1024); } while (0)
#define PG8_LDB(dst, b, h) do { _Pragma("unroll") for (int n = 0; n < 2; ++n) _Pragma("unroll") for (int k = 0; k < 2; ++k) dst[n][k] = *(const LAS bf16x8*)(lds + PG8_SB(b, h) + boff + n * 2048 + k * 1024); } while (0)
#define PG8_MMA(ai, bj, At, Bt) do { __builtin_amdgcn_s_setprio(1); if constexpr (F8) { _Pragma("unroll") for (int m = 0; m < 4; ++m) _Pragma("unroll") for (int n = 0; n < 2; ++n) { \
            const i32x8 a8 = __builtin_shufflevector(__builtin_bit_cast(i32x4, Bt[n][0]), __builtin_bit_cast(i32x4, Bt[n][1]), 0, 1, 2, 3, 4, 5, 6, 7); \
            const i32x8 b8 = __builtin_shufflevector(__builtin_bit_cast(i32x4, At[m][0]), __builtin_bit_cast(i32x4, At[m][1]), 0, 1, 2, 3, 4, 5, 6, 7); \
            acc[ai][bj][m][n] = __builtin_amdgcn_mfma_scale_f32_16x16x128_f8f6f4(a8, b8, acc[ai][bj][m][n], 0, 0, 0, 0, 0, 0); } } \
        else { _Pragma("unroll") for (int m = 0; m < 4; ++m) _Pragma("unroll") for (int n = 0; n < 2; ++n) _Pragma("unroll") for (int k = 0; k < 2; ++k) \
        acc[ai][bj][m][n] = __builtin_amdgcn_mfma_f32_16x16x32_bf16(Bt[n][k], At[m][k], acc[ai][bj][m][n], 0, 0, 0); } __builtin_amdgcn_s_setprio(0); } while (0)
#define PG8_WAIT_V(n) asm volatile("s_waitcnt vmcnt(" #n ")" ::: "memory")
#define PG8_WAIT_L(n) asm volatile("s_waitcnt lgkmcnt(" #n ")" ::: "memory")
#define PG8_BAR __builtin_amdgcn_s_barrier()
#define PG8_SCHED __builtin_amdgcn_sched_barrier(0)
    Unit cur, nxt; int ui = 0;
    if (!S.next(0, cur)) return;
    f32x4 acc[2][2][4][2];
#pragma unroll
    for (int a = 0; a < 2; ++a)
#pragma unroll
        for (int b = 0; b < 2; ++b)
#pragma unroll
            for (int m = 0; m < 4; ++m)
#pragma unroll
                for (int n = 0; n < 2; ++n) acc[a][b][m][n] = (f32x4){0.f, 0.f, 0.f, 0.f};
    bf16x8 At[4][2], B0[2][2], B1[2][2];
    const char* cA = cur.A; const char* cB = cur.B;
    unsigned gc[2][2], gn[2][2];
#define PG8_GOFF(dst, U) do { _Pragma("unroll") for (int _h = 0; _h < 2; ++_h) _Pragma("unroll") for (int _i = 0; _i < 2; ++_i) { int _R, _C; stage_rc(tid * 16 + _i * 8192, _R, _C); dst[_h][_i] = (unsigned)S.gather_row(U, _h * HALF + _R); } } while (0)
#define PG8_GCVT(dst) do { _Pragma("unroll") for (int _h = 0; _h < 2; ++_h) _Pragma("unroll") for (int _i = 0; _i < 2; ++_i) { int _R, _C; stage_rc(tid * 16 + _i * 8192, _R, _C); dst[_h][_i] = dst[_h][_i] * (unsigned)(lda * 2) + (unsigned)(_C * 2); } } while (0)
#pragma unroll
    for (int h = 0; h < 2; ++h)
#pragma unroll
        for (int i = 0; i < 2; ++i) { gc[h][i] = 0; gn[h][i] = 0; }
    if constexpr (GATHER) { PG8_GOFF(gc, cur); PG8_GCVT(gc); }
    PG8_STAGE_B(PG8_SB(0, 0), cB); PG8_STAGE_B(PG8_SB(0, 1), cB + hstepB); PG8_STAGE_A(PG8_SA(0, 0), cA, 0, gc); PG8_STAGE_A(PG8_SA(0, 1), cA, 1, gc);
    if (wr == 1) PG8_BAR;
    PG8_WAIT_V(2); PG8_BAR;
    PG8_STAGE_B(PG8_SB(1, 0), cB + kstep); PG8_STAGE_A(PG8_SA(1, 0), cA + kstep, 0, gc); PG8_STAGE_B(PG8_SB(1, 1), cB + hstepB + kstep);
    PG8_WAIT_V(6); PG8_BAR;
    for (;;) {
        const bool has_next = S.next(ui + 1, nxt);
        const char* nA = has_next ? nxt.A : cA; const char* nB = has_next ? nxt.B : cB;
        if constexpr (GATHER) { if (has_next) PG8_GOFF(gn, nxt); }
#pragma unroll 1
        for (int t = 0; t < nt; t += 2) {
            const bool last = (t == nt - 2);
            const int t1 = kmod ? (t + 1) % kmod : t + 1, t2 = kmod ? (t + 2) % kmod : t + 2;
            const char* a1 = cA + (size_t)t1 * kstep;
            const char* a2 = last ? nA : cA + (size_t)t2 * kstep; const char* b2 = last ? nB : cB + (size_t)t2 * kstep;
            const char* a3 = a2 + kstep; const char* b3 = b2 + kstep;
            if constexpr (MidT<Epi>::v >= 0) { if (t == MidT<Epi>::v) { unsigned o2 = ~0u; int w2 = wave_s; asm volatile("" : "+s"(w2), "+s"(o2)); int l2 = (int)__builtin_amdgcn_mbcnt_hi(o2, __builtin_amdgcn_mbcnt_lo(o2, 0u)); asm volatile("" : "+v"(l2));
                E.mid(acc, cur, w2 >> 2, w2 & 3, l2 & 15, l2 >> 4); } }
            PG8_LDB(B0, 0, 0); PG8_LDB(B1, 0, 1); PG8_SCHED; PG8_LDA(At, 0, 0); PG8_STAGE_A(PG8_SA(1, 1), a1, 1, gc);
            if constexpr (GATHER) { if (last && has_next) {
#pragma unroll
                for (int h = 0; h < 2; ++h)
#pragma unroll
                    for (int i = 0; i < 2; ++i) { int _R, _C; stage_rc(tid * 16 + i * 8192, _R, _C); gc[h][i] = gn[h][i] * (unsigned)(lda * 2) + (unsigned)(_C * 2); } } }
            PG8_WAIT_V(8); PG8_WAIT_L(0); PG8_BAR; if (cur.half != 2) { PG8_MMA(0, 0, At, B0); PG8_MMA(0, 1, At, B1); } PG8_BAR; PG8_SCHED;
            PG8_LDA(At, 0, 1); PG8_STAGE_B(PG8_SB(0, 0), b2); PG8_STAGE_B(PG8_SB(0, 1), b2 + hstepB); PG8_STAGE_A(PG8_SA(0, 0), a2, 0, gc);
            PG8_WAIT_V(8); PG8_WAIT_L(0); PG8_BAR; if (cur.half != 1) { PG8_MMA(1, 0, At, B0); PG8_MMA(1, 1, At, B1); } PG8_BAR; PG8_SCHED;
            PG8_LDB(B0, 1, 0); PG8_LDB(B1, 1, 1); PG8_SCHED; PG8_LDA(At, 1, 0); PG8_STAGE_A(PG8_SA(0, 1), a2, 1, gc);
            PG8_WAIT_V(8); PG8_WAIT_L(0); PG8_BAR; if (cur.half != 2) { PG8_MMA(0, 0, At, B0); PG8_MMA(0, 1, At, B1); } PG8_BAR; PG8_SCHED;
            PG8_LDA(At, 1, 1); PG8_STAGE_B(PG8_SB(1, 0), b3); PG8_STAGE_B(PG8_SB(1, 1), b3 + hstepB); PG8_STAGE_A(PG8_SA(1, 0), a3, 0, gc);
            PG8_WAIT_V(8); PG8_WAIT_L(0); PG8_BAR; if (cur.half != 1) { PG8_MMA(1, 0, At, B0); PG8_MMA(1, 1, At, B1); } PG8_BAR; PG8_SCHED;
        }
        if (wr == 0) PG8_BAR;
        { unsigned o2 = ~0u; int w2 = wave_s; asm volatile("" : "+s"(w2), "+s"(o2)); int l2 = (int)__builtin_amdgcn_mbcnt_hi(o2, __builtin_amdgcn_mbcnt_lo(o2, 0u)); asm volatile("" : "+v"(l2));
          E(acc, cur, w2 >> 2, w2 & 3, l2 & 15, l2 >> 4); }
        if (!has_next) break;
#pragma unroll
        for (int a = 0; a < 2; ++a)
#pragma unroll
            for (int b = 0; b < 2; ++b)
#pragma unroll
                for (int m = 0; m < 4; ++m)
#pragma unroll
                    for (int n = 0; n < 2; ++n) acc[a][b][m][n] = (f32x4){0.f, 0.f, 0.f, 0.f};
        cur = nxt; cA = nA; cB = nB; ++ui;
        if (wr == 1) PG8_BAR;
    }
    PG8_WAIT_V(0);
    PG8_BAR;
#undef PG8_SA
#undef PG8_SB
#undef PG8_STAGE
#undef PG8_STAGE_A
#undef PG8_STAGE_U
#undef PG8_STAGE_B
#undef PG8_GOFF
#undef PG8_GCVT
#undef PG8_LDA
#undef PG8_LDB
#undef PG8_MMA
#undef PG8_WAIT_V
#undef PG8_WAIT_L
#undef PG8_BAR
#undef PG8_SCHED
}
}
using pg8::Unit;

struct PlainSched {
    const char* A; const char* B; int nM, nN, nwg, G, c; size_t tA, tB;
    DI void init(const void* A_, const void* B_, int M, int N, int lda, int ldb, int G_, int c_) { A = (const char*)A_; B = (const char*)B_; nM = M / 256; nN = N / 256; nwg = nM * nN; G = G_; c = c_; tA = (size_t)256 * lda * 2; tB = (size_t)256 * ldb * 2; }
    DI bool next(int i, Unit& u) const {
        const long L = (long)i * G + c; if (L >= nwg) return false;
        int wgid = (int)L; { const int q = nwg / 8, r = nwg % 8, xcd = wgid % 8, off = wgid / 8; wgid = (xcd < r ? xcd * (q + 1) : r * (q + 1) + (xcd - r) * q) + off; }
        const int nig = 8 * nN, gid = wgid / nig, fm = gid * 8, gsz = (nM - fm) < 8 ? (nM - fm) : 8;
        u.pm = fm + ((wgid % nig) % gsz); u.pn = (wgid % nig) / gsz; u.e = 0; u.j = 0; u.n = 0; u.half = 0;
        u.A = A + (size_t)u.pm * tA; u.B = B + (size_t)u.pn * tB; return true;
    }
    DI int gather_row(const Unit&, int) const { return 0; }
};
struct GroupSched {
    const char* A; const char* B; int nM, nN, G, c; size_t gA, gB, tA, tB;
    DI void init(const void* A_, const void* B_, int nM_, int nN_, int lda, int ldb, int brows, int G_, int c_) { A = (const char*)A_; B = (const char*)B_; nM = nM_; nN = nN_; G = G_; c = c_;
        gA = (size_t)CROWS * lda * 2; gB = (size_t)brows * ldb * 2; tA = (size_t)256 * lda * 2; tB = (size_t)256 * ldb * 2; }
    DI bool next(int i, Unit& u) const {
        const int L = i * G + c; const int per = nM * nN; if (L >= NG * per) return false;
        const int g = L / per, r = L % per; u.e = g; u.pm = r % nM; u.pn = r / nM; u.j = 0; u.n = 0; u.half = 0;
        u.A = A + (size_t)g * gA + (size_t)u.pm * tA; u.B = B + (size_t)g * gB + (size_t)u.pn * tB; return true;
    }
    DI int gather_row(const Unit&, int) const { return 0; }
};
struct MoeSched {
    const char* A; const char* B; const int2* lists; const LAS int* tb; const LAS int* cnt;
    int nN, GM, G, c; size_t eB, tB, tA; bool gather;
    const LAS int* ul;
    DI void build(volatile LAS int* ulw, int tid) const {
        if (tid < 32) { const int L = tid * G + c; const int xcd = L & 7, q = L >> 3; const int sr = (q >> 5) * 8 + xcd, slot = q & 31;
            int mt = sr * GM + (slot % GM), nt_ = slot / GM; const int Mt = tb[32];
            bool ok = mt < Mt; int half = 0;
            const int rl = (Mt + 8 * GM - 1) / (8 * GM) - 1, m0 = rl * 8 * GM, Vm = Mt - m0, V = Vm * nN;
            if (tid == rl && 2 * V <= G) { ok = c < 2 * V; const int v = c >> 1; mt = m0 + (ok ? v % Vm : 0); nt_ = ok ? v / Vm : 0; half = 1 + (c & 1); }
            int e = 0; for (int k = 1; k < 32; ++k) e += (tb[k] <= mt) ? 1 : 0;
            ulw[tid * 8 + 0] = ok ? mt : -1; ulw[tid * 8 + 1] = e; ulw[tid * 8 + 2] = mt - tb[e]; ulw[tid * 8 + 3] = cnt[e]; ulw[tid * 8 + 4] = nt_; ulw[tid * 8 + 5] = half; }
    }
    DI bool next(int i, Unit& u) const {
        if (i >= 32) return false;
        const int mt = __builtin_amdgcn_readfirstlane(ul[i * 8 + 0]);
        if (mt < 0) return false;
        const int e = __builtin_amdgcn_readfirstlane(ul[i * 8 + 1]), nt_ = __builtin_amdgcn_readfirstlane(ul[i * 8 + 4]);
        u.e = e; u.pm = mt; u.pn = nt_; u.j = __builtin_amdgcn_readfirstlane(ul[i * 8 + 2]); u.n = __builtin_amdgcn_readfirstlane(ul[i * 8 + 3]); u.half = __builtin_amdgcn_readfirstlane(ul[i * 8 + 5]);
        u.A = gather ? A : A + (size_t)mt * tA;
        u.B = B + (size_t)e * eB + (size_t)nt_ * tB; return true;
    }
    DI int gather_row(const Unit& u, int r) const {
        const int li = u.j * 256 + r; const int n = u.n;
        const char* lb = (const char*)lists + (size_t)u.e * LIST_CAP * 8;
        int tok = 0; if (li < n) tok = *(const int*)(lb + (unsigned)li * 8u) >> 2;
        return tok;
    }
};

#define EPI_ROWS_BEGIN _Pragma("unroll") for (int ai = 0; ai < 2; ++ai) _Pragma("unroll") for (int m = 0; m < 4; ++m) { const int rt = 128 * ai + 64 * wr + 16 * m + fr;
#define EPI_ROWS_END }
DI u32x4 pack8(const f32x4& a, const f32x4& b) { u32x4 w; w.x = pk2(a[0], a[1]); w.y = pk2(a[2], a[3]); w.z = pk2(b[0], b[1]); w.w = pk2(b[2], b[3]); return w; }
DI void unpack8(const u32x4& w, f32x4& a, f32x4& b) { a[0] = bflo(w.x); a[1] = bfhi(w.x); a[2] = bflo(w.y); a[3] = bfhi(w.y); b[0] = bflo(w.z); b[1] = bfhi(w.z); b[2] = bflo(w.w); b[3] = bfhi(w.w); }

struct EpiScaled {
    static constexpr bool PERM = true;
    bf16_t* o; int ldc; float sc;
    DI void operator()(const f32x4 (&acc)[2][2][4][2], const Unit& u, int wr, int wc, int fr, int fq) const {
        EPI_ROWS_BEGIN
            const size_t row = (size_t)u.pm * 256 + rt;
#pragma unroll
            for (int bj = 0; bj < 2; ++bj) *(u32x4*)(o + row * ldc + u.pn * 256 + bj * 128 + 32 * wc + 8 * fq) = pack8(acc[ai][bj][m][0] * sc, acc[ai][bj][m][1] * sc);
        EPI_ROWS_END
    }
};
struct EpiK {
    static constexpr bool PERM = true;
    bf16_t* k; float* kmean; float sc;
    DI void operator()(const f32x4 (&acc)[2][2][4][2], const Unit& u, int wr, int wc, int fr, int fq) const {
        const int c0 = u.pn * 256 + 32 * wc + 8 * fq; const int ln = fq * 16 + fr;
        EPI_ROWS_BEGIN
            const size_t row = (size_t)u.pm * 256 + rt;
#pragma unroll
            for (int bj = 0; bj < 2; ++bj) *(u32x4*)(k + row * AW + c0 + bj * 128) = pack8(acc[ai][bj][m][0] * sc, acc[ai][bj][m][1] * sc);
        EPI_ROWS_END
#pragma unroll
        for (int bj = 0; bj < 2; ++bj)
#pragma unroll
            for (int n = 0; n < 2; ++n) { f32x4 s = (f32x4){0.f, 0.f, 0.f, 0.f};
#pragma unroll
                for (int ai = 0; ai < 2; ++ai)
#pragma unroll
                    for (int m = 0; m < 4; ++m) s += acc[ai][bj][m][n];
#pragma unroll
                for (int j = 0; j < 4; ++j) { float x = s[j]; x += shx(x, 1, ln); x += shx(x, 2, ln); x += shx(x, 4, ln); x += shx(x, 8, ln); s[j] = x; }
                if (fr == 0) { float* dst = kmean + (size_t)u.pm * AW + c0 + bj * 128 + 4 * n;
#pragma unroll
                    for (int j = 0; j < 4; ++j) unsafeAtomicAdd(dst + j, s[j] * sc); }
                asm volatile("" ::: "memory"); }
    }
};
struct EpiU {
    static constexpr bool PERM = true;
    bf16_t* ua; float sc;
    DI void operator()(const f32x4 (&acc)[2][2][4][2], const Unit& u, int wr, int wc, int fr, int fq) const {
        EPI_ROWS_BEGIN
            const int row = u.pm * 256 + rt;
#pragma unroll
            for (int bj = 0; bj < 2; ++bj) { const int ch = u.pn * 256 + bj * 128 + 32 * wc + 8 * fq; const int g = ch >> 4, c0 = ch & 15;
                *(u32x4*)(ua + ((size_t)g * CROWS + (row >> 5)) * UAK + (row & 31) * 16 + c0) = pack8(acc[ai][bj][m][0] * sc, acc[ai][bj][m][1] * sc); }
        EPI_ROWS_END
    }
};
struct EpiSig {
    static constexpr bool PERM = true;
    unsigned char* o; float sc;
    DI void operator()(const f32x4 (&acc)[2][2][4][2], const Unit& u, int wr, int wc, int fr, int fq) const {
        const float s2 = sc * GATE8_SCALE;
        EPI_ROWS_BEGIN
            const size_t row = (size_t)u.pm * 256 + rt;
#pragma unroll
            for (int bj = 0; bj < 2; ++bj) { const f32x4 a = acc[ai][bj][m][0] * s2, b = acc[ai][bj][m][1] * s2;
                u32x2 w; w.x = pk4_fp8(a[0], a[1], a[2], a[3]); w.y = pk4_fp8(b[0], b[1], b[2], b[3]);
                *(u32x2*)(o + row * D + u.pn * 256 + bj * 128 + 32 * wc + 8 * fq) = w; }
        EPI_ROWS_END
    }
};
struct EpiQK {
    static constexpr bool PERM = true;
    bf16_t *q, *k; float* kmean; float sc;
    DI void operator()(const f32x4 (&acc)[2][2][4][2], const Unit& u, int wr, int wc, int fr, int fq) const {
        Unit u2 = u; u2.pn = u.pn & 1;
        if (u.pn < 2) { EpiScaled E{q, AW, sc * (0.125f * LOG2E_C)}; E(acc, u2, wr, wc, fr, fq); }
        else { EpiK E{k, kmean, sc}; E(acc, u2, wr, wc, fr, fq); }
    }
};
struct EpiVUG {
    static constexpr bool PERM = true;
    bf16_t *v, *ua; unsigned char *ga, *gs; float sc;
    DI void operator()(const f32x4 (&acc)[2][2][4][2], const Unit& u, int wr, int wc, int fr, int fq) const {
        Unit u2 = u;
        if (u.pn < 2) { EpiScaled E{v, AW, sc}; E(acc, u2, wr, wc, fr, fq); }
        else if (u.pn < 4) { u2.pn = u.pn - 2; EpiU E{ua, sc}; E(acc, u2, wr, wc, fr, fq); }
        else { u2.pn = (u.pn - 4) & 3; EpiSig E{u.pn < 8 ? ga : gs, sc}; E(acc, u2, wr, wc, fr, fq); }
    }
};
struct EpiG1 {
    static constexpr bool PERM = true;
    EpiQK a; EpiVUG b;
    DI void operator()(const f32x4 (&acc)[2][2][4][2], const Unit& u, int wr, int wc, int fr, int fq) const {
        if (u.pn < 4) a(acc, u, wr, wc, fr, fq); else { Unit u2 = u; u2.pn = u.pn - 4; b(acc, u2, wr, wc, fr, fq); }
    }
};
struct EpiState {
    static constexpr bool PERM = false;
    float* e;
    DI void operator()(const f32x4 (&acc)[2][2][4][2], const Unit& u, int wr, int wc, int fr, int fq) const {
        EPI_ROWS_BEGIN
            float* rowp = e + ((size_t)u.e * CROWS + u.pm * 256 + rt) * 128 + 32 * wc + 4 * fq;
#pragma unroll
            for (int n = 0; n < 2; ++n) *(f32x4*)(rowp + 16 * n) = acc[ai][0][m][n];
        EPI_ROWS_END
    }
};
struct EpiSsmOut {
    static constexpr bool PERM = true;
    bf16_t* y;
    DI void operator()(const f32x4 (&acc)[2][2][4][2], const Unit& u, int wr, int wc, int fr, int fq) const {
        EPI_ROWS_BEGIN
            const int R = u.pm * 256 + rt;
#pragma unroll
            for (int bj = 0; bj < 2; ++bj) { const int col = u.pn * 256 + bj * 128 + 32 * wc + 8 * fq; const int j = col >> 4, c0 = col & 15;
                f32x4 a = acc[ai][bj][m][0], b = acc[ai][bj][m][1];
#pragma unroll
                for (int q = 0; q < 4; ++q) { a[q] = gelu_tanh(a[q]); b[q] = gelu_tanh(b[q]); }
                *(u32x4*)(y + ((size_t)R * 32 + j) * SW + u.e * 16 + c0) = pack8(a, b); }
        EPI_ROWS_END
    }
};
struct EpiGlu {
    static constexpr bool PERM = true;
    unsigned char* z;
    DI void operator()(const f32x4 (&acc)[2][2][4][2], const Unit& u, int wr, int wc, int fr, int fq) const {
        EPI_ROWS_BEGIN
            const size_t row = (size_t)u.pm * 256 + rt; f32x4 a = acc[ai][0][m][0], b = acc[ai][0][m][1]; const f32x4 ga = acc[ai][1][m][0], gb = acc[ai][1][m][1];
#pragma unroll
            for (int q = 0; q < 4; ++q) { a[q] *= AZ8_SCALE * sigmoidf_(ga[q]); b[q] *= AZ8_SCALE * sigmoidf_(gb[q]); }
            u32x2 w; w.x = pk4_fp8(a[0], a[1], a[2], a[3]); w.y = pk4_fp8(b[0], b[1], b[2], b[3]);
            *(u32x2*)(z + row * D + AW + u.pn * 128 + 32 * wc + 8 * fq) = w;
        EPI_ROWS_END
    }
};
struct EpiMerge {
    static constexpr bool PERM = true; static constexpr int MID_T = 4;
    unsigned char* mrg; const unsigned char* gatt; const unsigned char* gssm;
    DI void mid(f32x4 (&acc)[2][2][4][2], const Unit& u, int wr, int wc, int fr, int fq) const {
        constexpr float c2 = -1.4426950408889634f / GATE8_SCALE;
#pragma unroll
        for (int ai = 0; ai < 2; ++ai) {
            u32x2 ga[4][2], gs[4][2];
#pragma unroll
            for (int m = 0; m < 4; ++m) { const size_t row = (size_t)u.pm * 256 + 128 * ai + 64 * wr + 16 * m + fr;
#pragma unroll
                for (int bj = 0; bj < 2; ++bj) { const size_t off = row * D + u.pn * 256 + bj * 128 + 32 * wc + 8 * fq; ga[m][bj] = *(const u32x2*)(gatt + off); gs[m][bj] = *(const u32x2*)(gssm + off); } }
            asm volatile("" ::: "memory");
#pragma unroll
            for (int m = 0; m < 4; ++m)
#pragma unroll
                for (int bj = 0; bj < 2; ++bj) { f32x4 xa, xb, sa, sb; unpack8_fp8(ga[m][bj], xa, xb); unpack8_fp8(gs[m][bj], sa, sb);
#pragma unroll
                    for (int q = 0; q < 4; ++q) {
                        acc[ai][bj][m][0][q] *= (1.0f + __builtin_amdgcn_exp2f(sa[q] * c2)) * __builtin_amdgcn_rcpf(1.0f + __builtin_amdgcn_exp2f(xa[q] * c2));
                        acc[ai][bj][m][1][q] *= (1.0f + __builtin_amdgcn_exp2f(sb[q] * c2)) * __builtin_amdgcn_rcpf(1.0f + __builtin_amdgcn_exp2f(xb[q] * c2)); } }
            asm volatile("" ::: "memory"); }
    }
    DI void operator()(const f32x4 (&acc)[2][2][4][2], const Unit& u, int wr, int wc, int fr, int fq) const {
        constexpr float c2 = -1.4426950408889634f / GATE8_SCALE;
#pragma unroll
        for (int ai = 0; ai < 2; ++ai) {
            u32x2 gs[4][2];
#pragma unroll
            for (int m = 0; m < 4; ++m) { const size_t row = (size_t)u.pm * 256 + 128 * ai + 64 * wr + 16 * m + fr;
#pragma unroll
                for (int bj = 0; bj < 2; ++bj) gs[m][bj] = *(const u32x2*)(gssm + row * D + u.pn * 256 + bj * 128 + 32 * wc + 8 * fq); }
            asm volatile("" ::: "memory");
#pragma unroll
            for (int m = 0; m < 4; ++m) { const size_t row = (size_t)u.pm * 256 + 128 * ai + 64 * wr + 16 * m + fr;
#pragma unroll
                for (int bj = 0; bj < 2; ++bj) { const size_t off = row * D + u.pn * 256 + bj * 128 + 32 * wc + 8 * fq;
                    f32x4 sa, sb; unpack8_fp8(gs[m][bj], sa, sb);
#pragma unroll
                    for (int q = 0; q < 4; ++q) { sa[q] = (MRG8_SCALE / (W8_SCALE * AZ8_SCALE)) * __builtin_amdgcn_rcpf(1.0f + __builtin_amdgcn_exp2f(sa[q] * c2)); sb[q] = (MRG8_SCALE / (W8_SCALE * AZ8_SCALE)) * __builtin_amdgcn_rcpf(1.0f + __builtin_amdgcn_exp2f(sb[q] * c2)); }
                    const f32x4 va = acc[ai][bj][m][0] * sa, vb = acc[ai][bj][m][1] * sb;
                    u32x2 w; w.x = pk4_fp8(va[0], va[1], va[2], va[3]); w.y = pk4_fp8(vb[0], vb[1], vb[2], vb[3]);
                    *(u32x2*)(mrg + off) = w; } }
            asm volatile("" ::: "memory"); }
    }
};
template <bool ADD> struct EpiGate {
    static constexpr bool PERM = true;
    bf16_t* mrg; const bf16_t* gate;
    DI void operator()(const f32x4 (&acc)[2][2][4][2], const Unit& u, int wr, int wc, int fr, int fq) const {
        EPI_ROWS_BEGIN
            const size_t row = (size_t)u.pm * 256 + rt;
#pragma unroll
            for (int bj = 0; bj < 2; ++bj) { const size_t off = row * D + u.pn * 256 + bj * 128 + 32 * wc + 8 * fq;
                f32x4 ga, gb; unpack8(*(const u32x4*)(gate + off), ga, gb);
                f32x4 a = acc[ai][bj][m][0] * ga, b = acc[ai][bj][m][1] * gb;
                if (ADD) { f32x4 pa, pb; unpack8(*(const u32x4*)(mrg + off), pa, pb); a += pa; b += pb; }
                *(u32x4*)(mrg + off) = pack8(a, b); }
        EPI_ROWS_END
    }
};
struct EpiPlain {
    static constexpr bool PERM = true;
    bf16_t* o; int ldc; float sc;
    DI void operator()(const f32x4 (&acc)[2][2][4][2], const Unit& u, int wr, int wc, int fr, int fq) const {
        EPI_ROWS_BEGIN
            const size_t row = (size_t)u.pm * 256 + rt;
#pragma unroll
            for (int bj = 0; bj < 2; ++bj) *(u32x4*)(o + row * ldc + u.pn * 256 + bj * 128 + 32 * wc + 8 * fq) = pack8(acc[ai][bj][m][0] * sc, acc[ai][bj][m][1] * sc);
        EPI_ROWS_END
    }
};
struct EpiSwiglu {
    static constexpr bool PERM = true;
    unsigned char* act; const float* b1;
    DI void operator()(const f32x4 (&acc)[2][2][4][2], const Unit& u, int wr, int wc, int fr, int fq) const {
        int lrow = 64 * wr + fr; asm volatile("" : "+v"(lrow));
        const int cj = u.pn * 128 + 32 * wc + 8 * fq; const float* bb = b1 + (size_t)u.e * 2048 + cj;
        const f32x4 bg0 = *(const f32x4*)(bb), bg1 = *(const f32x4*)(bb + 4), bu0 = *(const f32x4*)(bb + 1024), bu1 = *(const f32x4*)(bb + 1028);
        unsigned char* abase = act + (size_t)u.pm * 256 * DFF;
        constexpr float dq = 1.0f / (W8_SCALE * H8_SCALE * PROBE_KREP);
#pragma unroll
        for (int ai = 0; ai < 2; ++ai) { if (u.half == 2 - ai) continue;
#pragma unroll
            for (int m = 0; m < 4; ++m) { const unsigned off = (unsigned)((128 * ai + 16 * m + lrow) * DFF + cj);
            f32x4 g0 = acc[ai][0][m][0] * dq + bg0, g1 = acc[ai][0][m][1] * dq + bg1, u0 = acc[ai][1][m][0] * dq + bu0, u1 = acc[ai][1][m][1] * dq + bu1;
            unsigned wv[2];
#pragma unroll
            for (int hv = 0; hv < 2; ++hv) { const f32x4 gq = hv ? g1 : g0, uq = hv ? u1 : u0; int r = 0;
#pragma unroll
                for (int q = 0; q < 4; q += 2) {
                    f32x2 g = {fminf(gq[q], 7.0f), fminf(gq[q + 1], 7.0f)};
                    const f32x2 up = {fminf(fmaxf(uq[q], -7.0f), 7.0f), fminf(fmaxf(uq[q + 1], -7.0f), 7.0f)};
                    f32x2 t = __builtin_elementwise_fma(up, (f32x2){ACT8_SCALE, ACT8_SCALE}, (f32x2){ACT8_SCALE, ACT8_SCALE}) * g;
                    const f32x2 a = g * (f32x2){-1.702f * 1.4426950408889634f, -1.702f * 1.4426950408889634f};
                    f32x2 e = {__builtin_amdgcn_exp2f(a[0]), __builtin_amdgcn_exp2f(a[1])}; e = e + (f32x2){1.0f, 1.0f};
                    const f32x2 rc = {__builtin_amdgcn_rcpf(e[0]), __builtin_amdgcn_rcpf(e[1])};
                    t = t * rc;
                    r = q ? __builtin_amdgcn_cvt_pk_fp8_f32(t[0], t[1], r, true) : __builtin_amdgcn_cvt_pk_fp8_f32(t[0], t[1], r, false); }
                wv[hv] = (unsigned)r; }
            u32x2 w; w.x = wv[0]; w.y = wv[1];
            *(u32x2*)(abase + off) = w;
            asm volatile("" ::: "memory"); } }
    }
};
struct EpiMoeOut {
    static constexpr bool PERM = true;
    bf16_t* yslot; const float* b2; const int2* lists;
    DI void operator()(const f32x4 (&acc)[2][2][4][2], const Unit& u, int wr, int wc, int fr, int fq) const {
        int lrow = 64 * wr + fr, cwl = 32 * wc + 8 * fq; asm volatile("" : "+v"(lrow), "+v"(cwl));
        const int n = u.n; const int cw = u.pn * 256 + cwl;
        const char* lb = (const char*)lists + (size_t)u.e * LIST_CAP * 8;
        f32x4 bv[2][2];
#pragma unroll
        for (int bj = 0; bj < 2; ++bj) { const float* bb = b2 + (size_t)u.e * D + cw + bj * 128; bv[bj][0] = *(const f32x4*)bb; bv[bj][1] = *(const f32x4*)(bb + 4); }
        constexpr float dq = 1.0f / (W8_SCALE * ACT8_SCALE);
#pragma unroll
        for (int ai = 0; ai < 2; ++ai) { if (u.half == 2 - ai) continue;
            int2 ent[4];
#pragma unroll
            for (int m = 0; m < 4; ++m) { const int li = u.j * 256 + 128 * ai + 16 * m + lrow; ent[m] = *(const int2*)(lb + (unsigned)(li < n ? li : 0) * 8u); }
#pragma unroll
            for (int m = 0; m < 4; ++m) { const int li = u.j * 256 + 128 * ai + 16 * m + lrow; const float gw = __int_as_float(ent[m].y);
                char* dst = (char*)yslot + ((unsigned)ent[m].x * (unsigned)D + (unsigned)cw);
                const float gs = gw * YS8_SCALE;
                const f32x4 a0 = (acc[ai][0][m][0] * dq + bv[0][0]) * gs, a1 = (acc[ai][0][m][1] * dq + bv[0][1]) * gs, b0 = (acc[ai][1][m][0] * dq + bv[1][0]) * gs, b1 = (acc[ai][1][m][1] * dq + bv[1][1]) * gs;
                u32x2 w0, w1; w0.x = pk4_fp8(a0[0], a0[1], a0[2], a0[3]); w0.y = pk4_fp8(a1[0], a1[1], a1[2], a1[3]); w1.x = pk4_fp8(b0[0], b0[1], b0[2], b0[3]); w1.y = pk4_fp8(b1[0], b1[1], b1[2], b1[3]);
                if (li < n) { *(u32x2*)dst = w0; *(u32x2*)(dst + 128) = w1; } }
            asm volatile("" ::: "memory"); }
    }
};

struct Frame {
    LAS unsigned char* lds; volatile LAS unsigned* MISC; unsigned* ctl;
    int tid, lane, wave, G, bid;
    float* out; unsigned char* ws;
};
enum { I_X = 0, I_C, I_RELB, I_WADA, I_BADA, I_GPREMIX, I_GPOSTMIX, I_GPREFFN, I_GPOSTFFN, I_WIN, I_ARE, I_AIM, I_LOGDT, I_BRE, I_BIM, I_CRE, I_CIM, I_DSKIP,
       I_WGLU, I_WSSMO, I_WATTO, I_WOUT, I_WROUTER, I_BROUTER, I_WEXPIN, I_BEXPIN, I_WEXPOUT, I_BEXPOUT };
typedef const GAS float* __attribute__((address_space(4))) * kptr_t;
DI kptr_t kargs_now() { kptr_t p = (kptr_t)__builtin_amdgcn_kernarg_segment_ptr(); asm volatile("" : "+s"(p)); return p; }
DI const float* inp(kptr_t k, int i) { return (const float*)k[i]; }
DI unsigned char* opaque_ws(Frame& F) { GAS unsigned char* w = (GAS unsigned char*)F.ws; asm volatile("" : "+s"(w)); return (unsigned char*)w; }
DI void refresh(Frame& F) { int w = F.wave; unsigned ones_ = ~0u; asm volatile("" : "+s"(w), "+s"(ones_)); int ln = (int)__builtin_amdgcn_mbcnt_hi(ones_, __builtin_amdgcn_mbcnt_lo(ones_, 0u)); asm volatile("" : "+v"(ln)); F.tid = w * 64 + ln; F.lane = ln; F.wave = w; int b = blockIdx.x; asm volatile("" : "+s"(b)); F.bid = b; }

struct TItem { const float* W; unsigned char* WT; int N, Kd, kofs, drow0, k0, n0; bool f8, valid; };
DI void item_load(const TItem& d, f32x4 (&v)[16], int lane) {
    const int r4 = lane >> 4, c4 = lane & 15;
    const char* base = (const char*)(d.W + (size_t)d.k0 * d.N + d.n0);
    unsigned voff = (unsigned)(r4 * d.N + 4 * c4) * 4u; asm volatile("" : "+v"(voff));
    const size_t rstep = (size_t)d.N * 16;
#pragma unroll
    for (int i = 0; i < 16; ++i) v[i] = __builtin_nontemporal_load((const f32x4*)(base + i * rstep + voff));
}
DI void item_scatter(const f32x4 (&v)[16], LAS float* scr, int lane) {
    const int r4 = lane >> 4, c4 = lane & 15;
#pragma unroll
    for (int i = 0; i < 16; ++i) { const int k = 4 * i + r4;
#pragma unroll
        for (int j = 0; j < 4; ++j) scr[(4 * c4 + j) * 64 + (k ^ (4 * (c4 ^ j)))] = v[i][j]; }
    LDS_WAIT(); asm volatile("" ::: "memory");
}
template <bool F8> DI void item_gather(const TItem& d, LAS float* scr, int lane) {
    if constexpr (F8) {
        const int nl = lane >> 2, kc = lane & 3;
        unsigned char* base = d.WT + (size_t)d.drow0 * d.Kd + d.kofs + d.k0;
        unsigned voff = (unsigned)(nl * d.Kd + 16 * kc); asm volatile("" : "+v"(voff));
        f32x4 x[16];
#pragma unroll
        for (int t = 0; t < 4; ++t) { const int n = nl + 16 * t; const int sw = 4 * (((n >> 2) & 15) ^ (n & 3));
#pragma unroll
            for (int q = 0; q < 4; ++q) { const int kq = 16 * kc + 4 * q; x[t * 4 + q] = *(const LAS f32x4*)(scr + n * 64 + (kq ^ sw)); } }
        asm volatile("s_waitcnt lgkmcnt(0)" : "+v"(x[0]), "+v"(x[1]), "+v"(x[2]), "+v"(x[3]), "+v"(x[4]), "+v"(x[5]), "+v"(x[6]), "+v"(x[7]),
                     "+v"(x[8]), "+v"(x[9]), "+v"(x[10]), "+v"(x[11]), "+v"(x[12]), "+v"(x[13]), "+v"(x[14]), "+v"(x[15]) :: "memory");
#pragma unroll
        for (int t = 0; t < 4; ++t) { u32x4 o;
#pragma unroll
            for (int q = 0; q < 4; ++q) { const f32x4 y = x[t * 4 + q]; o[q] = pk4_fp8(y[0] * W8_SCALE, y[1] * W8_SCALE, y[2] * W8_SCALE, y[3] * W8_SCALE); }
            *(u32x4*)(base + (size_t)t * 16 * d.Kd + voff) = o; }
    } else {
        const int nl = lane >> 3, kc = lane & 7;
        unsigned char* base = d.WT + ((size_t)d.drow0 * d.Kd + d.kofs + d.k0) * 2;
        unsigned voff = (unsigned)(nl * d.Kd + 8 * kc) * 2u; asm volatile("" : "+v"(voff));
        f32x4 x[16];
#pragma unroll
        for (int t = 0; t < 8; ++t) { const int n = nl + 8 * t; const int sw = 4 * (((n >> 2) & 15) ^ (n & 3));
#pragma unroll
            for (int q = 0; q < 2; ++q) { const int kq = 8 * kc + 4 * q; x[t * 2 + q] = *(const LAS f32x4*)(scr + n * 64 + (kq ^ sw)); } }
        asm volatile("s_waitcnt lgkmcnt(0)" : "+v"(x[0]), "+v"(x[1]), "+v"(x[2]), "+v"(x[3]), "+v"(x[4]), "+v"(x[5]), "+v"(x[6]), "+v"(x[7]),
                     "+v"(x[8]), "+v"(x[9]), "+v"(x[10]), "+v"(x[11]), "+v"(x[12]), "+v"(x[13]), "+v"(x[14]), "+v"(x[15]) :: "memory");
#pragma unroll
        for (int t = 0; t < 8; ++t) { u32x4 o;
#pragma unroll
            for (int q = 0; q < 2; ++q) { const f32x4 y = x[t * 2 + q]; o[2 * q] = pk2(y[0], y[1]); o[2 * q + 1] = pk2(y[2], y[3]); }
            *(u32x4*)(base + (size_t)t * 8 * d.Kd * 2 + voff) = o; }
    }
    LDS_WAIT(); asm volatile("" ::: "memory");
}
DI int imap(int n, int H) { return ((n % H) / 128) * 256 + (n / H) * 128 + (n % 128); }
constexpr int IT_IN = 16 * 64, IT_GLU = 8 * 16, IT_ATT = 8 * 16, IT_SSMO = 8 * 16, IT_OUT = 16 * 16, IT_W1 = 16 * 32, IT_W2 = 16 * 16;
constexpr int IT_LAYER = IT_IN + IT_GLU + IT_ATT + IT_SSMO + IT_OUT + NE * (IT_W1 + IT_W2);
constexpr int IT_SMALL = IT_IN + IT_GLU + IT_ATT + IT_SSMO + IT_OUT, IT_EXP = NE * (IT_W1 + IT_W2);
DI TItem decode_item(kptr_t KA, unsigned char* ws, int kind, int it) {
    TItem d; d.valid = it < (kind == 0 ? DEPTH * IT_SMALL : IT_EXP); if (!d.valid) it = 0;
    const int l = kind == 0 ? it / IT_SMALL : kind - 1; int r = kind == 0 ? it % IT_SMALL : IT_SMALL + it;
    const float* W; unsigned char* WT; int K, N, H = 0; bool f8 = false;
    int nsub = 0, Kd = 0, kofs = 0;
    if (r < IT_IN) { W = inp(KA, I_WIN) + (size_t)l * D * INW; K = D; N = INW;
        WT = ws + WS_WIN + (size_t)l * INW * D; f8 = true; }
    else if ((r -= IT_IN) < IT_GLU) { W = inp(KA, I_WGLU) + (size_t)l * SW * 1024; WT = ws + WS_WGLU + (size_t)l * 1024 * SW * 2; K = SW; N = 1024; H = 512; }
    else if ((r -= IT_GLU) < IT_ATT) { W = inp(KA, I_WATTO) + (size_t)l * AW * D; WT = ws + WS_WCAT + (size_t)l * D * D; K = AW; N = D; Kd = D; f8 = true; }
    else if ((r -= IT_ATT) < IT_SSMO) { W = inp(KA, I_WSSMO) + (size_t)l * SW * D; WT = ws + WS_WCAT + (size_t)l * D * D; K = SW; N = D; Kd = D; kofs = AW; f8 = true; }
    else if ((r -= IT_SSMO) < IT_OUT) { W = inp(KA, I_WOUT) + (size_t)l * D * D; WT = ws + WS_WOUT + (size_t)l * D * D; K = D; N = D; f8 = true; }
    else if ((r -= IT_OUT) < NE * IT_W1) { const int e = r / IT_W1; r %= IT_W1; W = inp(KA, I_WEXPIN) + ((size_t)l * NE + e) * D * 2048; WT = ws + WS_W1 + ((size_t)l * NE + e) * 2048 * D; K = D; N = 2048; H = 1024; f8 = true; }
    else { r -= NE * IT_W1; const int e = r / IT_W2; r %= IT_W2; W = inp(KA, I_WEXPOUT) + ((size_t)l * NE + e) * DFF * D; WT = ws + WS_W2 + ((size_t)l * NE + e) * D * DFF; K = DFF; N = D; f8 = true; }
    const int nblk = N / 64, kb = r / nblk, nb = r % nblk, n0 = nb * 64;
    d.W = W; d.WT = WT; d.N = N; d.Kd = Kd ? Kd : K; d.kofs = kofs; d.drow0 = (H ? imap(n0, H) : n0) - nsub; d.k0 = kb * 64; d.n0 = n0; d.f8 = f8;
    return d;
}
struct QState { int base, cnt; };
DI void run_items1(Frame& F, int kind, int quota, QState& q) {
    const kptr_t KA = kargs_now();
    LAS float* scr = (LAS float*)(F.lds + F.wave * 16384);
    unsigned* qctr = F.ctl + CW_QUEUE + 64 * kind;
#define RI_NEXT(D_) do { if (q.cnt == 8) { int b_ = 0; if (F.lane == 0) b_ = (int)__hip_atomic_fetch_add(qctr, 8u, __ATOMIC_RELAXED, __HIP_MEMORY_SCOPE_AGENT); q.base = __builtin_amdgcn_readfirstlane(b_); q.cnt = 0; } \
        D_ = decode_item(KA, F.ws, kind, q.base + q.cnt); ++q.cnt; } while (0)
    if (quota == 0) return;
    TItem d; RI_NEXT(d); if (!d.valid) return;
    f32x4 v[16]; item_load(d, v, F.lane);
    for (int n = 1; ; ++n) {
        item_scatter(v, scr, F.lane);
        TItem dn; dn.valid = false;
        if (quota < 0 || n < quota) { RI_NEXT(dn); if (dn.valid) item_load(dn, v, F.lane); }
        if (d.f8) item_gather<true>(d, scr, F.lane); else item_gather<false>(d, scr, F.lane);
        if (!dn.valid) break;
        d = dn;
    }
#undef RI_NEXT
}
DI void p_transposes(Frame& F) { refresh(F); QState q; q.base = 0; q.cnt = 8; run_items1(F, 0, -1, q); }
DI void p_adaln_unit(Frame& F, int unit) {
    refresh(F);
    const kptr_t KA = kargs_now();
    const int l = unit / 96, cb = unit % 96;
    LAS float* condT = (LAS float*)F.lds;
    LAS float* part = (LAS float*)(F.lds + 65536);
    for (int i = F.tid; i < NB * D; i += 512) { const int b = i / D, k = i % D; const float v = inp(KA, I_C)[i]; condT[k * 16 + b] = v / (1.0f + __expf(-v)); }
    __syncthreads();
    float acc[16];
#pragma unroll
    for (int b = 0; b < 16; ++b) acc[b] = 0.f;
    const float* wp = inp(KA, I_WADA) + (size_t)l * D * (NMOD * D) + cb * 64 + F.lane;
    for (int k0 = 0; k0 < 128; k0 += 32) {
        float wv[32];
#pragma unroll
        for (int kk = 0; kk < 32; ++kk) wv[kk] = wp[(size_t)(F.wave * 128 + k0 + kk) * (NMOD * D)];
#pragma unroll
        for (int kk = 0; kk < 32; ++kk) { const int k = F.wave * 128 + k0 + kk; const float w = wv[kk];
            const LAS f32x4* cp = (const LAS f32x4*)(condT + k * 16);
#pragma unroll
            for (int q = 0; q < 4; ++q) { const f32x4 cv = cp[q]; acc[4 * q] += cv[0] * w; acc[4 * q + 1] += cv[1] * w; acc[4 * q + 2] += cv[2] * w; acc[4 * q + 3] += cv[3] * w; } } }
#pragma unroll
    for (int b = 0; b < 16; ++b) part[(F.wave * 16 + b) * 64 + F.lane] = acc[b];
    __syncthreads();
    float* mod = (float*)(F.ws + WS_MOD);
    for (int o = F.tid; o < 1024; o += 512) { const int b = o >> 6, col = o & 63; float s = inp(KA, I_BADA)[(size_t)l * NMOD * D + cb * 64 + col];
#pragma unroll
        for (int w = 0; w < 8; ++w) s += part[(w * 16 + b) * 64 + col];
        mod[((size_t)l * NB + b) * (NMOD * D) + cb * 64 + col] = s; }
    __syncthreads();
}
DI double exp_d(double x) {
    const double kf = __builtin_rint(x * 1.4426950408889634); const double r = x - kf * 0.6931471805599453094;
    double t = 1.0, s = 1.0;
#pragma unroll
    for (int i = 1; i <= 16; ++i) { t *= r * (1.0 / (double)i); s += t; }
    const int k = (int)kf;
    return __builtin_ldexp(s, k);
}
DI void sincos_d(double a, double& sn, double& cs) {
    const double k = __builtin_rint(a * 0.15915494309189535); double r = __builtin_fma(-k, 6.283185307179586, a); r = __builtin_fma(-k, 2.4492935982947064e-16, r);
    const double x = r * 0.0625, x2 = x * x;
    double st = x, ct = 1.0, s = x, c = 1.0;
#pragma unroll
    for (int i = 1; i <= 9; ++i) { ct *= -x2 * (1.0 / (double)((2 * i - 1) * (2 * i))); c += ct; st *= -x2 * (1.0 / (double)((2 * i) * (2 * i + 1))); s += st; }
#pragma unroll
    for (int i = 0; i < 4; ++i) { const double s2 = 2.0 * s * c, c2 = c * c - s * s; s = s2; c = c2; }
    sn = s; cs = c;
}
DI void p_ssm_unit(Frame& F, int unit) {
    refresh(F);
    const kptr_t KA = kargs_now();
    const int l = unit / NG, g = unit % NG;
    LAS double* Lp = (LAS double*)F.lds;
    LAS float* Bb = (LAS float*)(F.lds + 33792);
    LAS float* Cc = (LAS float*)(F.lds + 50176);
    LAS float* Kt = (LAS float*)(F.lds + 66560);
    const int lg = l * NG + g;
    const double dt = exp_d((double)inp(KA, I_LOGDT)[lg]);
    for (int i = F.tid; i < 33 * 64; i += 512) { const int tau = i >> 6, p = i & 63;
        const double lre = fmin((double)inp(KA, I_ARE)[lg * SP + p], -1e-4), lim = (double)inp(KA, I_AIM)[lg * SP + p];
        const double mag = exp_d(lre * dt * (double)tau); double sn, cs; sincos_d(lim * dt * (double)tau, sn, cs);
        Lp[i * 2] = mag * cs; Lp[i * 2 + 1] = mag * sn; }
    __syncthreads();
    for (int i = F.tid; i < SP * SG; i += 512) { const int p = i >> 4, cc = i & 15;
        const double lre = fmin((double)inp(KA, I_ARE)[lg * SP + p], -1e-4), lim = (double)inp(KA, I_AIM)[lg * SP + p];
        const double nre = Lp[(64 + p) * 2] - 1.0, nim = Lp[(64 + p) * 2 + 1], den = lre * lre + lim * lim;
        const double zre = (nre * lre + nim * lim) / den, zim = (nim * lre - nre * lim) / den;
        const double br = (double)inp(KA, I_BRE)[((size_t)lg * SP + p) * SG + cc], bi = (double)inp(KA, I_BIM)[((size_t)lg * SP + p) * SG + cc];
        Bb[i * 2] = (float)(zre * br - zim * bi); Bb[i * 2 + 1] = (float)(zre * bi + zim * br); }
    for (int i = F.tid; i < SG * SP; i += 512) { Cc[i * 2] = inp(KA, I_CRE)[(size_t)lg * SG * SP + i]; Cc[i * 2 + 1] = inp(KA, I_CIM)[(size_t)lg * SG * SP + i]; }
    __syncthreads();
    LAS f32x2* Lf = (LAS f32x2*)(F.lds + 99328);
    for (int i = F.tid; i < 33 * 64; i += 512) Lf[i] = (f32x2){(float)Lp[i * 2], (float)Lp[i * 2 + 1]};
    __syncthreads();
    { const int pair = F.tid & 255, cc = pair >> 4, c2 = pair & 15, t0 = (F.tid >> 8) * 16; float acc[16];
#pragma unroll
      for (int q = 0; q < 16; ++q) acc[q] = 0.f;
      for (int p = 0; p < SP; ++p) { const float cr = Cc[(cc * 64 + p) * 2], ci = Cc[(cc * 64 + p) * 2 + 1], br = Bb[(p * 16 + c2) * 2], bi = Bb[(p * 16 + c2) * 2 + 1];
          const float gr = cr * br - ci * bi, gi = cr * bi + ci * br;
#pragma unroll
          for (int q = 0; q < 16; ++q) { const f32x2 lv = Lf[(t0 + q) * 64 + p]; acc[q] += gr * lv[0] - gi * lv[1]; } }
      if (t0 == 0 && cc == c2) acc[0] += inp(KA, I_DSKIP)[l * SW + g * 16 + cc];
#pragma unroll
      for (int q = 0; q < 16; ++q) Kt[((t0 + q) * 16 + cc) * 16 + c2] = acc[q]; }
    __syncthreads();
    bf16_t* bs = (bf16_t*)(F.ws + WS_BSSM) + (size_t)lg * 512 * UAK;
    for (int o = F.tid; o < 512 * (UAK / 8); o += 512) { const int n = o / (UAK / 8), k8 = (o % (UAK / 8)) * 8; const int j = n >> 4, cc = n & 15; float v[8];
        if (k8 < 512) { const int i = k8 >> 4, c0 = k8 & 15;
#pragma unroll
            for (int q = 0; q < 8; ++q) v[q] = (i <= j) ? Kt[((j - i) * 16 + cc) * 16 + c0 + q] : 0.f; }
        else { const int p0 = (k8 - 512) >> 1;
#pragma unroll
            for (int q = 0; q < 4; ++q) { const int p = p0 + q; const float cr = Cc[(cc * 64 + p) * 2], ci = Cc[(cc * 64 + p) * 2 + 1]; const f32x2 lv = Lf[(j + 1) * 64 + p];
                v[2 * q] = cr * lv[0] - ci * lv[1]; v[2 * q + 1] = -(cr * lv[1] + ci * lv[0]); } }
        u32x4 w; w.x = pk2(v[0], v[1]); w.y = pk2(v[2], v[3]); w.z = pk2(v[4], v[5]); w.w = pk2(v[6], v[7]);
        *(u32x4*)(bs + (size_t)n * UAK + k8) = w; }
    bf16_t* be = (bf16_t*)(F.ws + WS_BE) + (size_t)lg * 256 * 512;
    for (int o = F.tid; o < 256 * 64; o += 512) { const int n = o >> 6, k8 = (o & 63) * 8; float v[8];
        if (n < 128) { const int p = n >> 1, ri = n & 1, i = k8 >> 4, c0 = k8 & 15; const f32x2 lv = Lf[(31 - i) * 64 + p]; const float lr = lv[0], li = lv[1];
#pragma unroll
            for (int q = 0; q < 8; ++q) { const float br = Bb[(p * 16 + c0 + q) * 2], bi = Bb[(p * 16 + c0 + q) * 2 + 1]; v[q] = ri ? (lr * bi + li * br) : (lr * br - li * bi); } }
        else {
#pragma unroll
            for (int q = 0; q < 8; ++q) v[q] = 0.f; }
        u32x4 w; w.x = pk2(v[0], v[1]); w.y = pk2(v[2], v[3]); w.z = pk2(v[4], v[5]); w.w = pk2(v[6], v[7]);
        *(u32x4*)(be + (size_t)n * 512 + k8) = w; }
    float* l32 = (float*)(F.ws + WS_L32) + (size_t)lg * SP * 2;
    if (F.tid < SP) { l32[F.tid * 2] = (float)Lp[(32 * 64 + F.tid) * 2]; l32[F.tid * 2 + 1] = (float)Lp[(32 * 64 + F.tid) * 2 + 1]; }
    __syncthreads();
}

DI void load_row_f32(const float* p, int lane, f32x4 (&v)[4]) {
#pragma unroll
    for (int j = 0; j < 4; ++j) v[j] = *(const f32x4*)(p + 4 * lane + 256 * j);
}
DI float wave_sum_dpp(float v) {
#define DPP_ADD_(ctrl, rmask, bc) v += __int_as_float(__builtin_amdgcn_update_dpp(0, __float_as_int(v), ctrl, rmask, 0xf, bc))
    DPP_ADD_(0x111, 0xf, true); DPP_ADD_(0x112, 0xf, true); DPP_ADD_(0x114, 0xf, true); DPP_ADD_(0x118, 0xf, true);
    DPP_ADD_(0x142, 0xa, false); DPP_ADD_(0x143, 0xc, false);
#undef DPP_ADD_
    return __int_as_float(__builtin_amdgcn_readlane(__float_as_int(v), 63)); }
DI float sumsq(const f32x4 (&v)[4], int lane) { float s = 0.f; (void)lane;
#pragma unroll
    for (int j = 0; j < 4; ++j) s += (v[j][0] * v[j][0] + v[j][1] * v[j][1]) + (v[j][2] * v[j][2] + v[j][3] * v[j][3]);
    return wave_sum_dpp(s); }
struct ModP { f32x4 g[4], sc[4], sh[4]; };
DI void load_modp(ModP& m, const float* g, const float* sc, const float* sh, int lane) {
#pragma unroll
    for (int j = 0; j < 4; ++j) { const int o = 4 * lane + 256 * j; m.g[j] = *(const f32x4*)(g + o); m.sc[j] = *(const f32x4*)(sc + o); m.sh[j] = *(const f32x4*)(sh + o); } }
DI void mod_norm_store(const f32x4 (&xv)[4], float rstd, const ModP& m, bf16_t* orow, unsigned char* orow8, int lane, f32x4 (&hv)[4]) {
#pragma unroll
    for (int j = 0; j < 4; ++j) { const int o = 4 * lane + 256 * j; const f32x4 gv = m.g[j], scv = m.sc[j], shv = m.sh[j];
        hv[j] = xv[j] * rstd * gv * (1.0f + scv) + shv;
        u32x2 w; w.x = pk2(hv[j][0], hv[j][1]); w.y = pk2(hv[j][2], hv[j][3]); *(u32x2*)(orow + o) = w;
        *(unsigned*)(orow8 + o) = pk4_fp8(hv[j][0] * H8_SCALE, hv[j][1] * H8_SCALE, hv[j][2] * H8_SCALE, hv[j][3] * H8_SCALE); }
}
DI void mod_norm_store8(const f32x4 (&xv)[4], float rstd, const ModP& m, unsigned char* orow, int lane, f32x4 (&hv)[4]) {
#pragma unroll
    for (int j = 0; j < 4; ++j) { const int o = 4 * lane + 256 * j; const f32x4 gv = m.g[j], scv = m.sc[j], shv = m.sh[j];
        hv[j] = xv[j] * rstd * gv * (1.0f + scv) + shv;
        *(unsigned*)(orow + o) = pk4_fp8(hv[j][0] * H8_SCALE, hv[j][1] * H8_SCALE, hv[j][2] * H8_SCALE, hv[j][3] * H8_SCALE); }
}
DI void phase_n0(Frame& F, int l) {
    refresh(F);
    const kptr_t KA = kargs_now();
    const float* mod = (const float*)(F.ws + WS_MOD) + (size_t)l * NB * NMOD * D;
    const int gw = F.bid * 8 + F.wave, NGW = F.G * 8;
    for (int r0 = gw * 2; r0 < T; r0 += NGW * 2) {
        f32x4 xa[2][4], hv[4];
#pragma unroll
        for (int rr = 0; rr < 2; ++rr) load_row_f32(inp(KA, I_X) + (size_t)(r0 + rr) * D, F.lane, xa[rr]);
        ModP mp; { const int b = r0 / SEQ; load_modp(mp, inp(KA, I_GPREMIX) + l * D, mod + (size_t)b * NMOD * D + 1 * D, mod + (size_t)b * NMOD * D + 0 * D, F.lane); }
#pragma unroll
        for (int rr = 0; rr < 2; ++rr) { const int r = r0 + rr; const float rstd = rsqrtf(sumsq(xa[rr], F.lane) * (1.0f / D) + RMS_EPS);
            mod_norm_store8(xa[rr], rstd, mp, F.ws + WS_HF8 + (size_t)r * D, F.lane, hv); }
    }
}
DI void load_row_bf16(const bf16_t* p, int lane, f32x4 (&v)[4]) {
#pragma unroll
    for (int j = 0; j < 4; ++j) { const u32x2 w = *(const u32x2*)(p + 4 * lane + 256 * j); v[j][0] = bflo(w.x); v[j][1] = bfhi(w.x); v[j][2] = bflo(w.y); v[j][3] = bfhi(w.y); }
}
DI void phase_n1(Frame& F, int l) {
    refresh(F);
    const kptr_t KA = kargs_now();
    constexpr int RP = 2064;
    LAS unsigned char* WTl = F.lds; LAS unsigned char* HTl = F.lds + 32 * RP; LAS float* PS = (LAS float*)(F.lds + 48 * RP);
    volatile LAS int* hist = (volatile LAS int*)(F.MISC + 64); volatile LAS int* basew = (volatile LAS int*)(F.MISC + 96);
    const float* wr_ = inp(KA, I_WROUTER) + (size_t)l * D * NE;
    for (int idx = F.tid; idx < D * 8; idx += 512) { const int k = idx >> 3, c = idx & 7; const f32x4 v = *(const f32x4*)(wr_ + k * 32 + 4 * c);
#pragma unroll
        for (int q = 0; q < 4; ++q) *(LAS bf16_t*)(WTl + (4 * c + q) * RP + k * 2) = (bf16_t)(pk2(v[q], 0.f) & 0xffffu); }
    __syncthreads();
    const float* mod = (const float*)(F.ws + WS_MOD) + (size_t)l * NB * NMOD * D;
    const bf16_t* ymix = (const bf16_t*)(F.ws + WS_YMIX); unsigned char* h8 = F.ws + WS_H8;
    const float* xin = inp(KA, I_X); bf16_t* xb = (bf16_t*)(F.ws + WS_XB);
    int2* lists = (int2*)(F.ws + WS_LISTS); unsigned* cntg = F.ctl + CW_CNT + l * NE * 64;
    const float brt = inp(KA, I_BROUTER)[l * NE + (F.lane & 31)];
    for (int blk = F.bid; blk < T / 16; blk += F.G) {
        if (F.tid < 32) hist[F.tid] = 0;
        f32x4 hv[2][4], yv2[2][4], xv2[2][4];
#pragma unroll
        for (int rr = 0; rr < 2; ++rr) { const int r = blk * 16 + F.wave * 2 + rr;
            load_row_bf16(ymix + (size_t)r * D, F.lane, yv2[rr]); if (l == 0) load_row_f32(xin + (size_t)r * D, F.lane, xv2[rr]); else load_row_bf16(xb + (size_t)r * D, F.lane, xv2[rr]); }
        const float* mb = mod + (size_t)((blk * 16) / SEQ) * NMOD * D;
        f32x4 gpm[4], gtm[4]; ModP mp;
#pragma unroll
        for (int j = 0; j < 4; ++j) { const int o = 4 * F.lane + 256 * j; gpm[j] = *(const f32x4*)(inp(KA, I_GPOSTMIX) + l * D + o); gtm[j] = *(const f32x4*)(mb + 2 * D + o); }
        load_modp(mp, inp(KA, I_GPREFFN) + l * D, mb + 4 * D, mb + 3 * D, F.lane);
#pragma unroll
        for (int rr = 0; rr < 2; ++rr) { const int r = blk * 16 + F.wave * 2 + rr;
            f32x4 (&yv)[4] = yv2[rr]; f32x4 (&xv)[4] = xv2[rr];
            const float rstd_y = rsqrtf(sumsq(yv, F.lane) * (1.0f / D) + RMS_EPS);
#pragma unroll
            for (int j = 0; j < 4; ++j) { const int o = 4 * F.lane + 256 * j; const f32x4 gv = gpm[j], gt = gtm[j];
                xv[j] = xv[j] + gt * (yv[j] * rstd_y * gv); u32x2 w; w.x = pk2(xv[j][0], xv[j][1]); w.y = pk2(xv[j][2], xv[j][3]); *(u32x2*)(xb + (size_t)r * D + o) = w; }
            const float rstd_x = rsqrtf(sumsq(xv, F.lane) * (1.0f / D) + RMS_EPS);
            mod_norm_store8(xv, rstd_x, mp, h8 + (size_t)r * D, F.lane, hv[rr]); }
#pragma unroll
        for (int rr = 0; rr < 2; ++rr)
#pragma unroll
            for (int j = 0; j < 4; ++j) { u32x2 w; w.x = pk2(hv[rr][j][0], hv[rr][j][1]); w.y = pk2(hv[rr][j][2], hv[rr][j][3]); *(LAS u32x2*)(HTl + (F.wave * 2 + rr) * RP + (4 * F.lane + 256 * j) * 2) = w; }
        __syncthreads();
        { const int r16 = F.lane & 15, kg = F.lane >> 4; f32x4 c0 = (f32x4){0.f, 0.f, 0.f, 0.f}, c1 = c0;
#pragma unroll
          for (int st = 0; st < 4; ++st) { const int kb2 = (128 * F.wave + 32 * st + 8 * kg) * 2;
              const bf16x8 af = *(const LAS bf16x8*)(HTl + r16 * RP + kb2), b0 = *(const LAS bf16x8*)(WTl + r16 * RP + kb2), b1 = *(const LAS bf16x8*)(WTl + (16 + r16) * RP + kb2);
              c0 = __builtin_amdgcn_mfma_f32_16x16x32_bf16(af, b0, c0, 0, 0, 0); c1 = __builtin_amdgcn_mfma_f32_16x16x32_bf16(af, b1, c1, 0, 0, 0); }
#pragma unroll
          for (int i = 0; i < 4; ++i) { PS[(F.wave * 16 + 4 * kg + i) * 32 + r16] = c0[i]; PS[(F.wave * 16 + 4 * kg + i) * 32 + 16 + r16] = c1[i]; } }
        __syncthreads();
        float lgs = 0.f;
#pragma unroll
        for (int w = 0; w < 8; ++w) lgs += PS[(w * 16 + F.wave * 2 + (F.lane >> 5)) * 32 + (F.lane & 31)];
        float lg = lgs + brt; const int e_me = F.lane & 31;
        float topv[4]; int tope[4];
#pragma unroll
        for (int k = 0; k < 4; ++k) { float mv = lg; int mi = e_me;
#pragma unroll
            for (int st = 0; st < 4; ++st) {
                float ov; int oi;
                if (st == 0) { ov = __int_as_float(__builtin_amdgcn_update_dpp(0, __float_as_int(mv), 0x121, 0xf, 0xf, false)); oi = __builtin_amdgcn_update_dpp(0, mi, 0x121, 0xf, 0xf, false); }
                else if (st == 1) { ov = __int_as_float(__builtin_amdgcn_update_dpp(0, __float_as_int(mv), 0x122, 0xf, 0xf, false)); oi = __builtin_amdgcn_update_dpp(0, mi, 0x122, 0xf, 0xf, false); }
                else if (st == 2) { ov = __int_as_float(__builtin_amdgcn_update_dpp(0, __float_as_int(mv), 0x124, 0xf, 0xf, false)); oi = __builtin_amdgcn_update_dpp(0, mi, 0x124, 0xf, 0xf, false); }
                else { ov = __int_as_float(__builtin_amdgcn_update_dpp(0, __float_as_int(mv), 0x128, 0xf, 0xf, false)); oi = __builtin_amdgcn_update_dpp(0, mi, 0x128, 0xf, 0xf, false); }
                if (ov > mv || (ov == mv && oi < mi)) { mv = ov; mi = oi; } }
            { const float ov = shx(mv, 16, F.lane); const int oi = shxi(mi, 16, F.lane); if (ov > mv || (ov == mv && oi < mi)) { mv = ov; mi = oi; } }
            topv[k] = mv; tope[k] = mi; if (e_me == mi) lg = -INFINITY; }
        const float e1 = __expf(topv[1] - topv[0]), e2 = __expf(topv[2] - topv[0]), e3 = __expf(topv[3] - topv[0]); const float inv = 1.0f / (1.0f + e1 + e2 + e3);
        const int ks = F.lane & 31; const bool slot = ks < 4;
        const int my_e = ks == 0 ? tope[0] : (ks == 1 ? tope[1] : (ks == 2 ? tope[2] : tope[3]));
        const float my_g = (ks == 0 ? 1.0f : (ks == 1 ? e1 : (ks == 2 ? e2 : e3))) * inv;
        const int row = blk * 16 + F.wave * 2 + (F.lane >> 5);
        __syncthreads();
        int lrank = 0; if (slot) lrank = atomicAdd((int*)(hist + my_e), 1);
        __syncthreads();
        if (F.tid < 32) { const int n = hist[F.tid]; basew[F.tid] = n ? (int)atomicAdd(cntg + F.tid * 64, (unsigned)n) : 0; }
        __syncthreads();
        if (slot) { const int pos = basew[my_e] + lrank; int2 ent; ent.x = row * 4 + ks; ent.y = __float_as_int(my_g); lists[(size_t)my_e * LIST_CAP + pos] = ent; }
    }
    __syncthreads();
}
DI void load_row_fp8(const unsigned char* p, int lane, f32x4 (&v)[4]) {
#pragma unroll
    for (int j = 0; j < 4; ++j) { const unsigned w = *(const unsigned*)(p + 4 * lane + 256 * j); const f32x2 lo = __builtin_amdgcn_cvt_pk_f32_fp8((int)w, false), hi = __builtin_amdgcn_cvt_pk_f32_fp8((int)w, true); v[j] = (f32x4){lo[0], lo[1], hi[0], hi[1]}; }
}
DI void phase_n2(Frame& F, int l) {
    refresh(F);
    const kptr_t KA = kargs_now();
    const float* mod = (const float*)(F.ws + WS_MOD) + (size_t)l * NB * NMOD * D; const unsigned char* ys = F.ws + WS_YSLOT; bf16_t* xb = (bf16_t*)(F.ws + WS_XB);
    const int gw = F.bid * 8 + F.wave, NGW = F.G * 8;
    for (int r0 = gw * 2; r0 < T; r0 += NGW * 2) {
        f32x4 ya[2][4][4], xa[2][4];
#pragma unroll
        for (int rr = 0; rr < 2; ++rr) { const int r = r0 + rr;
#pragma unroll
            for (int k = 0; k < 4; ++k) load_row_fp8(ys + ((size_t)r * 4 + k) * D, F.lane, ya[rr][k]);
            load_row_bf16(xb + (size_t)r * D, F.lane, xa[rr]); }
        const float* mb = mod + (size_t)(r0 / SEQ) * NMOD * D;
        f32x4 gpf[4], gtf[4]; ModP mp;
#pragma unroll
        for (int j = 0; j < 4; ++j) { const int o = 4 * F.lane + 256 * j; gpf[j] = *(const f32x4*)(inp(KA, I_GPOSTFFN) + l * D + o); gtf[j] = *(const f32x4*)(mb + 5 * D + o); }
        if (l + 1 < DEPTH) { const float* mb2 = mb + (size_t)NB * NMOD * D; load_modp(mp, inp(KA, I_GPREMIX) + (l + 1) * D, mb2 + 1 * D, mb2 + 0 * D, F.lane); }
#pragma unroll
        for (int rr = 0; rr < 2; ++rr) { const int r = r0 + rr;
            f32x4 yv[4], hv[4]; f32x4 (&xv)[4] = xa[rr];
#pragma unroll
            for (int j = 0; j < 4; ++j) yv[j] = ((ya[rr][0][j] + ya[rr][1][j]) + (ya[rr][2][j] + ya[rr][3][j])) * (1.0f / YS8_SCALE);
            const float rstd_y = rsqrtf(sumsq(yv, F.lane) * (1.0f / D) + RMS_EPS);
#pragma unroll
            for (int j = 0; j < 4; ++j) { const int o = 4 * F.lane + 256 * j; const f32x4 gv = gpf[j], gt = gtf[j];
                xv[j] = xv[j] + gt * (yv[j] * rstd_y * gv);
                if (l + 1 < DEPTH) { u32x2 w; w.x = pk2(xv[j][0], xv[j][1]); w.y = pk2(xv[j][2], xv[j][3]); *(u32x2*)(xb + (size_t)r * D + o) = w; } else *(f32x4*)(F.out + (size_t)r * D + o) = xv[j]; }
            if (l + 1 < DEPTH) { const float rstd_x = rsqrtf(sumsq(xv, F.lane) * (1.0f / D) + RMS_EPS);
                mod_norm_store8(xv, rstd_x, mp, F.ws + WS_HF8 + (size_t)r * D, F.lane, hv); } }
    }
}
DI void phase_scan(Frame& F, int l) {
    refresh(F);
    const float* E = (const float*)(F.ws + WS_E); bf16_t* ua = (bf16_t*)(F.ws + WS_UA); const float* l32 = (const float*)(F.ws + WS_L32) + (size_t)l * NG * SP * 2;
    for (int u = F.bid; u < NG * 2; u += F.G) { const int g = u >> 1, b = (u & 1) * 8 + (F.tid >> 6), p = F.tid & 63;
        const float lr = l32[(g * SP + p) * 2], li = l32[(g * SP + p) * 2 + 1];
        const size_t row0 = (size_t)g * CROWS + b * NCH; float sr = 0.f, si = 0.f;
        f32x2 ev[NCH];
#pragma unroll
        for (int k = 0; k < NCH; ++k) ev[k] = *(const f32x2*)(E + (row0 + k) * 128 + 2 * p);
        asm volatile("" ::: "memory");
#pragma unroll
        for (int k = 0; k < NCH; ++k) {
            *(unsigned*)(ua + (row0 + k) * UAK + 512 + 2 * p) = pk2(sr, si);
            const float nr = lr * sr - li * si + ev[k][0], ni = lr * si + li * sr + ev[k][1]; sr = nr; si = ni; }
    }
}
constexpr float LOG2E = 1.4426950408889634f;
DI int t5_bucket(int n) { return n < 16 ? n : 16 + (n >= 19) + (n >= 21) + (n >= 24) + (n >= 27) + (n >= 31) + (n >= 35) + (n >= 40) + (n >= 46) + (n >= 52) + (n >= 59) + (n >= 67) + (n >= 77) + (n >= 87) + (n >= 99) + (n >= 113); }
#define MFMA32(a, b, c) __builtin_amdgcn_mfma_f32_32x32x16_bf16((a), (b), (c), 0, 0, 0)
DI void phase_attn(Frame& F, int l) {
    refresh(F);
    const kptr_t KA = kargs_now();
    const bf16_t* qb = (const bf16_t*)(F.ws + WS_Q); const bf16_t* kb = (const bf16_t*)(F.ws + WS_K); const bf16_t* vb = (const bf16_t*)(F.ws + WS_V);
    const float* kmean = (const float*)(F.ws + WS_KMEAN) + (size_t)l * NB * NBLK * AW; unsigned char* att = F.ws + WS_AZ;
    constexpr int ATT_BUF = 9216;
    LAS unsigned char* KS = F.lds; LAS unsigned char* VS = F.lds + 2 * ATT_BUF; LAS float* BIAS = (LAS float*)(F.lds + 4 * ATT_BUF); LAS float* KM = (LAS float*)(F.lds + 4 * ATT_BUF + 512); LAS int* OVF = (LAS int*)(F.lds + 4 * ATT_BUF + 512 + 2048);
    constexpr int ATT_RC = 208, ATT_RN = 280; LAS float* RT = (LAS float*)(F.lds + 4 * ATT_BUF + 512 + 2048 + 64);
    QState cq; cq.base = 0; cq.cnt = 8;
    constexpr int SLOT_ITEMS = 3;
    if (F.bid & 1) { __syncthreads(); run_items1(F, 1 + l, SLOT_ITEMS, cq); }
    for (int U = F.bid; U < NB * NH * NBLK; U += F.G) {
        refresh(F);
        const int lane = F.lane, wave = F.wave, qi = lane & 31, hh = lane >> 5;
        const int srow = F.tid >> 3, sch = F.tid & 7;
        const int c = U & 255, it = U >> 8, bh = c >> 1, set = c & 1;
        const int qblk = set ? (it == 0 ? 6 : (it == 1 ? 1 : (it == 2 ? 5 : 2))) : (it == 0 ? 7 : (it == 1 ? 0 : (it == 2 ? 4 : 3)));
        const int b = bh >> 3, h = bh & 7;
        const size_t qtok = (size_t)b * SEQ + qblk * 256 + 32 * wave + qi;
        bf16x8 qf[4];
#pragma unroll
        for (int s = 0; s < 4; ++s) qf[s] = *(const bf16x8*)(qb + qtok * AW + h * HD + 16 * s + 8 * hh);
        u32x4 kreg, vreg;
        { const size_t tok = (size_t)b * SEQ + qblk * 256 + srow; kreg = *(const u32x4*)(kb + tok * AW + h * HD + sch * 8); vreg = *(const u32x4*)(vb + tok * AW + h * HD + sch * 8); }
        const float km_v = kmean[((size_t)(b * NBLK + (F.tid >> 6))) * AW + h * HD + (F.tid & 63)] * (1.0f / 256.0f);
        const float bias_v = inp(KA, I_RELB)[t5_bucket(F.tid & 127) * NH + h] * LOG2E;
        __syncthreads();
        if (F.tid < 128) BIAS[F.tid] = bias_v;
        if (F.tid == 0) OVF[0] = 0;
        KM[F.tid] = km_v;
        *(LAS u32x4*)(KS + srow * 144 + sch * 16) = kreg; *(LAS u32x4*)(VS + srow * 144 + sch * 16) = vreg;
        { const size_t tok = (size_t)b * SEQ + qblk * 256 + 64 + srow; kreg = *(const u32x4*)(kb + tok * AW + h * HD + sch * 8); vreg = *(const u32x4*)(vb + tok * AW + h * HD + sch * 8); }
        __syncthreads();
        for (int e = F.tid; e < 4 * ATT_RN; e += 512) { const int cpy = e / ATT_RN, dist = ATT_RC - (e - cpy * ATT_RN + cpy); RT[e] = dist < 0 ? -1.0e30f : BIAS[dist > 127 ? 127 : dist]; }
        const float bfar = BIAS[127];
        unsigned selmask = 0;
        {
            float gsc[8];
#pragma unroll
            for (int j = 0; j < 8; ++j) { float a = 0.f;
#pragma unroll
                for (int s = 0; s < 4; ++s)
#pragma unroll
                    for (int e = 0; e < 8; ++e) a += __uint_as_float(((unsigned)(unsigned short)qf[s][e]) << 16) * KM[j * 64 + 16 * s + 8 * hh + e];
                a = half_sum(a); gsc[j] = (j < qblk) ? a : -INFINITY; }
#pragma unroll
            for (int rnd = 0; rnd < 3; ++rnd) { float bv = -INFINITY; int bi = -1;
#pragma unroll
                for (int j = 0; j < 8; ++j) if (gsc[j] > bv) { bv = gsc[j]; bi = j; }
                if (bi >= 0) selmask |= 1u << bi;
#pragma unroll
                for (int j = 0; j < 8; ++j) if (j == bi) gsc[j] = -INFINITY; }
        }
        f32x16 o[2]; float l_run;
        const int n_tiles = 4 * (qblk + 1);
        const int pv_q = (lane & 15) >> 2, pv_p = lane & 3, pv_c = (lane >> 4) & 1;
#define ATT_JB(T) ((T) < 4 ? qblk : qblk - 1 - (((T) - 4) >> 2))
#define ATT_KT(T) ((T) < 4 ? (T) : ((T) < 6 ? 7 - (T) : ((T) < 8 ? (T) - 6 : ((T) & 3))))
#define ATT_TOK(T) ((size_t)b * SEQ + ATT_JB(T) * 256 + ATT_KT(T) * 64 + srow)
#define ATT_PV_STEP(S_) do { const int ks_ = (S_) >> 1, r0_ = 8 * ((S_) & 1); u32x4 w_; \
            w_.x = pk2(st[ks_][r0_], st[ks_][r0_ + 1]); w_.y = pk2(st[ks_][r0_ + 2], st[ks_][r0_ + 3]); w_.z = pk2(st[ks_][r0_ + 4], st[ks_][r0_ + 5]); w_.w = pk2(st[ks_][r0_ + 6], st[ks_][r0_ + 7]); \
            const bf16x8 pfs_ = __builtin_bit_cast(bf16x8, w_); \
            _Pragma("unroll") for (int ds_ = 0; ds_ < 2; ++ds_) { const LAS unsigned char* base_ = VSb + (16 * (S_) + 4 * hh + pv_q) * 144 + (32 * ds_ + 16 * pv_c + 4 * pv_p) * 2; \
                const s16x4 lo_ = __builtin_amdgcn_ds_read_tr16_b64_v4i16((LAS s16x4*)base_), hi_ = __builtin_amdgcn_ds_read_tr16_b64_v4i16((LAS s16x4*)(base_ + 8 * 144)); \
                bf16x8 vf_; vf_[0] = lo_[0]; vf_[1] = lo_[1]; vf_[2] = lo_[2]; vf_[3] = lo_[3]; vf_[4] = hi_[0]; vf_[5] = hi_[1]; vf_[6] = hi_[2]; vf_[7] = hi_[3]; \
                o[ds_] = MFMA32(vf_, pfs_, o[ds_]); } } while (0)
#define ATT_BODY(NEAR_, RP_) do { \
            bf16x8 kf[8]; f32x16 st[2];                                                  \
            _Pragma("unroll") for (int ks_ = 0; ks_ < 2; ++ks_) _Pragma("unroll") for (int s_ = 0; s_ < 4; ++s_) kf[ks_ * 4 + s_] = *(const LAS bf16x8*)(KSb + (32 * ks_ + qi) * 144 + 32 * s_ + 16 * hh); \
            if (NEAR_) { \
                _Pragma("unroll") for (int ks_ = 0; ks_ < 2; ++ks_) _Pragma("unroll") for (int g_ = 0; g_ < 4; ++g_) { const f32x4 t_ = *(const LAS f32x4*)((RP_) + (32 * ks_ + 8 * g_) * 4); \
                    st[ks_][4 * g_] = t_[0]; st[ks_][4 * g_ + 1] = t_[1]; st[ks_][4 * g_ + 2] = t_[2]; st[ks_][4 * g_ + 3] = t_[3]; } \
                asm volatile("s_waitcnt lgkmcnt(0)" : "+v"(kf[0]), "+v"(kf[1]), "+v"(kf[2]), "+v"(kf[3]), "+v"(kf[4]), "+v"(kf[5]), "+v"(kf[6]), "+v"(kf[7]), "+v"(st[0]), "+v"(st[1]) :: "memory"); \
                _Pragma("unroll") for (int s_ = 0; s_ < 4; ++s_) _Pragma("unroll") for (int ks_ = 0; ks_ < 2; ++ks_) st[ks_] = MFMA32(kf[ks_ * 4 + s_], qf[s_], st[ks_]); \
            } else { \
                const float cbm = lane_sel ? bfar : -1.0e30f;                             \
                f32x16 negm; _Pragma("unroll") for (int i_ = 0; i_ < 16; ++i_) negm[i_] = cbm; \
                asm volatile("s_waitcnt lgkmcnt(0)" : "+v"(kf[0]), "+v"(kf[1]), "+v"(kf[2]), "+v"(kf[3]), "+v"(kf[4]), "+v"(kf[5]), "+v"(kf[6]), "+v"(kf[7]) :: "memory"); \
                _Pragma("unroll") for (int s_ = 0; s_ < 4; ++s_) _Pragma("unroll") for (int ks_ = 0; ks_ < 2; ++ks_) st[ks_] = MFMA32(kf[ks_ * 4 + s_], qf[s_], s_ == 0 ? negm : st[ks_]); } \
            s16x4 vlo[8], vhi[8];                                                        \
            _Pragma("unroll") for (int s_ = 0; s_ < 4; ++s_) _Pragma("unroll") for (int ds_ = 0; ds_ < 2; ++ds_) { const LAS unsigned char* base_ = VSb + (16 * s_ + 4 * hh + pv_q) * 144 + (32 * ds_ + 16 * pv_c + 4 * pv_p) * 2; \
                vlo[s_ * 2 + ds_] = __builtin_amdgcn_ds_read_tr16_b64_v4i16((LAS s16x4*)base_); vhi[s_ * 2 + ds_] = __builtin_amdgcn_ds_read_tr16_b64_v4i16((LAS s16x4*)(base_ + 8 * 144)); } \
            asm volatile("" ::: "memory"); \
            f32x2 ls2 = {0.f, 0.f}; \
            _Pragma("unroll") for (int s4_ = 0; s4_ < 4; ++s4_) { const int ks_ = s4_ >> 1, r0_ = 8 * (s4_ & 1);        \
                _Pragma("unroll") for (int j_ = 0; j_ < 8; j_ += 2) { const float p0_ = __builtin_amdgcn_exp2f(st[ks_][r0_ + j_]), p1_ = __builtin_amdgcn_exp2f(st[ks_][r0_ + j_ + 1]); st[ks_][r0_ + j_] = p0_; st[ks_][r0_ + j_ + 1] = p1_; ls2 += (f32x2){p0_, p1_}; } \
                if (s4_ == 0) asm volatile("s_waitcnt lgkmcnt(0)" : "+v"(vlo[0]), "+v"(vlo[1]), "+v"(vlo[2]), "+v"(vlo[3]), "+v"(vlo[4]), "+v"(vlo[5]), "+v"(vlo[6]), "+v"(vlo[7]), \
                         "+v"(vhi[0]), "+v"(vhi[1]), "+v"(vhi[2]), "+v"(vhi[3]), "+v"(vhi[4]), "+v"(vhi[5]), "+v"(vhi[6]), "+v"(vhi[7]) :: "memory"); \
                u32x4 w_; w_.x = pk2(st[ks_][r0_], st[ks_][r0_ + 1]); w_.y = pk2(st[ks_][r0_ + 2], st[ks_][r0_ + 3]); w_.z = pk2(st[ks_][r0_ + 4], st[ks_][r0_ + 5]); w_.w = pk2(st[ks_][r0_ + 6], st[ks_][r0_ + 7]); \
                const bf16x8 pfs_ = __builtin_bit_cast(bf16x8, w_); \
                _Pragma("unroll") for (int ds_ = 0; ds_ < 2; ++ds_) { const s16x4 lo_ = vlo[s4_ * 2 + ds_], hi_ = vhi[s4_ * 2 + ds_]; \
                    bf16x8 vf_; vf_[0] = lo_[0]; vf_[1] = lo_[1]; vf_[2] = lo_[2]; vf_[3] = lo_[3]; vf_[4] = hi_[0]; vf_[5] = hi_[1]; vf_[6] = hi_[2]; vf_[7] = hi_[3]; \
                    o[ds_] = MFMA32(vf_, pfs_, o[ds_]); } } \
            l_run += ls2[0] + ls2[1]; } while (0)
#define ATT_ADVANCE(T) do { if ((T) + 1 < n_tiles) { \
                LAS unsigned char* KSn = KS + (((T) + 1) & 1) * ATT_BUF; LAS unsigned char* VSn = VS + (((T) + 1) & 1) * ATT_BUF; \
                *(LAS u32x4*)(KSn + srow * 144 + sch * 16) = kreg; *(LAS u32x4*)(VSn + srow * 144 + sch * 16) = vreg; \
                if ((T) + 2 < n_tiles) { const int t2_ = (T) + 2; const size_t tok_ = ATT_TOK(t2_); \
                    kreg = *(const u32x4*)(kb + tok_ * AW + h * HD + sch * 8); vreg = *(const u32x4*)(vb + tok_ * AW + h * HD + sch * 8); } } \
            __syncthreads(); } while (0)
#define ATT_PRIME() \
            u32x4 kreg, vreg; \
            { const size_t tok = ATT_TOK(0); kreg = *(const u32x4*)(kb + tok * AW + h * HD + sch * 8); vreg = *(const u32x4*)(vb + tok * AW + h * HD + sch * 8); } \
            *(LAS u32x4*)(KS + srow * 144 + sch * 16) = kreg; *(LAS u32x4*)(VS + srow * 144 + sch * 16) = vreg; \
            { const size_t tok = ATT_TOK(1); kreg = *(const u32x4*)(kb + tok * AW + h * HD + sch * 8); vreg = *(const u32x4*)(vb + tok * AW + h * HD + sch * 8); } \
            __syncthreads();
        {
#pragma unroll
            for (int i = 0; i < 16; ++i) { o[0][i] = 0.f; o[1][i] = 0.f; }
            l_run = 0.f;
            __syncthreads();
            const int nA = n_tiles < 6 ? n_tiles : 6;
            int ti = 0;
            for (; ti < nA; ++ti) {
                LAS unsigned char* KSb = KS + (ti & 1) * ATT_BUF; LAS unsigned char* VSb = VS + (ti & 1) * ATT_BUF;
                const bool own = ti < 4; const int jb = ATT_JB(ti), kt = ATT_KT(ti);
                const bool lane_sel = own || (((selmask >> jb) & 1u) != 0u);
                const bool active = own ? (kt <= (wave >> 1)) : (__ballot(lane_sel) != 0ull);
                if (active) {
                    const int toff = (qblk - jb) * 256 + 32 * wave - 64 * kt;
                    if (toff - 63 < 113) {
                        const int y0 = ATT_RC - toff - qi + 4 * hh;
                        const LAS unsigned char* rp = (const LAS unsigned char*)RT + (lane_sel ? (y0 & 3) * (ATT_RN * 4) + (y0 & ~3) * 4 : (ATT_RC + 4) * 4);
                        ATT_BODY(1, rp);
                    } else { ATT_BODY(0, (const LAS unsigned char*)RT); }
                }
                ATT_ADVANCE(ti);
            }
            for (; ti < n_tiles; ++ti) {
                LAS unsigned char* KSb = KS + (ti & 1) * ATT_BUF; LAS unsigned char* VSb = VS + (ti & 1) * ATT_BUF;
                const int jb = ATT_JB(ti);
                const bool lane_sel = ((selmask >> jb) & 1u) != 0u;
                if (__ballot(lane_sel) != 0ull) ATT_BODY(0, (const LAS unsigned char*)RT);
                ATT_ADVANCE(ti);
            }
            { const float lchk = half_sum(l_run);
              if (__ballot(!(lchk > 5.5e-20f && lchk < 1.8e19f)) != 0ull && lane == 0) *(volatile LAS int*)OVF = 1; }
            __syncthreads();
        }
        if (*(volatile LAS int*)OVF != 0) {
            __syncthreads();
#pragma unroll
            for (int i = 0; i < 16; ++i) { o[0][i] = 0.f; o[1][i] = 0.f; }
            l_run = 0.f; float m_run = -INFINITY;
            ATT_PRIME()
            for (int ti = 0; ti < n_tiles; ++ti) {
                LAS unsigned char* KSb = KS + (ti & 1) * ATT_BUF; LAS unsigned char* VSb = VS + (ti & 1) * ATT_BUF;
                const bool own = ti < 4; const int jb = ATT_JB(ti), kt = ATT_KT(ti);
                const bool lane_sel = own || (((selmask >> jb) & 1u) != 0u);
                const bool active = own ? (kt <= (wave >> 1)) : (__ballot(lane_sel) != 0ull);
                if (active) {
                    f32x16 st[2]; float ls = 0.f;
#pragma unroll
                    for (int ks = 0; ks < 2; ++ks) {
#pragma unroll
                        for (int i = 0; i < 16; ++i) st[ks][i] = 0.f;
#pragma unroll
                        for (int s = 0; s < 4; ++s) { const bf16x8 a = *(const LAS bf16x8*)(KSb + (32 * ks + qi) * 144 + 32 * s + 16 * hh); st[ks] = MFMA32(a, qf[s], st[ks]); } }
                    const int dbase = (qblk - jb) * 256 + 32 * wave + qi - 64 * kt - 4 * hh;
                    float mx = -INFINITY;
#pragma unroll
                    for (int ks = 0; ks < 2; ++ks)
#pragma unroll
                        for (int i = 0; i < 16; ++i) { const int dist = dbase - (32 * ks + (i & 3) + 8 * (i >> 2));
                            const float bias = ((volatile LAS float*)BIAS)[dist < 0 ? 0 : (dist > 127 ? 127 : dist)];
                            const bool valid = lane_sel && (!own || dist >= 0);
                            const float sv = valid ? st[ks][i] + bias : -INFINITY; st[ks][i] = sv; mx = fmaxf(mx, sv); }
                    mx = half_max(mx);
                    const float m_new = fmaxf(m_run, mx);
                    const float m_use = (m_new > -1.0e37f) ? m_new : 0.f;
                    const float alpha = __builtin_amdgcn_exp2f(m_run - m_use); m_run = m_new;
#pragma unroll
                    for (int ks = 0; ks < 2; ++ks)
#pragma unroll
                        for (int i = 0; i < 16; ++i) { const float p = __builtin_amdgcn_exp2f(st[ks][i] - m_use); st[ks][i] = p; ls += p; }
                    l_run = l_run * alpha + ls;
#pragma unroll
                    for (int i = 0; i < 16; ++i) { o[0][i] *= alpha; o[1][i] *= alpha; }
#pragma unroll
                    for (int s4 = 0; s4 < 4; ++s4) ATT_PV_STEP(s4);
                }
                ATT_ADVANCE(ti);
            }
        }
#undef ATT_PV_STEP
#undef ATT_BODY
#undef ATT_ADVANCE
#undef ATT_PRIME
#undef ATT_JB
#undef ATT_KT
#undef ATT_TOK
        const float ltot = half_sum(l_run); const float inv = AZ8_SCALE / ltot;
#pragma unroll
        for (int ds = 0; ds < 2; ++ds)
#pragma unroll
            for (int g4 = 0; g4 < 4; ++g4)
                *(unsigned*)(att + qtok * D + h * HD + 32 * ds + 8 * g4 + 4 * hh) = pk4_fp8(o[ds][4 * g4] * inv, o[ds][4 * g4 + 1] * inv, o[ds][4 * g4 + 2] * inv, o[ds][4 * g4 + 3] * inv);
        if (!((F.bid & 1) && it == 3)) { __syncthreads(); run_items1(F, 1 + l, SLOT_ITEMS, cq); }
    }
    __syncthreads();
    run_items1(F, 1 + l, -1, cq);
    __syncthreads();
}

#define DUP_PHASE 0
#define REP(k) for (int _r = 0; _r < ((DUP_PHASE == (k)) ? 2 : 1); ++_r)
struct Args { const float* in[28]; float* out; unsigned char* ws; };
__global__ void __launch_bounds__(512, 2) fwd_kernel(Args args) {
    extern __shared__ __attribute__((aligned(16))) unsigned char lds_raw[];
    Frame F;
    F.lds = (LAS unsigned char*)lds_raw; F.MISC = (volatile LAS unsigned*)(F.lds + LDS_MISC);
    F.tid = threadIdx.x; F.lane = F.tid & 63; F.wave = __builtin_amdgcn_readfirstlane(F.tid >> 6); F.G = gridDim.x; F.bid = blockIdx.x;
    F.ws = (unsigned char*)(GAS unsigned char*)args.ws; F.ctl = (unsigned*)(GAS unsigned*)(args.ws + WS_CTL); F.out = (float*)(GAS float*)args.out;
    for (int u = F.tid; u < (LDS_BYTES - LDS_MISC) / 4; u += 512) F.MISC[u] = 0u;
    __syncthreads();
    XcdBarrier bar = xcd_barrier_post(F.ctl + CW_BAR, F.MISC + 0, F.tid == 0);
#define GRID_BAR() do { XcdBarrier _b = bar; asm volatile("" : "+s"(_b.bar), "+s"(_b.x)); refresh(F); xcd_barrier(_b, F.tid == 0); } while (0)

    REP(1) { for (int u = F.bid; u < 256; u += F.G) { if (u < 64) p_ssm_unit(F, u); else p_adaln_unit(F, u - 64); }
    p_transposes(F); __syncthreads(); }
    GRID_BAR();
    REP(2) phase_n0(F, 0);
    GRID_BAR();

    for (int l = 0; l < DEPTH; ++l) {
        REP(3) { unsigned char* ws = opaque_ws(F); constexpr float dq8 = 1.0f / (W8_SCALE * H8_SCALE);
          { PlainSched S; S.init(ws + WS_HF8, ws + WS_WIN + (size_t)l * INW * D, T, INW, D / 2, D / 2, F.G, F.bid);
            EpiG1 E{EpiQK{(bf16_t*)(ws + WS_Q), (bf16_t*)(ws + WS_K), (float*)(ws + WS_KMEAN) + (size_t)l * NB * NBLK * AW, dq8}, EpiVUG{(bf16_t*)(ws + WS_V), (bf16_t*)(ws + WS_UA), ws + WS_GATT, ws + WS_GSSM, dq8}};
            pg8::gemm_phase<EpiG1, PlainSched, false, true>(F.lds, S, E, D / 128, D / 2, D / 2, F.wave); } }
        GRID_BAR();
        REP(4) { unsigned char* ws = opaque_ws(F); GroupSched S; S.init(ws + WS_UA, (bf16_t*)(ws + WS_BE) + (size_t)l * NG * 256 * 512, 4, 1, UAK, 512, 256, F.G, F.bid);
          EpiState E{(float*)(ws + WS_E)};
          pg8::gemm_phase<EpiState, GroupSched, false>(F.lds, S, E, 512 / 64, UAK, 512, F.wave); }
        GRID_BAR();
        REP(5) { phase_scan(F, l);
        phase_attn(F, l); }
        GRID_BAR();
        REP(6) { unsigned char* ws = opaque_ws(F); GroupSched S; S.init(ws + WS_UA, (bf16_t*)(ws + WS_BSSM) + (size_t)l * NG * 512 * UAK, 4, 2, UAK, UAK, 512, F.G, F.bid);
          EpiSsmOut E{(bf16_t*)(ws + WS_Y)};
          pg8::gemm_phase<EpiSsmOut, GroupSched, false>(F.lds, S, E, UAK / 64, UAK, UAK, F.wave); }
        GRID_BAR();
        REP(7) { unsigned char* ws = opaque_ws(F); PlainSched S; S.init(ws + WS_Y, (bf16_t*)(ws + WS_WGLU) + (size_t)l * 1024 * SW, T, 1024, SW, SW, F.G, F.bid);
          EpiGlu E{ws + WS_AZ};
          pg8::gemm_phase<EpiGlu, PlainSched, false>(F.lds, S, E, SW / 64, SW, SW, F.wave); }
        GRID_BAR();
        REP(8) { unsigned char* ws = opaque_ws(F); PlainSched S; S.init(ws + WS_AZ, ws + WS_WCAT + (size_t)l * D * D, T, D, D / 2, D / 2, F.G, F.bid);
          EpiMerge E{ws + WS_MRG, ws + WS_GATT, ws + WS_GSSM};
          pg8::gemm_phase<EpiMerge, PlainSched, false, true>(F.lds, S, E, D / 128, D / 2, D / 2, F.wave); }
        GRID_BAR();
        REP(10) { unsigned char* ws = opaque_ws(F); PlainSched S; S.init(ws + WS_MRG, ws + WS_WOUT + (size_t)l * D * D, T, D, D / 2, D / 2, F.G, F.bid);
          EpiPlain E{(bf16_t*)(ws + WS_YMIX), D, 1.0f / (W8_SCALE * MRG8_SCALE)};
          pg8::gemm_phase<EpiPlain, PlainSched, false, true>(F.lds, S, E, D / 128, D / 2, D / 2, F.wave); }
        GRID_BAR();
        phase_n1(F, l);
        GRID_BAR();
        volatile LAS int* tbw = (volatile LAS int*)(F.MISC + 16); volatile LAS int* cntw = (volatile LAS int*)(F.MISC + 128);
        if (F.tid < 32) cntw[F.tid] = (int)__hip_atomic_load(F.ctl + CW_CNT + (l * NE + F.tid) * 64, __ATOMIC_RELAXED, __HIP_MEMORY_SCOPE_AGENT);
        __syncthreads();
        if (F.tid == 0) { int s = 0; for (int e = 0; e < NE; ++e) { tbw[e] = s; s += (cntw[e] + 255) >> 8; } tbw[32] = s; }
        __syncthreads();
        REP(12) { unsigned char* ws = opaque_ws(F); const kptr_t KA = kargs_now(); MoeSched S; S.A = (const char*)(ws + WS_H8); S.B = (const char*)(ws + WS_W1 + (size_t)l * NE * 2048 * D); S.lists = (const int2*)(ws + WS_LISTS);
          S.tb = (const LAS int*)(F.MISC + 16); S.cnt = (const LAS int*)(F.MISC + 128); S.nN = 8; S.GM = 4; S.G = F.G; S.c = F.bid; S.eB = (size_t)2048 * D; S.tB = (size_t)256 * D; S.tA = 0; S.gather = true; S.ul = (const LAS int*)(F.MISC + 192);
          refresh(F); __syncthreads(); S.build((volatile LAS int*)(F.MISC + 192), F.tid); __syncthreads();
          EpiSwiglu E{ws + WS_ACT, inp(KA, I_BEXPIN) + (size_t)l * NE * 2048};
          pg8::gemm_phase<EpiSwiglu, MoeSched, true, true>(F.lds, S, E, (D / 128) * PROBE_KREP, D / 2, D / 2, F.wave, PROBE_KREP > 1 ? D / 128 : 0); }
        GRID_BAR();
        REP(13) { unsigned char* ws = opaque_ws(F); const kptr_t KA = kargs_now(); MoeSched S; S.A = (const char*)(ws + WS_ACT); S.B = (const char*)(ws + WS_W2 + (size_t)l * NE * D * DFF); S.lists = (const int2*)(ws + WS_LISTS);
          S.tb = (const LAS int*)(F.MISC + 16); S.cnt = (const LAS int*)(F.MISC + 128); S.nN = 4; S.GM = 8; S.G = F.G; S.c = F.bid; S.eB = (size_t)D * DFF; S.tB = (size_t)256 * DFF; S.tA = (size_t)256 * DFF; S.gather = false; S.ul = (const LAS int*)(F.MISC + 192);
          refresh(F); __syncthreads(); S.build((volatile LAS int*)(F.MISC + 192), F.tid); __syncthreads();
          EpiMoeOut E{(bf16_t*)(ws + WS_YSLOT), inp(KA, I_BEXPOUT) + (size_t)l * NE * D, (const int2*)(ws + WS_LISTS)};
          pg8::gemm_phase<EpiMoeOut, MoeSched, false, true>(F.lds, S, E, DFF / 128, DFF / 2, DFF / 2, F.wave); }
        GRID_BAR();
        phase_n2(F, l);
        GRID_BAR();
    }
}

extern "C" void kernel_launch(void* const* d_in, const int* in_sizes, int n_in, void* d_out, int out_size, void* d_ws, size_t ws_size, hipStream_t stream) {
    static int grid = 0;
    if (grid == 0) {
        if (n_in != 28 || out_size != T * D || ws_size < WS_END) { fprintf(stderr, "kernel_launch: unexpected shapes (n_in %d, out %d, ws %zu < %zu)\n", n_in, out_size, ws_size, (size_t)WS_END); grid = -1; return; }
        int dev = 0, cus = 0, per_cu = 0;
        if (hipGetDevice(&dev) != hipSuccess || hipDeviceGetAttribute(&cus, hipDeviceAttributeMultiprocessorCount, dev) != hipSuccess) { grid = -1; return; }
        if (hipFuncSetAttribute((const void*)fwd_kernel, hipFuncAttributeMaxDynamicSharedMemorySize, LDS_BYTES) != hipSuccess) { fprintf(stderr, "kernel_launch: hipFuncSetAttribute failed\n"); grid = -1; return; }
        if (hipOccupancyMaxActiveBlocksPerMultiprocessor(&per_cu, (const void*)fwd_kernel, 512, LDS_BYTES) != hipSuccess || per_cu < 1) { fprintf(stderr, "kernel_launch: occupancy query says %d\n", per_cu); }
        (void)hipGetLastError();
        grid = cus;
    }
    if (grid < 0) return;
    if (hipMemsetAsync(d_ws, 0, WS_ZERO_BYTES, stream) != hipSuccess) { fprintf(stderr, "kernel_launch: memset failed\n"); return; }
    Args a{};
    for (int i = 0; i < 28; ++i) a.in[i] = (const float*)d_in[i];
    a.out = (float*)d_out; a.ws = (unsigned char*)d_ws;
    hipLaunchKernelGGL(fwd_kernel, dim3(grid), dim3(512), LDS_BYTES, stream, a);
    const hipError_t le = hipPeekAtLastError();
    if (le != hipSuccess) fprintf(stderr, "kernel_launch: launch failed: %s\n", hipGetErrorName(le));
}
```

```cpp
#include <hip/hip_runtime.h>
#include <cstdio>
#include <cstdint>

#define LAS __attribute__((address_space(3)))
#define GAS __attribute__((address_space(1)))
typedef unsigned short bf16_t;
typedef short bf16x8 __attribute__((ext_vector_type(8)));
typedef short s16x4 __attribute__((ext_vector_type(4)));
typedef float f32x4 __attribute__((ext_vector_type(4)));
typedef float f32x2 __attribute__((ext_vector_type(2)));
typedef float f32x16 __attribute__((ext_vector_type(16)));
typedef unsigned u32x4 __attribute__((ext_vector_type(4)));
typedef unsigned u32x2 __attribute__((ext_vector_type(2)));
typedef __bf16 bf16x2v __attribute__((ext_vector_type(2)));
typedef int i32x4 __attribute__((ext_vector_type(4)));
typedef int i32x8 __attribute__((ext_vector_type(8)));
#define DI __device__ __forceinline__

#define PROBE_KREP 1
constexpr int D = 1024, NB = 16, SEQ = 2048, T = NB * SEQ, DEPTH = 2;
constexpr int AW = 512, NH = 8, HD = 64, MBLK = 256, NBLK = SEQ / MBLK;
constexpr int SW = 512, SG = 16, NG = 32, SP = 64, CH = 32  , NCH = SEQ / CH  ;
constexpr int INW = 4096, NE = 32, TOPK = 4, DFF = 1024, NMOD = 6;
constexpr int UAK = 640;
constexpr int CROWS = NB * NCH;
constexpr float RMS_EPS = 1e-6f, LOG2E_C = 1.4426950408889634f;

constexpr size_t MiB = 1u << 20;
constexpr size_t WS_CTL = 0;
constexpr size_t WS_KMEAN = 1 * MiB;
constexpr size_t WS_ZERO_BYTES = 2 * MiB;
constexpr size_t WS_MOD = 2 * MiB;
constexpr size_t WS_L32 = 3 * MiB;
constexpr size_t WS_LISTS = 4 * MiB;
constexpr size_t WS_WIN = 12 * MiB;
constexpr size_t WS_WGLU = 28 * MiB;
constexpr size_t WS_WATT = 30 * MiB;
constexpr size_t WS_WSSM = 32 * MiB;
constexpr size_t WS_WOUT = 34 * MiB;
constexpr size_t WS_BSSM = 38 * MiB;
constexpr size_t WS_BE = 80 * MiB;
constexpr size_t WS_W1 = 98 * MiB;
constexpr size_t WS_W2 = 354 * MiB;
constexpr size_t WS_H = 482 * MiB;
constexpr size_t WS_Q = 546 * MiB, WS_K = 578 * MiB, WS_V = 610 * MiB;
constexpr size_t WS_H8 = WS_Q;
constexpr size_t WS_UA = 642 * MiB;
constexpr size_t WS_GATT = 684 * MiB, WS_GSSM = 748 * MiB;
constexpr size_t WS_ATT = 812 * MiB;
constexpr size_t WS_E = 844 * MiB;
constexpr size_t WS_Y = 860 * MiB;
constexpr size_t WS_Z = 892 * MiB;
constexpr size_t WS_MRG = 924 * MiB;
constexpr size_t WS_YMIX = 988 * MiB;
constexpr size_t WS_ACT = 1052 * MiB;
constexpr size_t WS_YSLOT = 1338 * MiB;
constexpr size_t WS_XB = 1594 * MiB;
constexpr size_t WS_HF8 = 1658 * MiB;
constexpr size_t WS_WIN8 = 1690 * MiB;
constexpr size_t WS_AZ = 1696 * MiB;
constexpr size_t WS_WCAT = 1760 * MiB;
constexpr size_t WS_END = 1764 * MiB;
constexpr int LIST_CAP = T;

constexpr int CW_BAR = 4096;
constexpr int CW_QUEUE = 8192;
constexpr int CW_CNT = 16384;

constexpr int RING_BYTES = 131072;
constexpr int LDS_MISC = RING_BYTES;
constexpr int LDS_BYTES = RING_BYTES + 4096;

DI unsigned pk2(float lo, float hi) { f32x2 v = {lo, hi}; bf16x2v r = __builtin_convertvector(v, bf16x2v); return __builtin_bit_cast(unsigned, r); }
DI float sat8(float x) { return __builtin_amdgcn_fmed3f(x, -448.0f, 448.0f); }
DI unsigned pk4_fp8(float a, float b, float c, float d) { int r = 0; r = __builtin_amdgcn_cvt_pk_fp8_f32(sat8(a), sat8(b), r, false); r = __builtin_amdgcn_cvt_pk_fp8_f32(sat8(c), sat8(d), r, true); return (unsigned)r; }
constexpr float W8_SCALE = 64.0f, H8_SCALE = 16.0f, ACT8_SCALE = 8.0f, GATE8_SCALE = 16.0f, YS8_SCALE = 64.0f, MRG8_SCALE = 32.0f, AZ8_SCALE = 8.0f;
DI void unpack8_fp8(const u32x2& w, f32x4& a, f32x4& b) { const f32x2 p0 = __builtin_amdgcn_cvt_pk_f32_fp8((int)w.x, false), p1 = __builtin_amdgcn_cvt_pk_f32_fp8((int)w.x, true), p2 = __builtin_amdgcn_cvt_pk_f32_fp8((int)w.y, false), p3 = __builtin_amdgcn_cvt_pk_f32_fp8((int)w.y, true);
    a = (f32x4){p0[0], p0[1], p1[0], p1[1]}; b = (f32x4){p2[0], p2[1], p3[0], p3[1]}; }
DI float bflo(unsigned w) { return __uint_as_float(w << 16); }
DI float bfhi(unsigned w) { return __uint_as_float(w & 0xffff0000u); }
DI float sigmoidf_(float x) { return __builtin_amdgcn_rcpf(1.0f + __builtin_amdgcn_exp2f(-1.4426950408889634f * x)); }
DI float gelu_tanh(float x) { const float u = 0.7978845608028654f * (x + 0.044715f * x * x * x); return x * __builtin_amdgcn_rcpf(1.0f + __builtin_amdgcn_exp2f(-2.8853900817779268f * u)); }
DI float shx(float v, int m, int lane) { return __int_as_float(__builtin_amdgcn_ds_bpermute((lane ^ m) << 2, __float_as_int(v))); }
DI int shxi(int v, int m, int lane) { return __builtin_amdgcn_ds_bpermute((lane ^ m) << 2, v); }
DI float half_max(float v) { const auto rr = __builtin_amdgcn_permlane32_swap(__float_as_uint(v), __float_as_uint(v), false, false); return fmaxf(__uint_as_float(rr[0]), __uint_as_float(rr[1])); }
DI float half_sum(float v) { const auto rr = __builtin_amdgcn_permlane32_swap(__float_as_uint(v), __float_as_uint(v), false, false); return __uint_as_float(rr[0]) + __uint_as_float(rr[1]); }
DI float wave_sum(float v, int lane) {
#pragma unroll
    for (int o = 1; o < 64; o <<= 1) v += shx(v, o, lane);
    return v;
}
#define LDS_WAIT() asm volatile("s_waitcnt lgkmcnt(0)" ::: "memory")
#define VM_WAIT() asm volatile("s_waitcnt vmcnt(0)" ::: "memory")

#define XB_TMO      128
#define XB_XCNT(j)  (256  + 64 * (j))
#define XB_XSUB(j)  (1280 + 64 * (j))
#define XB_XGEN(j)  (2304 + 64 * (j))
#define XB_TOP      3328
#define XB_TOPGEN   3392
#define XCD_BAR_WORDS 3456
#define XB_SPIN_CAP (1u << 18)
__device__ __forceinline__ unsigned xb_ld(unsigned* p)              { return __hip_atomic_load(p, __ATOMIC_RELAXED, __HIP_MEMORY_SCOPE_AGENT); }
__device__ __forceinline__ unsigned xb_add(unsigned* p, unsigned v) { return __hip_atomic_fetch_add(p, v, __ATOMIC_RELAXED, __HIP_MEMORY_SCOPE_AGENT); }
__device__ __forceinline__ unsigned xb_xcc_id() { return (unsigned)__builtin_amdgcn_s_getreg((3 << 11) | 20) & 0xFu; }
#define XB_SPIN(cond, bar) do { unsigned _sp = 0; while (cond) { __builtin_amdgcn_s_sleep(1); \
    if ((++_sp & 255u) == 0u) { if (xb_ld(&(bar)[XB_TMO])) break; if (_sp > XB_SPIN_CAP) { atomicAdd(&(bar)[XB_TMO], 1u); break; } } } } while (0)
struct XcdBarrier { unsigned* bar; unsigned x; volatile LAS unsigned* st; };
__device__ __forceinline__ XcdBarrier xcd_barrier_post(unsigned* bar, volatile LAS unsigned* st, bool t0) {
    XcdBarrier b; b.bar = bar; b.x = xb_xcc_id(); b.st = st;
    if (t0) (void)xb_add(&bar[XB_XCNT(b.x)], 1u);
    return b;
}
__device__ __forceinline__ void xcd_barrier_complete(unsigned* bar, unsigned x, unsigned& nloc, unsigned& nx) {
    const unsigned G = gridDim.x * gridDim.y * gridDim.z;
    unsigned sum, cnt, mine, sp = 0u;
    for (;;) {
        sum = 0u; cnt = 0u; mine = 0u;
#pragma unroll
        for (unsigned j = 0; j < 16; ++j) { const unsigned c = xb_ld(&bar[XB_XCNT(j)]); sum += c; cnt += (c > 0u) ? 1u : 0u; mine = (j == x) ? c : mine; }
        if (sum == G) break;
        __builtin_amdgcn_s_sleep(1);
        if ((++sp & 255u) == 0u) { if (xb_ld(&bar[XB_TMO])) break; if (sp > XB_SPIN_CAP) { atomicAdd(&bar[XB_TMO], 1u); break; } }
    }
    nloc = mine > 0u ? mine : 1u; nx = cnt > 0u ? cnt : 1u;
}
__device__ __forceinline__ void xcd_barrier(const XcdBarrier& b, bool t0) {
    asm volatile("s_waitcnt vmcnt(0)" ::: "memory");
    __syncthreads();
    if (t0) {
        unsigned* bar = b.bar;
        __builtin_amdgcn_s_waitcnt(0);
        unsigned nloc = b.st[0], nx = b.st[1];
        if (nloc == 0u) { xcd_barrier_complete(bar, b.x, nloc, nx); b.st[0] = nloc; b.st[1] = nx; }
        const unsigned old = xb_add(&bar[XB_XSUB(b.x)], 1u);
        const unsigned gen = old / nloc;
        if (old + 1u == (gen + 1u) * nloc) {
            __builtin_amdgcn_fence(__ATOMIC_RELEASE, "agent");
            asm volatile("s_waitcnt vmcnt(0)" ::: "memory");
            const unsigned og = xb_add(&bar[XB_TOP], 1u);
            const unsigned tg = og / nx;
            if (og + 1u == (tg + 1u) * nx) xb_add(&bar[XB_TOPGEN], 1u);
            else XB_SPIN(xb_ld(&bar[XB_TOPGEN]) == tg, bar);
            __builtin_amdgcn_fence(__ATOMIC_ACQUIRE, "agent");
            xb_add(&bar[XB_XGEN(b.x)], 1u);
            asm volatile("s_waitcnt vmcnt(0)" ::: "memory");
        } else {
            XB_SPIN(xb_ld(&bar[XB_XGEN(b.x)]) == gen, bar);
            __builtin_amdgcn_fence(__ATOMIC_ACQUIRE, "agent");
            asm volatile("s_waitcnt vmcnt(0)" ::: "memory");
        }
    }
    __syncthreads();
}

namespace pg8 {
constexpr int BM = 256, BK = 64, HALF = 128, HTB = HALF * BK * 2, STAGE_BYTES = 8 * HTB;
__host__ __device__ __forceinline__ int lds_byte(int r, int c) { const int st = (r >> 4) * 2 + (c >> 5), rr = r & 15, cc = c & 31, ob = rr * 64 + cc * 2; return st * 1024 + (ob ^ (((ob >> 9) & 1) << 5)); }
__host__ __device__ __forceinline__ void stage_rc(int b, int& R, int& C) { const int st = b / 1024, sb = b % 1024, swz = sb ^ (((sb >> 9) & 1) << 5); R = (st >> 1) * 16 + swz / 64; C = (st & 1) * 32 + (swz % 64) / 2; }
__host__ __device__ __forceinline__ int perm32(int rho) { const int n = rho >> 4, i = rho & 15; return 8 * (i >> 2) + 4 * n + (i & 3); }

struct Unit { int pm, pn, e, j, n, half; const char* A; const char* B; };
template <class...> struct voider { typedef void type; };
template <class E, class = void> struct MidT { static constexpr int v = -1; };
template <class E> struct MidT<E, typename voider<decltype(E::MID_T)>::type> { static constexpr int v = E::MID_T; };

template <class Epi, class Sched, bool GATHER, bool F8 = false>
__device__ __forceinline__ void gemm_phase(LAS unsigned char* lds, const Sched& S, const Epi& E, const int nt, const int lda, const int ldb, int wave_s, const int kmod = 0) {
    unsigned ones_ = ~0u; asm volatile("" : "+s"(wave_s), "+s"(ones_)); int tid = wave_s * 64 + (int)__builtin_amdgcn_mbcnt_hi(ones_, __builtin_amdgcn_mbcnt_lo(ones_, 0u)); asm volatile("" : "+v"(tid));
    const int wid = __builtin_amdgcn_readfirstlane(tid >> 6), lane = tid & 63, wr = wid >> 2, wc = wid & 3, fr = lane & 15, fq = lane >> 4;
    unsigned voffA, voffB;
    { int R, C; stage_rc(tid * 16, R, C); const int Rb = Epi::PERM ? ((R & ~31) + perm32(R & 31)) : R;
        voffA = (unsigned)(R * lda + C) * 2u; voffB = (unsigned)(Rb * ldb + C) * 2u; }
    const size_t qstepA = (size_t)64 * lda * 2, qstepB = (size_t)64 * ldb * 2;
    const size_t kstep = (size_t)(BK * 2);
    const size_t hstepA = (size_t)HALF * lda * 2, hstepB = (size_t)HALF * ldb * 2;
    const unsigned ldsw = (unsigned)wid * 1024u;
    const int aoff = lds_byte(wr * 64 + fr, fq * 8), boff = lds_byte(wc * 32 + fr, fq * 8);
#define PG8_SA(b, h) (((b) * 2 + (h)) * HTB)
#define PG8_SB(b, h) ((4 + (b) * 2 + (h)) * HTB)
#define PG8_STAGE(bufoff, gbase, voff) do { _Pragma("unroll") for (int _i = 0; _i < 2; ++_i) { unsigned _vo = (voff)[_i]; asm volatile("" : "+v"(_vo));     \
        __builtin_amdgcn_global_load_lds((const unsigned*)((const char*)(gbase) + _vo), (LAS unsigned*)(lds + (bufoff) + ldsw + _i * 8192), 16, 0, 0); } } while (0)
#define PG8_STAGE_U(bufoff, gbase, voff, qstep) do { _Pragma("unroll") for (int _i = 0; _i < 2; ++_i) { unsigned _vo = (voff); asm volatile("" : "+v"(_vo)); \
        __builtin_amdgcn_global_load_lds((const unsigned*)((const char*)(gbase) + _i * (qstep) + _vo), (LAS unsigned*)(lds + (bufoff) + ldsw + _i * 8192), 16, 0, 0); } } while (0)
#define PG8_STAGE_B(bufoff, gbase) PG8_STAGE_U(bufoff, gbase, voffB, qstepB)
#define PG8_STAGE_A(bufoff, gbase, h, GO) do { if constexpr (GATHER) { PG8_STAGE(bufoff, gbase, (GO)[h]); } else { PG8_STAGE_U(bufoff, (const char*)(gbase) + (h) * hstepA, voffA, qstepA); } } while (0)
#define PG8_LDA(dst, b, h) do { _Pragma("unroll") for (int m = 0; m < 4; ++m) _Pragma("unroll") for (int k = 0; k < 2; ++k) dst[m][k] = *(const LAS bf16x8*)(lds + PG8_SA(b, h) + aoff + m * 2048 + k * 1024); } while (0)
#define PG8_LDB(dst, b, h) do { _Pragma("unroll") for (int n = 0; n < 2; ++n) _Pragma("unroll") for (int k = 0; k < 2; ++k) dst[n][k] = *(const LAS bf16x8*)(lds + PG8_SB(b, h) + boff + n * 2048 + k * 1024); } while (0)
#define PG8_MMA(ai, bj, At, Bt) do { __builtin_amdgcn_s_setprio(1); if constexpr (F8) { _Pragma("unroll") for (int m = 0; m < 4; ++m) _Pragma("unroll") for (int n = 0; n < 2; ++n) { \
            const i32x8 a8 = __builtin_shufflevector(__builtin_bit_cast(i32x4, Bt[n][0]), __builtin_bit_cast(i32x4, Bt[n][1]), 0, 1, 2, 3, 4, 5, 6, 7); \
            const i32x8 b8 = __builtin_shufflevector(__builtin_bit_cast(i32x4, At[m][0]), __builtin_bit_cast(i32x4, At[m][1]), 0, 1, 2, 3, 4, 5, 6, 7); \
            acc[ai][bj][m][n] = __builtin_amdgcn_mfma_scale_f32_16x16x128_f8f6f4(a8, b8, acc[ai][bj][m][n], 0, 0, 0, 0, 0, 0); } } \
        else { _Pragma("unroll") for (int m = 0; m < 4; ++m) _Pragma("unroll") for (int n = 0; n < 2; ++n) _Pragma("unroll") for (int k = 0; k < 2; ++k) \
        acc[ai][bj][m][n] = __builtin_amdgcn_mfma_f32_16x16x32_bf16(Bt[n][k], At[m][k], acc[ai][bj][m][n], 0, 0, 0); } __builtin_amdgcn_s_setprio(0); } while (0)
#define PG8_WAIT_V(n) asm volatile("s_waitcnt vmcnt(" #n ")" ::: "memory")
#define PG8_WAIT_L(n) asm volatile("s_waitcnt lgkmcnt(" #n ")" ::: "memory")
#define PG8_BAR __builtin_amdgcn_s_barrier()
#define PG8_SCHED __builtin_amdgcn_sched_barrier(0)
    Unit cur, nxt; int ui = 0;
    if (!S.next(0, cur)) return;
    f32x4 acc[2][2][4][2];
#pragma unroll
    for (int a = 0; a < 2; ++a)
#pragma unroll
        for (int b = 0; b < 2; ++b)
#pragma unroll
            for (int m = 0; m < 4; ++m)
#pragma unroll
                for (int n = 0; n < 2; ++n) acc[a][b][m][n] = (f32x4){0.f, 0.f, 0.f, 0.f};
    bf16x8 At[4][2], B0[2][2], B1[2][2];
    const char* cA = cur.A; const char* cB = cur.B;
    unsigned gc[2][2], gn[2][2];
#define PG8_GOFF(dst, U) do { _Pragma("unroll") for (int _h = 0; _h < 2; ++_h) _Pragma("unroll") for (int _i = 0; _i < 2; ++_i) { int _R, _C; stage_rc(tid * 16 + _i * 8192, _R, _C); dst[_h][_i] = (unsigned)S.gather_row(U, _h * HALF + _R); } } while (0)
#define PG8_GCVT(dst) do { _Pragma("unroll") for (int _h = 0; _h < 2; ++_h) _Pragma("unroll") for (int _i = 0; _i < 2; ++_i) { int _R, _C; stage_rc(tid * 16 + _i * 8192, _R, _C); dst[_h][_i] = dst[_h][_i] * (unsigned)(lda * 2) + (unsigned)(_C * 2); } } while (0)
#pragma unroll
    for (int h = 0; h < 2; ++h)
#pragma unroll
        for (int i = 0; i < 2; ++i) { gc[h][i] = 0; gn[h][i] = 0; }
    if constexpr (GATHER) { PG8_GOFF(gc, cur); PG8_GCVT(gc); }
    PG8_STAGE_B(PG8_SB(0, 0), cB); PG8_STAGE_B(PG8_SB(0, 1), cB + hstepB); PG8_STAGE_A(PG8_SA(0, 0), cA, 0, gc); PG8_STAGE_A(PG8_SA(0, 1), cA, 1, gc);
    if (wr == 1) PG8_BAR;
    PG8_WAIT_V(2); PG8_BAR;
    PG8_STAGE_B(PG8_SB(1, 0), cB + kstep); PG8_STAGE_A(PG8_SA(1, 0), cA + kstep, 0, gc); PG8_STAGE_B(PG8_SB(1, 1), cB + hstepB + kstep);
    PG8_WAIT_V(6); PG8_BAR;
    for (;;) {
        const bool has_next = S.next(ui + 1, nxt);
        const char* nA = has_next ? nxt.A : cA; const char* nB = has_next ? nxt.B : cB;
        if constexpr (GATHER) { if (has_next) PG8_GOFF(gn, nxt); }
#pragma unroll 1
        for (int t = 0; t < nt; t += 2) {
            const bool last = (t == nt - 2);
            const int t1 = kmod ? (t + 1) % kmod : t + 1, t2 = kmod ? (t + 2) % kmod : t + 2;
            const char* a1 = cA + (size_t)t1 * kstep;
            const char* a2 = last ? nA : cA + (size_t)t2 * kstep; const char* b2 = last ? nB : cB + (size_t)t2 * kstep;
            const char* a3 = a2 + kstep; const char* b3 = b2 + kstep;
            if constexpr (MidT<Epi>::v >= 0) { if (t == MidT<Epi>::v) { unsigned o2 = ~0u; int w2 = wave_s; asm volatile("" : "+s"(w2), "+s"(o2)); int l2 = (int)__builtin_amdgcn_mbcnt_hi(o2, __builtin_amdgcn_mbcnt_lo(o2, 0u)); asm volatile("" : "+v"(l2));
                E.mid(acc, cur, w2 >> 2, w2 & 3, l2 & 15, l2 >> 4); } }
            PG8_LDB(B0, 0, 0); PG8_LDB(B1, 0, 1); PG8_SCHED; PG8_LDA(At, 0, 0); PG8_STAGE_A(PG8_SA(1, 1), a1, 1, gc);
            if constexpr (GATHER) { if (last && has_next) {
#pragma unroll
                for (int h = 0; h < 2; ++h)
#pragma unroll
                    for (int i = 0; i < 2; ++i) { int _R, _C; stage_rc(tid * 16 + i * 8192, _R, _C); gc[h][i] = gn[h][i] * (unsigned)(lda * 2) + (unsigned)(_C * 2); } } }
            PG8_WAIT_V(8); PG8_WAIT_L(0); PG8_BAR; if (cur.half != 2) { PG8_MMA(0, 0, At, B0); PG8_MMA(0, 1, At, B1); } PG8_BAR; PG8_SCHED;
            PG8_LDA(At, 0, 1); PG8_STAGE_B(PG8_SB(0, 0), b2); PG8_STAGE_B(PG8_SB(0, 1), b2 + hstepB); PG8_STAGE_A(PG8_SA(0, 0), a2, 0, gc);
            PG8_WAIT_V(8); PG8_WAIT_L(0); PG8_BAR; if (cur.half != 1) { PG8_MMA(1, 0, At, B0); PG8_MMA(1, 1, At, B1); } PG8_BAR; PG8_SCHED;
            PG8_LDB(B0, 1, 0); PG8_LDB(B1, 1, 1); PG8_SCHED; PG8_LDA(At, 1, 0); PG8_STAGE_A(PG8_SA(0, 1), a2, 1, gc);
            PG8_WAIT_V(8); PG8_WAIT_L(0); PG8_BAR; if (cur.half != 2) { PG8_MMA(0, 0, At, B0); PG8_MMA(0, 1, At, B1); } PG8_BAR; PG8_SCHED;
            PG8_LDA(At, 1, 1); PG8_STAGE_B(PG8_SB(1, 0), b3); PG8_STAGE_B(PG8_SB(1, 1), b3 + hstepB); PG8_STAGE_A(PG8_SA(1, 0), a3, 0, gc);
            PG8_WAIT_V(8); PG8_WAIT_L(0); PG8_BAR; if (cur.half != 1) { PG8_MMA(1, 0, At, B0); PG8_MMA(1, 1, At, B1); } PG8_BAR; PG8_SCHED;
        }
        if (wr == 0) PG8_BAR;
        { unsigned o2 = ~0u; int w2 = wave_s; asm volatile("" : "+s"(w2), "+s"(o2)); int l2 = (int)__builtin_amdgcn_mbcnt_hi(o2, __builtin_amdgcn_mbcnt_lo(o2, 0u)); asm volatile("" : "+v"(l2));
          E(acc, cur, w2 >> 2, w2 & 3, l2 & 15, l2 >> 4); }
        if (!has_next) break;
#pragma unroll
        for (int a = 0; a < 2; ++a)
#pragma unroll
            for (int b = 0; b < 2; ++b)
#pragma unroll
                for (int m = 0; m < 4; ++m)
#pragma unroll
                    for (int n = 0; n < 2; ++n) acc[a][b][m][n] = (f32x4){0.f, 0.f, 0.f, 0.f};
        cur = nxt; cA = nA; cB = nB; ++ui;
        if (wr == 1) PG8_BAR;
    }
    PG8_WAIT_V(0);
    PG8_BAR;
#undef PG8_SA
#undef PG8_SB
#undef PG8_STAGE
#undef PG8_STAGE_A
#undef PG8_STAGE_U
#undef PG8_STAGE_B
#undef PG8_GOFF
#undef PG8_GCVT
#undef PG8_LDA
#undef PG8_LDB
#undef PG8_MMA
#undef PG8_WAIT_V
#undef PG8_WAIT_L
#undef PG8_BAR
#undef PG8_SCHED
}
}
using pg8::Unit;

struct PlainSched {
    const char* A; const char* B; int nM, nN, nwg, G, c; size_t tA, tB;
    DI void init(const void* A_, const void* B_, int M, int N, int lda, int ldb, int G_, int c_) { A = (const char*)A_; B = (const char*)B_; nM = M / 256; nN = N / 256; nwg = nM * nN; G = G_; c = c_; tA = (size_t)256 * lda * 2; tB = (size_t)256 * ldb * 2; }
    DI bool next(int i, Unit& u) const {
        const long L = (long)i * G + c; if (L >= nwg) return false;
        int wgid = (int)L; { const int q = nwg / 8, r = nwg % 8, xcd = wgid % 8, off = wgid / 8; wgid = (xcd < r ? xcd * (q + 1) : r * (q + 1) + (xcd - r) * q) + off; }
        const int nig = 8 * nN, gid = wgid / nig, fm = gid * 8, gsz = (nM - fm) < 8 ? (nM - fm) : 8;
        u.pm = fm + ((wgid % nig) % gsz); u.pn = (wgid % nig) / gsz; u.e = 0; u.j = 0; u.n = 0; u.half = 0;
        u.A = A + (size_t)u.pm * tA; u.B = B + (size_t)u.pn * tB; return true;
    }
    DI int gather_row(const Unit&, int) const { return 0; }
};
struct GroupSched {
    const char* A; const char* B; int nM, nN, G, c; size_t gA, gB, tA, tB;
    DI void init(const void* A_, const void* B_, int nM_, int nN_, int lda, int ldb, int brows, int G_, int c_) { A = (const char*)A_; B = (const char*)B_; nM = nM_; nN = nN_; G = G_; c = c_;
        gA = (size_t)CROWS * lda * 2; gB = (size_t)brows * ldb * 2; tA = (size_t)256 * lda * 2; tB = (size_t)256 * ldb * 2; }
    DI bool next(int i, Unit& u) const {
        const int L = i * G + c; const int per = nM * nN; if (L >= NG * per) return false;
        const int g = L / per, r = L % per; u.e = g; u.pm = r % nM; u.pn = r / nM; u.j = 0; u.n = 0; u.half = 0;
        u.A = A + (size_t)g * gA + (size_t)u.pm * tA; u.B = B + (size_t)g * gB + (size_t)u.pn * tB; return true;
    }
    DI int gather_row(const Unit&, int) const { return 0; }
};
struct MoeSched {
    const char* A; const char* B; const int2* lists; const LAS int* tb; const LAS int* cnt;
    int nN, GM, G, c; size_t eB, tB, tA; bool gather;
    const LAS int* ul;
    DI void build(volatile LAS int* ulw, int tid) const {
        if (tid < 32) { const int L = tid * G + c; const int xcd = L & 7, q = L >> 3; const int sr = (q >> 5) * 8 + xcd, slot = q & 31;
            int mt = sr * GM + (slot % GM), nt_ = slot / GM; const int Mt = tb[32];
            bool ok = mt < Mt; int half = 0;
            const int rl = (Mt + 8 * GM - 1) / (8 * GM) - 1, m0 = rl * 8 * GM, Vm = Mt - m0, V = Vm * nN;
            if (tid == rl && 2 * V <= G) { ok = c < 2 * V; const int v = c >> 1; mt = m0 + (ok ? v % Vm : 0); nt_ = ok ? v / Vm : 0; half = 1 + (c & 1); }
            int e = 0; for (int k = 1; k < 32; ++k) e += (tb[k] <= mt) ? 1 : 0;
            ulw[tid * 8 + 0] = ok ? mt : -1; ulw[tid * 8 + 1] = e; ulw[tid * 8 + 2] = mt - tb[e]; ulw[tid * 8 + 3] = cnt[e]; ulw[tid * 8 + 4] = nt_; ulw[tid * 8 + 5] = half; }
    }
    DI bool next(int i, Unit& u) const {
        if (i >= 32) return false;
        const int mt = __builtin_amdgcn_readfirstlane(ul[i * 8 + 0]);
        if (mt < 0) return false;
        const int e = __builtin_amdgcn_readfirstlane(ul[i * 8 + 1]), nt_ = __builtin_amdgcn_readfirstlane(ul[i * 8 + 4]);
        u.e = e; u.pm = mt; u.pn = nt_; u.j = __builtin_amdgcn_readfirstlane(ul[i * 8 + 2]); u.n = __builtin_amdgcn_readfirstlane(ul[i * 8 + 3]); u.half = __builtin_amdgcn_readfirstlane(ul[i * 8 + 5]);
        u.A = gather ? A : A + (size_t)mt * tA;
        u.B = B + (size_t)e * eB + (size_t)nt_ * tB; return true;
    }
    DI int gather_row(const Unit& u, int r) const {
        const int li = u.j * 256 + r; const int n = u.n;
        const char* lb = (const char*)lists + (size_t)u.e * LIST_CAP * 8;
        int tok = 0; if (li < n) tok = *(const int*)(lb + (unsigned)li * 8u) >> 2;
        return tok;
    }
};

#define EPI_ROWS_BEGIN _Pragma("unroll") for (int ai = 0; ai < 2; ++ai) _Pragma("unroll") for (int m = 0; m < 4; ++m) { const int rt = 128 * ai + 64 * wr + 16 * m + fr;
#define EPI_ROWS_END }
DI u32x4 pack8(const f32x4& a, const f32x4& b) { u32x4 w; w.x = pk2(a[0], a[1]); w.y = pk2(a[2], a[3]); w.z = pk2(b[0], b[1]); w.w = pk2(b[2], b[3]); return w; }
DI void unpack8(const u32x4& w, f32x4& a, f32x4& b) { a[0] = bflo(w.x); a[1] = bfhi(w.x); a[2] = bflo(w.y); a[3] = bfhi(w.y); b[0] = bflo(w.z); b[1] = bfhi(w.z); b[2] = bflo(w.w); b[3] = bfhi(w.w); }

struct EpiScaled {
    static constexpr bool PERM = true;
    bf16_t* o; int ldc; float sc;
    DI void operator()(const f32x4 (&acc)[2][2][4][2], const Unit& u, int wr, int wc, int fr, int fq) const {
        EPI_ROWS_BEGIN
            const size_t row = (size_t)u.pm * 256 + rt;
#pragma unroll
            for (int bj = 0; bj < 2; ++bj) *(u32x4*)(o + row * ldc + u.pn * 256 + bj * 128 + 32 * wc + 8 * fq) = pack8(acc[ai][bj][m][0] * sc, acc[ai][bj][m][1] * sc);
        EPI_ROWS_END
    }
};
struct EpiK {
    static constexpr bool PERM = true;
    bf16_t* k; float* kmean; float sc;
    DI void operator()(const f32x4 (&acc)[2][2][4][2], const Unit& u, int wr, int wc, int fr, int fq) const {
        const int c0 = u.pn * 256 + 32 * wc + 8 * fq; const int ln = fq * 16 + fr;
        EPI_ROWS_BEGIN
            const size_t row = (size_t)u.pm * 256 + rt;
#pragma unroll
            for (int bj = 0; bj < 2; ++bj) *(u32x4*)(k + row * AW + c0 + bj * 128) = pack8(acc[ai][bj][m][0] * sc, acc[ai][bj][m][1] * sc);
        EPI_ROWS_END
#pragma unroll
        for (int bj = 0; bj < 2; ++bj)
#pragma unroll
            for (int n = 0; n < 2; ++n) { f32x4 s = (f32x4){0.f, 0.f, 0.f, 0.f};
#pragma unroll
                for (int ai = 0; ai < 2; ++ai)
#pragma unroll
                    for (int m = 0; m < 4; ++m) s += acc[ai][bj][m][n];
#pragma unroll
                for (int j = 0; j < 4; ++j) { float x = s[j]; x += shx(x, 1, ln); x += shx(x, 2, ln); x += shx(x, 4, ln); x += shx(x, 8, ln); s[j] = x; }
                if (fr == 0) { float* dst = kmean + (size_t)u.pm * AW + c0 + bj * 128 + 4 * n;
#pragma unroll
                    for (int j = 0; j < 4; ++j) unsafeAtomicAdd(dst + j, s[j] * sc); }
                asm volatile("" ::: "memory"); }
    }
};
struct EpiU {
    static constexpr bool PERM = true;
    bf16_t* ua; float sc;
    DI void operator()(const f32x4 (&acc)[2][2][4][2], const Unit& u, int wr, int wc, int fr, int fq) const {
        EPI_ROWS_BEGIN
            const int row = u.pm * 256 + rt;
#pragma unroll
            for (int bj = 0; bj < 2; ++bj) { const int ch = u.pn * 256 + bj * 128 + 32 * wc + 8 * fq; const int g = ch >> 4, c0 = ch & 15;
                *(u32x4*)(ua + ((size_t)g * CROWS + (row >> 5)) * UAK + (row & 31) * 16 + c0) = pack8(acc[ai][bj][m][0] * sc, acc[ai][bj][m][1] * sc); }
        EPI_ROWS_END
    }
};
struct EpiSig {
    static constexpr bool PERM = true;
    unsigned char* o; float sc;
    DI void operator()(const f32x4 (&acc)[2][2][4][2], const Unit& u, int wr, int wc, int fr, int fq) const {
        const float s2 = sc * GATE8_SCALE;
        EPI_ROWS_BEGIN
            const size_t row = (size_t)u.pm * 256 + rt;
#pragma unroll
            for (int bj = 0; bj < 2; ++bj) { const f32x4 a = acc[ai][bj][m][0] * s2, b = acc[ai][bj][m][1] * s2;
                u32x2 w; w.x = pk4_fp8(a[0], a[1], a[2], a[3]); w.y = pk4_fp8(b[0], b[1], b[2], b[3]);
                *(u32x2*)(o + row * D + u.pn * 256 + bj * 128 + 32 * wc + 8 * fq) = w; }
        EPI_ROWS_END
    }
};
struct EpiQK {
    static constexpr bool PERM = true;
    bf16_t *q, *k; float* kmean; float sc;
    DI void operator()(const f32x4 (&acc)[2][2][4][2], const Unit& u, int wr, int wc, int fr, int fq) const {
        Unit u2 = u; u2.pn = u.pn & 1;
        if (u.pn < 2) { EpiScaled E{q, AW, sc * (0.125f * LOG2E_C)}; E(acc, u2, wr, wc, fr, fq); }
        else { EpiK E{k, kmean, sc}; E(acc, u2, wr, wc, fr, fq); }
    }
};
struct EpiVUG {
    static constexpr bool PERM = true;
    bf16_t *v, *ua; unsigned char *ga, *gs; float sc;
    DI void operator()(const f32x4 (&acc)[2][2][4][2], const Unit& u, int wr, int wc, int fr, int fq) const {
        Unit u2 = u;
        if (u.pn < 2) { EpiScaled E{v, AW, sc}; E(acc, u2, wr, wc, fr, fq); }
        else if (u.pn < 4) { u2.pn = u.pn - 2; EpiU E{ua, sc}; E(acc, u2, wr, wc, fr, fq); }
        else { u2.pn = (u.pn - 4) & 3; EpiSig E{u.pn < 8 ? ga : gs, sc}; E(acc, u2, wr, wc, fr, fq); }
    }
};
struct EpiG1 {
    static constexpr bool PERM = true;
    EpiQK a; EpiVUG b;
    DI void operator()(const f32x4 (&acc)[2][2][4][2], const Unit& u, int wr, int wc, int fr, int fq) const {
        if (u.pn < 4) a(acc, u, wr, wc, fr, fq); else { Unit u2 = u; u2.pn = u.pn - 4; b(acc, u2, wr, wc, fr, fq); }
    }
};
struct EpiState {
    static constexpr bool PERM = false;
    float* e;
    DI void operator()(const f32x4 (&acc)[2][2][4][2], const Unit& u, int wr, int wc, int fr, int fq) const {
        EPI_ROWS_BEGIN
            float* rowp = e + ((size_t)u.e * CROWS + u.pm * 256 + rt) * 128 + 32 * wc + 4 * fq;
#pragma unroll
            for (int n = 0; n < 2; ++n) *(f32x4*)(rowp + 16 * n) = acc[ai][0][m][n];
        EPI_ROWS_END
    }
};
struct EpiSsmOut {
    static constexpr bool PERM = true;
    bf16_t* y;
    DI void operator()(const f32x4 (&acc)[2][2][4][2], const Unit& u, int wr, int wc, int fr, int fq) const {
        EPI_ROWS_BEGIN
            const int R = u.pm * 256 + rt;
#pragma unroll
            for (int bj = 0; bj < 2; ++bj) { const int col = u.pn * 256 + bj * 128 + 32 * wc + 8 * fq; const int j = col >> 4, c0 = col & 15;
                f32x4 a = acc[ai][bj][m][0], b = acc[ai][bj][m][1];
#pragma unroll
                for (int q = 0; q < 4; ++q) { a[q] = gelu_tanh(a[q]); b[q] = gelu_tanh(b[q]); }
                *(u32x4*)(y + ((size_t)R * 32 + j) * SW + u.e * 16 + c0) = pack8(a, b); }
        EPI_ROWS_END
    }
};
struct EpiGlu {
    static constexpr bool PERM = true;
    unsigned char* z;
    DI void operator()(const f32x4 (&acc)[2][2][4][2], const Unit& u, int wr, int wc, int fr, int fq) const {
        EPI_ROWS_BEGIN
            const size_t row = (size_t)u.pm * 256 + rt; f32x4 a = acc[ai][0][m][0], b = acc[ai][0][m][1]; const f32x4 ga = acc[ai][1][m][0], gb = acc[ai][1][m][1];
#pragma unroll
            for (int q = 0; q < 4; ++q) { a[q] *= AZ8_SCALE * sigmoidf_(ga[q]); b[q] *= AZ8_SCALE * sigmoidf_(gb[q]); }
            u32x2 w; w.x = pk4_fp8(a[0], a[1], a[2], a[3]); w.y = pk4_fp8(b[0], b[1], b[2], b[3]);
            *(u32x2*)(z + row * D + AW + u.pn * 128 + 32 * wc + 8 * fq) = w;
        EPI_ROWS_END
    }
};
struct EpiMerge {
    static constexpr bool PERM = true; static constexpr int MID_T = 4;
    unsigned char* mrg; const unsigned char* gatt; const unsigned char* gssm;
    const LAS float* t1; const LAS float* t2;
    DI void mid(f32x4 (&acc)[2][2][4][2], const Unit& u, int wr, int wc, int fr, int fq) const {
#pragma unroll
        for (int ai = 0; ai < 2; ++ai) {
            u32x2 ga[4][2], gs[4][2];
#pragma unroll
            for (int m = 0; m < 4; ++m) { const size_t row = (size_t)u.pm * 256 + 128 * ai + 64 * wr + 16 * m + fr;
#pragma unroll
                for (int bj = 0; bj < 2; ++bj) { const size_t off = row * D + u.pn * 256 + bj * 128 + 32 * wc + 8 * fq; ga[m][bj] = *(const u32x2*)(gatt + off); gs[m][bj] = *(const u32x2*)(gssm + off); } }
            asm volatile("" ::: "memory");
#pragma unroll
            for (int m = 0; m < 4; ++m)
#pragma unroll
                for (int bj = 0; bj < 2; ++bj) {
#pragma unroll
                    for (int q = 0; q < 4; ++q) {
                        acc[ai][bj][m][0][q] *= t2[(gs[m][bj].x >> (8 * q)) & 255u] * t1[(ga[m][bj].x >> (8 * q)) & 255u];
                        acc[ai][bj][m][1][q] *= t2[(gs[m][bj].y >> (8 * q)) & 255u] * t1[(ga[m][bj].y >> (8 * q)) & 255u]; } }
            asm volatile("" ::: "memory"); }
    }
    DI void operator()(const f32x4 (&acc)[2][2][4][2], const Unit& u, int wr, int wc, int fr, int fq) const {
#pragma unroll
        for (int ai = 0; ai < 2; ++ai) {
            u32x2 gs[4][2];
#pragma unroll
            for (int m = 0; m < 4; ++m) { const size_t row = (size_t)u.pm * 256 + 128 * ai + 64 * wr + 16 * m + fr;
#pragma unroll
                for (int bj = 0; bj < 2; ++bj) gs[m][bj] = *(const u32x2*)(gssm + row * D + u.pn * 256 + bj * 128 + 32 * wc + 8 * fq); }
            asm volatile("" ::: "memory");
#pragma unroll
            for (int m = 0; m < 4; ++m) { const size_t row = (size_t)u.pm * 256 + 128 * ai + 64 * wr + 16 * m + fr;
#pragma unroll
                for (int bj = 0; bj < 2; ++bj) { const size_t off = row * D + u.pn * 256 + bj * 128 + 32 * wc + 8 * fq;
                    f32x4 sa, sb;
#pragma unroll
                    for (int q = 0; q < 4; ++q) { sa[q] = (MRG8_SCALE / (W8_SCALE * AZ8_SCALE)) * t1[(gs[m][bj].x >> (8 * q)) & 255u]; sb[q] = (MRG8_SCALE / (W8_SCALE * AZ8_SCALE)) * t1[(gs[m][bj].y >> (8 * q)) & 255u]; }
                    const f32x4 va = acc[ai][bj][m][0] * sa, vb = acc[ai][bj][m][1] * sb;
                    u32x2 w; w.x = pk4_fp8(va[0], va[1], va[2], va[3]); w.y = pk4_fp8(vb[0], vb[1], vb[2], vb[3]);
                    *(u32x2*)(mrg + off) = w; } }
            asm volatile("" ::: "memory"); }
    }
};
template <bool ADD> struct EpiGate {
    static constexpr bool PERM = true;
    bf16_t* mrg; const bf16_t* gate;
    DI void operator()(const f32x4 (&acc)[2][2][4][2], const Unit& u, int wr, int wc, int fr, int fq) const {
        EPI_ROWS_BEGIN
            const size_t row = (size_t)u.pm * 256 + rt;
#pragma unroll
            for (int bj = 0; bj < 2; ++bj) { const size_t off = row * D + u.pn * 256 + bj * 128 + 32 * wc + 8 * fq;
                f32x4 ga, gb; unpack8(*(const u32x4*)(gate + off), ga, gb);
                f32x4 a = acc[ai][bj][m][0] * ga, b = acc[ai][bj][m][1] * gb;
                if (ADD) { f32x4 pa, pb; unpack8(*(const u32x4*)(mrg + off), pa, pb); a += pa; b += pb; }
                *(u32x4*)(mrg + off) = pack8(a, b); }
        EPI_ROWS_END
    }
};
struct EpiPlain {
    static constexpr bool PERM = true;
    bf16_t* o; int ldc; float sc;
    DI void operator()(const f32x4 (&acc)[2][2][4][2], const Unit& u, int wr, int wc, int fr, int fq) const {
        EPI_ROWS_BEGIN
            const size_t row = (size_t)u.pm * 256 + rt;
#pragma unroll
            for (int bj = 0; bj < 2; ++bj) *(u32x4*)(o + row * ldc + u.pn * 256 + bj * 128 + 32 * wc + 8 * fq) = pack8(acc[ai][bj][m][0] * sc, acc[ai][bj][m][1] * sc);
        EPI_ROWS_END
    }
};
struct EpiSwiglu {
    static constexpr bool PERM = true;
    unsigned char* act; const float* b1;
    DI void operator()(const f32x4 (&acc)[2][2][4][2], const Unit& u, int wr, int wc, int fr, int fq) const {
        int lrow = 64 * wr + fr; asm volatile("" : "+v"(lrow));
        const int cj = u.pn * 128 + 32 * wc + 8 * fq; const float* bb = b1 + (size_t)u.e * 2048 + cj;
        const f32x4 bg0 = *(const f32x4*)(bb), bg1 = *(const f32x4*)(bb + 4), bu0 = *(const f32x4*)(bb + 1024), bu1 = *(const f32x4*)(bb + 1028);
        unsigned char* abase = act + (size_t)u.pm * 256 * DFF;
        constexpr float dq = 1.0f / (W8_SCALE * H8_SCALE * PROBE_KREP);
#pragma unroll
        for (int ai = 0; ai < 2; ++ai) { if (u.half == 2 - ai) continue;
#pragma unroll
            for (int m = 0; m < 4; ++m) { const unsigned off = (unsigned)((128 * ai + 16 * m + lrow) * DFF + cj);
            f32x4 g0 = acc[ai][0][m][0] * dq + bg0, g1 = acc[ai][0][m][1] * dq + bg1, u0 = acc[ai][1][m][0] * dq + bu0, u1 = acc[ai][1][m][1] * dq + bu1;
            unsigned wv[2];
#pragma unroll
            for (int hv = 0; hv < 2; ++hv) { const f32x4 gq = hv ? g1 : g0, uq = hv ? u1 : u0; int r = 0;
#pragma unroll
                for (int q = 0; q < 4; q += 2) {
                    f32x2 g = {fminf(gq[q], 7.0f), fminf(gq[q + 1], 7.0f)};
                    const f32x2 up = {fminf(fmaxf(uq[q], -7.0f), 7.0f), fminf(fmaxf(uq[q + 1], -7.0f), 7.0f)};
                    f32x2 t = __builtin_elementwise_fma(up, (f32x2){ACT8_SCALE, ACT8_SCALE}, (f32x2){ACT8_SCALE, ACT8_SCALE}) * g;
                    const f32x2 a = g * (f32x2){-1.702f * 1.4426950408889634f, -1.702f * 1.4426950408889634f};
                    f32x2 e = {__builtin_amdgcn_exp2f(a[0]), __builtin_amdgcn_exp2f(a[1])}; e = e + (f32x2){1.0f, 1.0f};
                    const f32x2 rc = {__builtin_amdgcn_rcpf(e[0]), __builtin_amdgcn_rcpf(e[1])};
                    t = t * rc;
                    r = q ? __builtin_amdgcn_cvt_pk_fp8_f32(t[0], t[1], r, true) : __builtin_amdgcn_cvt_pk_fp8_f32(t[0], t[1], r, false); }
                wv[hv] = (unsigned)r; }
            u32x2 w; w.x = wv[0]; w.y = wv[1];
            *(u32x2*)(abase + off) = w;
            asm volatile("" ::: "memory"); } }
    }
};
struct EpiMoeOut {
    static constexpr bool PERM = true;
    bf16_t* yslot; const float* b2; const int2* lists;
    DI void operator()(const f32x4 (&acc)[2][2][4][2], const Unit& u, int wr, int wc, int fr, int fq) const {
        int lrow = 64 * wr + fr, cwl = 32 * wc + 8 * fq; asm volatile("" : "+v"(lrow), "+v"(cwl));
        const int n = u.n; const int cw = u.pn * 256 + cwl;
        const char* lb = (const char*)lists + (size_t)u.e * LIST_CAP * 8;
        f32x4 bv[2][2];
#pragma unroll
        for (int bj = 0; bj < 2; ++bj) { const float* bb = b2 + (size_t)u.e * D + cw + bj * 128; bv[bj][0] = *(const f32x4*)bb; bv[bj][1] = *(const f32x4*)(bb + 4); }
        constexpr float dq = 1.0f / (W8_SCALE * ACT8_SCALE);
#pragma unroll
        for (int ai = 0; ai < 2; ++ai) { if (u.half == 2 - ai) continue;
            int2 ent[4];
#pragma unroll
            for (int m = 0; m < 4; ++m) { const int li = u.j * 256 + 128 * ai + 16 * m + lrow; ent[m] = *(const int2*)(lb + (unsigned)(li < n ? li : 0) * 8u); }
#pragma unroll
            for (int m = 0; m < 4; ++m) { const int li = u.j * 256 + 128 * ai + 16 * m + lrow; const float gw = __int_as_float(ent[m].y);
                char* dst = (char*)yslot + ((unsigned)ent[m].x * (unsigned)D + (unsigned)cw);
                const float gs = gw * YS8_SCALE;
                const f32x4 a0 = (acc[ai][0][m][0] * dq + bv[0][0]) * gs, a1 = (acc[ai][0][m][1] * dq + bv[0][1]) * gs, b0 = (acc[ai][1][m][0] * dq + bv[1][0]) * gs, b1 = (acc[ai][1][m][1] * dq + bv[1][1]) * gs;
                u32x2 w0, w1; w0.x = pk4_fp8(a0[0], a0[1], a0[2], a0[3]); w0.y = pk4_fp8(a1[0], a1[1], a1[2], a1[3]); w1.x = pk4_fp8(b0[0], b0[1], b0[2], b0[3]); w1.y = pk4_fp8(b1[0], b1[1], b1[2], b1[3]);
                if (li < n) { *(u32x2*)dst = w0; *(u32x2*)(dst + 128) = w1; } }
            asm volatile("" ::: "memory"); }
    }
};

struct Frame {
    LAS unsigned char* lds; volatile LAS unsigned* MISC; unsigned* ctl;
    int tid, lane, wave, G, bid;
    float* out; unsigned char* ws;
};
enum { I_X = 0, I_C, I_RELB, I_WADA, I_BADA, I_GPREMIX, I_GPOSTMIX, I_GPREFFN, I_GPOSTFFN, I_WIN, I_ARE, I_AIM, I_LOGDT, I_BRE, I_BIM, I_CRE, I_CIM, I_DSKIP,
       I_WGLU, I_WSSMO, I_WATTO, I_WOUT, I_WROUTER, I_BROUTER, I_WEXPIN, I_BEXPIN, I_WEXPOUT, I_BEXPOUT };
typedef const GAS float* __attribute__((address_space(4))) * kptr_t;
DI kptr_t kargs_now() { kptr_t p = (kptr_t)__builtin_amdgcn_kernarg_segment_ptr(); asm volatile("" : "+s"(p)); return p; }
DI const float* inp(kptr_t k, int i) { return (const float*)k[i]; }
DI unsigned char* opaque_ws(Frame& F) { GAS unsigned char* w = (GAS unsigned char*)F.ws; asm volatile("" : "+s"(w)); return (unsigned char*)w; }
DI void refresh(Frame& F) { int w = F.wave; unsigned ones_ = ~0u; asm volatile("" : "+s"(w), "+s"(ones_)); int ln = (int)__builtin_amdgcn_mbcnt_hi(ones_, __builtin_amdgcn_mbcnt_lo(ones_, 0u)); asm volatile("" : "+v"(ln)); F.tid = w * 64 + ln; F.lane = ln; F.wave = w; int b = blockIdx.x; asm volatile("" : "+s"(b)); F.bid = b; }

struct TItem { const float* W; unsigned char* WT; int N, Kd, kofs, drow0, k0, n0; bool f8, valid; };
DI void item_load(const TItem& d, f32x4 (&v)[16], int lane) {
    const int r4 = lane >> 4, c4 = lane & 15;
    const char* base = (const char*)(d.W + (size_t)d.k0 * d.N + d.n0);
    unsigned voff = (unsigned)(r4 * d.N + 4 * c4) * 4u; asm volatile("" : "+v"(voff));
    const size_t rstep = (size_t)d.N * 16;
#pragma unroll
    for (int i = 0; i < 16; ++i) v[i] = __builtin_nontemporal_load((const f32x4*)(base + i * rstep + voff));
}
DI void item_scatter(const f32x4 (&v)[16], LAS float* scr, int lane) {
    const int r4 = lane >> 4, c4 = lane & 15;
#pragma unroll
    for (int i = 0; i < 16; ++i) { const int k = 4 * i + r4;
#pragma unroll
        for (int j = 0; j < 4; ++j) scr[(4 * c4 + j) * 64 + (k ^ (4 * (c4 ^ j)))] = v[i][j]; }
    LDS_WAIT(); asm volatile("" ::: "memory");
}
template <bool F8> DI void item_gather(const TItem& d, LAS float* scr, int lane) {
    if constexpr (F8) {
        const int nl = lane >> 2, kc = lane & 3;
        unsigned char* base = d.WT + (size_t)d.drow0 * d.Kd + d.kofs + d.k0;
        unsigned voff = (unsigned)(nl * d.Kd + 16 * kc); asm volatile("" : "+v"(voff));
        f32x4 x[16];
#pragma unroll
        for (int t = 0; t < 4; ++t) { const int n = nl + 16 * t; const int sw = 4 * (((n >> 2) & 15) ^ (n & 3));
#pragma unroll
            for (int q = 0; q < 4; ++q) { const int kq = 16 * kc + 4 * q; x[t * 4 + q] = *(const LAS f32x4*)(scr + n * 64 + (kq ^ sw)); } }
        asm volatile("s_waitcnt lgkmcnt(0)" : "+v"(x[0]), "+v"(x[1]), "+v"(x[2]), "+v"(x[3]), "+v"(x[4]), "+v"(x[5]), "+v"(x[6]), "+v"(x[7]),
                     "+v"(x[8]), "+v"(x[9]), "+v"(x[10]), "+v"(x[11]), "+v"(x[12]), "+v"(x[13]), "+v"(x[14]), "+v"(x[15]) :: "memory");
#pragma unroll
        for (int t = 0; t < 4; ++t) { u32x4 o;
#pragma unroll
            for (int q = 0; q < 4; ++q) { const f32x4 y = x[t * 4 + q]; o[q] = pk4_fp8(y[0] * W8_SCALE, y[1] * W8_SCALE, y[2] * W8_SCALE, y[3] * W8_SCALE); }
            *(u32x4*)(base + (size_t)t * 16 * d.Kd + voff) = o; }
    } else {
        const int nl = lane >> 3, kc = lane & 7;
        unsigned char* base = d.WT + ((size_t)d.drow0 * d.Kd + d.kofs + d.k0) * 2;
        unsigned voff = (unsigned)(nl * d.Kd + 8 * kc) * 2u; asm volatile("" : "+v"(voff));
        f32x4 x[16];
#pragma unroll
        for (int t = 0; t < 8; ++t) { const int n = nl + 8 * t; const int sw = 4 * (((n >> 2) & 15) ^ (n & 3));
#pragma unroll
            for (int q = 0; q < 2; ++q) { const int kq = 8 * kc + 4 * q; x[t * 2 + q] = *(const LAS f32x4*)(scr + n * 64 + (kq ^ sw)); } }
        asm volatile("s_waitcnt lgkmcnt(0)" : "+v"(x[0]), "+v"(x[1]), "+v"(x[2]), "+v"(x[3]), "+v"(x[4]), "+v"(x[5]), "+v"(x[6]), "+v"(x[7]),
                     "+v"(x[8]), "+v"(x[9]), "+v"(x[10]), "+v"(x[11]), "+v"(x[12]), "+v"(x[13]), "+v"(x[14]), "+v"(x[15]) :: "memory");
#pragma unroll
        for (int t = 0; t < 8; ++t) { u32x4 o;
#pragma unroll
            for (int q = 0; q < 2; ++q) { const f32x4 y = x[t * 2 + q]; o[2 * q] = pk2(y[0], y[1]); o[2 * q + 1] = pk2(y[2], y[3]); }
            *(u32x4*)(base + (size_t)t * 8 * d.Kd * 2 + voff) = o; }
    }
    LDS_WAIT(); asm volatile("" ::: "memory");
}
DI int imap(int n, int H) { return ((n % H) / 128) * 256 + (n / H) * 128 + (n % 128); }
constexpr int IT_IN = 16 * 64, IT_GLU = 8 * 16, IT_ATT = 8 * 16, IT_SSMO = 8 * 16, IT_OUT = 16 * 16, IT_W1 = 16 * 32, IT_W2 = 16 * 16;
constexpr int IT_LAYER = IT_IN + IT_GLU + IT_ATT + IT_SSMO + IT_OUT + NE * (IT_W1 + IT_W2);
constexpr int IT_SMALL = IT_IN + IT_GLU + IT_ATT + IT_SSMO + IT_OUT, IT_EXP = NE * (IT_W1 + IT_W2);
DI TItem decode_item(kptr_t KA, unsigned char* ws, int kind, int it) {
    TItem d; d.valid = it < (kind == 0 ? DEPTH * IT_SMALL : IT_EXP); if (!d.valid) it = 0;
    const int l = kind == 0 ? it / IT_SMALL : kind - 1; int r = kind == 0 ? it % IT_SMALL : IT_SMALL + it;
    const float* W; unsigned char* WT; int K, N, H = 0; bool f8 = false;
    int nsub = 0, Kd = 0, kofs = 0;
    if (r < IT_IN) { W = inp(KA, I_WIN) + (size_t)l * D * INW; K = D; N = INW;
        WT = ws + WS_WIN + (size_t)l * INW * D; f8 = true; }
    else if ((r -= IT_IN) < IT_GLU) { W = inp(KA, I_WGLU) + (size_t)l * SW * 1024; WT = ws + WS_WGLU + (size_t)l * 1024 * SW * 2; K = SW; N = 1024; H = 512; }
    else if ((r -= IT_GLU) < IT_ATT) { W = inp(KA, I_WATTO) + (size_t)l * AW * D; WT = ws + WS_WCAT + (size_t)l * D * D; K = AW; N = D; Kd = D; f8 = true; }
    else if ((r -= IT_ATT) < IT_SSMO) { W = inp(KA, I_WSSMO) + (size_t)l * SW * D; WT = ws + WS_WCAT + (size_t)l * D * D; K = SW; N = D; Kd = D; kofs = AW; f8 = true; }
    else if ((r -= IT_SSMO) < IT_OUT) { W = inp(KA, I_WOUT) + (size_t)l * D * D; WT = ws + WS_WOUT + (size_t)l * D * D; K = D; N = D; f8 = true; }
    else if ((r -= IT_OUT) < NE * IT_W1) { const int e = r / IT_W1; r %= IT_W1; W = inp(KA, I_WEXPIN) + ((size_t)l * NE + e) * D * 2048; WT = ws + WS_W1 + ((size_t)l * NE + e) * 2048 * D; K = D; N = 2048; H = 1024; f8 = true; }
    else { r -= NE * IT_W1; const int e = r / IT_W2; r %= IT_W2; W = inp(KA, I_WEXPOUT) + ((size_t)l * NE + e) * DFF * D; WT = ws + WS_W2 + ((size_t)l * NE + e) * D * DFF; K = DFF; N = D; f8 = true; }
    const int nblk = N / 64, kb = r / nblk, nb = r % nblk, n0 = nb * 64;
    d.W = W; d.WT = WT; d.N = N; d.Kd = Kd ? Kd : K; d.kofs = kofs; d.drow0 = (H ? imap(n0, H) : n0) - nsub; d.k0 = kb * 64; d.n0 = n0; d.f8 = f8;
    return d;
}
struct QState { int base, cnt; };
DI void run_items1(Frame& F, int kind, int quota, QState& q) {
    const kptr_t KA = kargs_now();
    LAS float* scr = (LAS float*)(F.lds + F.wave * 16384);
    unsigned* qctr = F.ctl + CW_QUEUE + 64 * kind;
#define RI_NEXT(D_) do { if (q.cnt == 8) { int b_ = 0; if (F.lane == 0) b_ = (int)__hip_atomic_fetch_add(qctr, 8u, __ATOMIC_RELAXED, __HIP_MEMORY_SCOPE_AGENT); q.base = __builtin_amdgcn_readfirstlane(b_); q.cnt = 0; } \
        D_ = decode_item(KA, F.ws, kind, q.base + q.cnt); ++q.cnt; } while (0)
    if (quota == 0) return;
    TItem d; RI_NEXT(d); if (!d.valid) return;
    f32x4 v[16]; item_load(d, v, F.lane);
    for (int n = 1; ; ++n) {
        item_scatter(v, scr, F.lane);
        TItem dn; dn.valid = false;
        if (quota < 0 || n < quota) { RI_NEXT(dn); if (dn.valid) item_load(dn, v, F.lane); }
        if (d.f8) item_gather<true>(d, scr, F.lane); else item_gather<false>(d, scr, F.lane);
        if (!dn.valid) break;
        d = dn;
    }
#undef RI_NEXT
}
DI void p_transposes(Frame& F) { refresh(F); QState q; q.base = 0; q.cnt = 8; run_items1(F, 0, -1, q); }
DI void p_adaln_unit(Frame& F, int unit) {
    refresh(F);
    const kptr_t KA = kargs_now();
    const int l = unit / 96, cb = unit % 96;
    LAS float* condT = (LAS float*)F.lds;
    LAS float* part = (LAS float*)(F.lds + 65536);
    for (int i = F.tid; i < NB * D; i += 512) { const int b = i / D, k = i % D; const float v = inp(KA, I_C)[i]; condT[k * 16 + b] = v / (1.0f + __expf(-v)); }
    __syncthreads();
    float acc[16];
#pragma unroll
    for (int b = 0; b < 16; ++b) acc[b] = 0.f;
    const float* wp = inp(KA, I_WADA) + (size_t)l * D * (NMOD * D) + cb * 64 + F.lane;
    for (int k0 = 0; k0 < 128; k0 += 32) {
        float wv[32];
#pragma unroll
        for (int kk = 0; kk < 32; ++kk) wv[kk] = wp[(size_t)(F.wave * 128 + k0 + kk) * (NMOD * D)];
#pragma unroll
        for (int kk = 0; kk < 32; ++kk) { const int k = F.wave * 128 + k0 + kk; const float w = wv[kk];
            const LAS f32x4* cp = (const LAS f32x4*)(condT + k * 16);
#pragma unroll
            for (int q = 0; q < 4; ++q) { const f32x4 cv = cp[q]; acc[4 * q] += cv[0] * w; acc[4 * q + 1] += cv[1] * w; acc[4 * q + 2] += cv[2] * w; acc[4 * q + 3] += cv[3] * w; } } }
#pragma unroll
    for (int b = 0; b < 16; ++b) part[(F.wave * 16 + b) * 64 + F.lane] = acc[b];
    __syncthreads();
    float* mod = (float*)(F.ws + WS_MOD);
    for (int o = F.tid; o < 1024; o += 512) { const int b = o >> 6, col = o & 63; float s = inp(KA, I_BADA)[(size_t)l * NMOD * D + cb * 64 + col];
#pragma unroll
        for (int w = 0; w < 8; ++w) s += part[(w * 16 + b) * 64 + col];
        mod[((size_t)l * NB + b) * (NMOD * D) + cb * 64 + col] = s; }
    __syncthreads();
}
DI double exp_d(double x) {
    const double kf = __builtin_rint(x * 1.4426950408889634); const double r = x - kf * 0.6931471805599453094;
    double t = 1.0, s = 1.0;
#pragma unroll
    for (int i = 1; i <= 16; ++i) { t *= r * (1.0 / (double)i); s += t; }
    const int k = (int)kf;
    return __builtin_ldexp(s, k);
}
DI void sincos_d(double a, double& sn, double& cs) {
    const double k = __builtin_rint(a * 0.15915494309189535); double r = __builtin_fma(-k, 6.283185307179586, a); r = __builtin_fma(-k, 2.4492935982947064e-16, r);
    const double x = r * 0.0625, x2 = x * x;
    double st = x, ct = 1.0, s = x, c = 1.0;
#pragma unroll
    for (int i = 1; i <= 9; ++i) { ct *= -x2 * (1.0 / (double)((2 * i - 1) * (2 * i))); c += ct; st *= -x2 * (1.0 / (double)((2 * i) * (2 * i + 1))); s += st; }
#pragma unroll
    for (int i = 0; i < 4; ++i) { const double s2 = 2.0 * s * c, c2 = c * c - s * s; s = s2; c = c2; }
    sn = s; cs = c;
}
DI void p_ssm_unit(Frame& F, int unit) {
    refresh(F);
    const kptr_t KA = kargs_now();
    const int l = unit / NG, g = unit % NG;
    LAS double* Lp = (LAS double*)F.lds;
    LAS float* Bb = (LAS float*)(F.lds + 33792);
    LAS float* Cc = (LAS float*)(F.lds + 50176);
    LAS float* Kt = (LAS float*)(F.lds + 66560);
    const int lg = l * NG + g;
    const double dt = exp_d((double)inp(KA, I_LOGDT)[lg]);
    for (int i = F.tid; i < 33 * 64; i += 512) { const int tau = i >> 6, p = i & 63;
        const double lre = fmin((double)inp(KA, I_ARE)[lg * SP + p], -1e-4), lim = (double)inp(KA, I_AIM)[lg * SP + p];
        const double mag = exp_d(lre * dt * (double)tau); double sn, cs; sincos_d(lim * dt * (double)tau, sn, cs);
        Lp[i * 2] = mag * cs; Lp[i * 2 + 1] = mag * sn; }
    __syncthreads();
    for (int i = F.tid; i < SP * SG; i += 512) { const int p = i >> 4, cc = i & 15;
        const double lre = fmin((double)inp(KA, I_ARE)[lg * SP + p], -1e-4), lim = (double)inp(KA, I_AIM)[lg * SP + p];
        const double nre = Lp[(64 + p) * 2] - 1.0, nim = Lp[(64 + p) * 2 + 1], den = lre * lre + lim * lim;
        const double zre = (nre * lre + nim * lim) / den, zim = (nim * lre - nre * lim) / den;
        const double br = (double)inp(KA, I_BRE)[((size_t)lg * SP + p) * SG + cc], bi = (double)inp(KA, I_BIM)[((size_t)lg * SP + p) * SG + cc];
        Bb[i * 2] = (float)(zre * br - zim * bi); Bb[i * 2 + 1] = (float)(zre * bi + zim * br); }
    for (int i = F.tid; i < SG * SP; i += 512) { Cc[i * 2] = inp(KA, I_CRE)[(size_t)lg * SG * SP + i]; Cc[i * 2 + 1] = inp(KA, I_CIM)[(size_t)lg * SG * SP + i]; }
    __syncthreads();
    LAS f32x2* Lf = (LAS f32x2*)(F.lds + 99328);
    for (int i = F.tid; i < 33 * 64; i += 512) Lf[i] = (f32x2){(float)Lp[i * 2], (float)Lp[i * 2 + 1]};
    __syncthreads();
    { const int pair = F.tid & 255, cc = pair >> 4, c2 = pair & 15, t0 = (F.tid >> 8) * 16; float acc[16];
#pragma unroll
      for (int q = 0; q < 16; ++q) acc[q] = 0.f;
      for (int p = 0; p < SP; ++p) { const float cr = Cc[(cc * 64 + p) * 2], ci = Cc[(cc * 64 + p) * 2 + 1], br = Bb[(p * 16 + c2) * 2], bi = Bb[(p * 16 + c2) * 2 + 1];
          const float gr = cr * br - ci * bi, gi = cr * bi + ci * br;
#pragma unroll
          for (int q = 0; q < 16; ++q) { const f32x2 lv = Lf[(t0 + q) * 64 + p]; acc[q] += gr * lv[0] - gi * lv[1]; } }
      if (t0 == 0 && cc == c2) acc[0] += inp(KA, I_DSKIP)[l * SW + g * 16 + cc];
#pragma unroll
      for (int q = 0; q < 16; ++q) Kt[((t0 + q) * 16 + cc) * 16 + c2] = acc[q]; }
    __syncthreads();
    bf16_t* bs = (bf16_t*)(F.ws + WS_BSSM) + (size_t)lg * 512 * UAK;
    for (int o = F.tid; o < 512 * (UAK / 8); o += 512) { const int n = o / (UAK / 8), k8 = (o % (UAK / 8)) * 8; const int j = n >> 4, cc = n & 15; float v[8];
        if (k8 < 512) { const int i = k8 >> 4, c0 = k8 & 15;
#pragma unroll
            for (int q = 0; q < 8; ++q) v[q] = (i <= j) ? Kt[((j - i) * 16 + cc) * 16 + c0 + q] : 0.f; }
        else { const int p0 = (k8 - 512) >> 1;
#pragma unroll
            for (int q = 0; q < 4; ++q) { const int p = p0 + q; const float cr = Cc[(cc * 64 + p) * 2], ci = Cc[(cc * 64 + p) * 2 + 1]; const f32x2 lv = Lf[(j + 1) * 64 + p];
                v[2 * q] = cr * lv[0] - ci * lv[1]; v[2 * q + 1] = -(cr * lv[1] + ci * lv[0]); } }
        u32x4 w; w.x = pk2(v[0], v[1]); w.y = pk2(v[2], v[3]); w.z = pk2(v[4], v[5]); w.w = pk2(v[6], v[7]);
        *(u32x4*)(bs + (size_t)n * UAK + k8) = w; }
    bf16_t* be = (bf16_t*)(F.ws + WS_BE) + (size_t)lg * 256 * 512;
    for (int o = F.tid; o < 256 * 64; o += 512) { const int n = o >> 6, k8 = (o & 63) * 8; float v[8];
        if (n < 128) { const int p = n >> 1, ri = n & 1, i = k8 >> 4, c0 = k8 & 15; const f32x2 lv = Lf[(31 - i) * 64 + p]; const float lr = lv[0], li = lv[1];
#pragma unroll
            for (int q = 0; q < 8; ++q) { const float br = Bb[(p * 16 + c0 + q) * 2], bi = Bb[(p * 16 + c0 + q) * 2 + 1]; v[q] = ri ? (lr * bi + li * br) : (lr * br - li * bi); } }
        else {
#pragma unroll
            for (int q = 0; q < 8; ++q) v[q] = 0.f; }
        u32x4 w; w.x = pk2(v[0], v[1]); w.y = pk2(v[2], v[3]); w.z = pk2(v[4], v[5]); w.w = pk2(v[6], v[7]);
        *(u32x4*)(be + (size_t)n * 512 + k8) = w; }
    float* l32 = (float*)(F.ws + WS_L32) + (size_t)lg * SP * 2;
    if (F.tid < SP) { l32[F.tid * 2] = (float)Lp[(32 * 64 + F.tid) * 2]; l32[F.tid * 2 + 1] = (float)Lp[(32 * 64 + F.tid) * 2 + 1]; }
    __syncthreads();
}

DI void load_row_f32(const float* p, int lane, f32x4 (&v)[4]) {
#pragma unroll
    for (int j = 0; j < 4; ++j) v[j] = *(const f32x4*)(p + 4 * lane + 256 * j);
}
DI float wave_sum_dpp(float v) {
#define DPP_ADD_(ctrl, rmask, bc) v += __int_as_float(__builtin_amdgcn_update_dpp(0, __float_as_int(v), ctrl, rmask, 0xf, bc))
    DPP_ADD_(0x111, 0xf, true); DPP_ADD_(0x112, 0xf, true); DPP_ADD_(0x114, 0xf, true); DPP_ADD_(0x118, 0xf, true);
    DPP_ADD_(0x142, 0xa, false); DPP_ADD_(0x143, 0xc, false);
#undef DPP_ADD_
    return __int_as_float(__builtin_amdgcn_readlane(__float_as_int(v), 63)); }
DI float sumsq(const f32x4 (&v)[4], int lane) { float s = 0.f; (void)lane;
#pragma unroll
    for (int j = 0; j < 4; ++j) s += (v[j][0] * v[j][0] + v[j][1] * v[j][1]) + (v[j][2] * v[j][2] + v[j][3] * v[j][3]);
    return wave_sum_dpp(s); }
struct ModP { f32x4 g[4], sc[4], sh[4]; };
DI void load_modp(ModP& m, const float* g, const float* sc, const float* sh, int lane) {
#pragma unroll
    for (int j = 0; j < 4; ++j) { const int o = 4 * lane + 256 * j; m.g[j] = *(const f32x4*)(g + o); m.sc[j] = *(const f32x4*)(sc + o); m.sh[j] = *(const f32x4*)(sh + o); } }
DI void mod_norm_store(const f32x4 (&xv)[4], float rstd, const ModP& m, bf16_t* orow, unsigned char* orow8, int lane, f32x4 (&hv)[4]) {
#pragma unroll
    for (int j = 0; j < 4; ++j) { const int o = 4 * lane + 256 * j; const f32x4 gv = m.g[j], scv = m.sc[j], shv = m.sh[j];
        hv[j] = xv[j] * rstd * gv * (1.0f + scv) + shv;
        u32x2 w; w.x = pk2(hv[j][0], hv[j][1]); w.y = pk2(hv[j][2], hv[j][3]); *(u32x2*)(orow + o) = w;
        *(unsigned*)(orow8 + o) = pk4_fp8(hv[j][0] * H8_SCALE, hv[j][1] * H8_SCALE, hv[j][2] * H8_SCALE, hv[j][3] * H8_SCALE); }
}
DI void mod_norm_store8(const f32x4 (&xv)[4], float rstd, const ModP& m, unsigned char* orow, int lane, f32x4 (&hv)[4]) {
#pragma unroll
    for (int j = 0; j < 4; ++j) { const int o = 4 * lane + 256 * j; const f32x4 gv = m.g[j], scv = m.sc[j], shv = m.sh[j];
        hv[j] = xv[j] * rstd * gv * (1.0f + scv) + shv;
        *(unsigned*)(orow + o) = pk4_fp8(hv[j][0] * H8_SCALE, hv[j][1] * H8_SCALE, hv[j][2] * H8_SCALE, hv[j][3] * H8_SCALE); }
}
DI void phase_n0(Frame& F, int l) {
    refresh(F);
    const kptr_t KA = kargs_now();
    const float* mod = (const float*)(F.ws + WS_MOD) + (size_t)l * NB * NMOD * D;
    const int gw = F.bid * 8 + F.wave, NGW = F.G * 8;
    for (int r0 = gw * 2; r0 < T; r0 += NGW * 2) {
        f32x4 xa[2][4], hv[4];
#pragma unroll
        for (int rr = 0; rr < 2; ++rr) load_row_f32(inp(KA, I_X) + (size_t)(r0 + rr) * D, F.lane, xa[rr]);
        ModP mp; { const int b = r0 / SEQ; load_modp(mp, inp(KA, I_GPREMIX) + l * D, mod + (size_t)b * NMOD * D + 1 * D, mod + (size_t)b * NMOD * D + 0 * D, F.lane); }
#pragma unroll
        for (int rr = 0; rr < 2; ++rr) { const int r = r0 + rr; const float rstd = rsqrtf(sumsq(xa[rr], F.lane) * (1.0f / D) + RMS_EPS);
            mod_norm_store8(xa[rr], rstd, mp, F.ws + WS_HF8 + (size_t)r * D, F.lane, hv); }
    }
}
DI void load_row_bf16(const bf16_t* p, int lane, f32x4 (&v)[4]) {
#pragma unroll
    for (int j = 0; j < 4; ++j) { const u32x2 w = *(const u32x2*)(p + 4 * lane + 256 * j); v[j][0] = bflo(w.x); v[j][1] = bfhi(w.x); v[j][2] = bflo(w.y); v[j][3] = bfhi(w.y); }
}
DI void phase_n1(Frame& F, int l) {
    refresh(F);
    const kptr_t KA = kargs_now();
    constexpr int RP = 2064;
    LAS unsigned char* WTl = F.lds; LAS unsigned char* HTl = F.lds + 32 * RP; LAS float* PS = (LAS float*)(F.lds + 48 * RP);
    volatile LAS int* hist = (volatile LAS int*)(F.MISC + 64); volatile LAS int* basew = (volatile LAS int*)(F.MISC + 96);
    const float* wr_ = inp(KA, I_WROUTER) + (size_t)l * D * NE;
    for (int idx = F.tid; idx < D * 8; idx += 512) { const int k = idx >> 3, c = idx & 7; const f32x4 v = *(const f32x4*)(wr_ + k * 32 + 4 * c);
#pragma unroll
        for (int q = 0; q < 4; ++q) *(LAS bf16_t*)(WTl + (4 * c + q) * RP + k * 2) = (bf16_t)(pk2(v[q], 0.f) & 0xffffu); }
    __syncthreads();
    const float* mod = (const float*)(F.ws + WS_MOD) + (size_t)l * NB * NMOD * D;
    const bf16_t* ymix = (const bf16_t*)(F.ws + WS_YMIX); unsigned char* h8 = F.ws + WS_H8;
    const float* xin = inp(KA, I_X); bf16_t* xb = (bf16_t*)(F.ws + WS_XB);
    int2* lists = (int2*)(F.ws + WS_LISTS); unsigned* cntg = F.ctl + CW_CNT + l * NE * 64;
    const float brt = inp(KA, I_BROUTER)[l * NE + (F.lane & 31)];
    for (int blk = F.bid; blk < T / 16; blk += F.G) {
        if (F.tid < 32) hist[F.tid] = 0;
        f32x4 hv[2][4], yv2[2][4], xv2[2][4];
#pragma unroll
        for (int rr = 0; rr < 2; ++rr) { const int r = blk * 16 + F.wave * 2 + rr;
            load_row_bf16(ymix + (size_t)r * D, F.lane, yv2[rr]); if (l == 0) load_row_f32(xin + (size_t)r * D, F.lane, xv2[rr]); else load_row_bf16(xb + (size_t)r * D, F.lane, xv2[rr]); }
        const float* mb = mod + (size_t)((blk * 16) / SEQ) * NMOD * D;
        f32x4 gpm[4], gtm[4]; ModP mp;
#pragma unroll
        for (int j = 0; j < 4; ++j) { const int o = 4 * F.lane + 256 * j; gpm[j] = *(const f32x4*)(inp(KA, I_GPOSTMIX) + l * D + o); gtm[j] = *(const f32x4*)(mb + 2 * D + o); }
        load_modp(mp, inp(KA, I_GPREFFN) + l * D, mb + 4 * D, mb + 3 * D, F.lane);
#pragma unroll
        for (int rr = 0; rr < 2; ++rr) { const int r = blk * 16 + F.wave * 2 + rr;
            f32x4 (&yv)[4] = yv2[rr]; f32x4 (&xv)[4] = xv2[rr];
            const float rstd_y = rsqrtf(sumsq(yv, F.lane) * (1.0f / D) + RMS_EPS);
#pragma unroll
            for (int j = 0; j < 4; ++j) { const int o = 4 * F.lane + 256 * j; const f32x4 gv = gpm[j], gt = gtm[j];
                xv[j] = xv[j] + gt * (yv[j] * rstd_y * gv); u32x2 w; w.x = pk2(xv[j][0], xv[j][1]); w.y = pk2(xv[j][2], xv[j][3]); *(u32x2*)(xb + (size_t)r * D + o) = w; }
            const float rstd_x = rsqrtf(sumsq(xv, F.lane) * (1.0f / D) + RMS_EPS);
            mod_norm_store8(xv, rstd_x, mp, h8 + (size_t)r * D, F.lane, hv[rr]); }
#pragma unroll
        for (int rr = 0; rr < 2; ++rr)
#pragma unroll
            for (int j = 0; j < 4; ++j) { u32x2 w; w.x = pk2(hv[rr][j][0], hv[rr][j][1]); w.y = pk2(hv[rr][j][2], hv[rr][j][3]); *(LAS u32x2*)(HTl + (F.wave * 2 + rr) * RP + (4 * F.lane + 256 * j) * 2) = w; }
        __syncthreads();
        { const int r16 = F.lane & 15, kg = F.lane >> 4; f32x4 c0 = (f32x4){0.f, 0.f, 0.f, 0.f}, c1 = c0;
#pragma unroll
          for (int st = 0; st < 4; ++st) { const int kb2 = (128 * F.wave + 32 * st + 8 * kg) * 2;
              const bf16x8 af = *(const LAS bf16x8*)(HTl + r16 * RP + kb2), b0 = *(const LAS bf16x8*)(WTl + r16 * RP + kb2), b1 = *(const LAS bf16x8*)(WTl + (16 + r16) * RP + kb2);
              c0 = __builtin_amdgcn_mfma_f32_16x16x32_bf16(af, b0, c0, 0, 0, 0); c1 = __builtin_amdgcn_mfma_f32_16x16x32_bf16(af, b1, c1, 0, 0, 0); }
#pragma unroll
          for (int i = 0; i < 4; ++i) { PS[(F.wave * 16 + 4 * kg + i) * 32 + r16] = c0[i]; PS[(F.wave * 16 + 4 * kg + i) * 32 + 16 + r16] = c1[i]; } }
        __syncthreads();
        float lgs = 0.f;
#pragma unroll
        for (int w = 0; w < 8; ++w) lgs += PS[(w * 16 + F.wave * 2 + (F.lane >> 5)) * 32 + (F.lane & 31)];
        float lg = lgs + brt; const int e_me = F.lane & 31;
        float topv[4]; int tope[4];
#pragma unroll
        for (int k = 0; k < 4; ++k) { float mv = lg; int mi = e_me;
#pragma unroll
            for (int st = 0; st < 4; ++st) {
                float ov; int oi;
                if (st == 0) { ov = __int_as_float(__builtin_amdgcn_update_dpp(0, __float_as_int(mv), 0x121, 0xf, 0xf, false)); oi = __builtin_amdgcn_update_dpp(0, mi, 0x121, 0xf, 0xf, false); }
                else if (st == 1) { ov = __int_as_float(__builtin_amdgcn_update_dpp(0, __float_as_int(mv), 0x122, 0xf, 0xf, false)); oi = __builtin_amdgcn_update_dpp(0, mi, 0x122, 0xf, 0xf, false); }
                else if (st == 2) { ov = __int_as_float(__builtin_amdgcn_update_dpp(0, __float_as_int(mv), 0x124, 0xf, 0xf, false)); oi = __builtin_amdgcn_update_dpp(0, mi, 0x124, 0xf, 0xf, false); }
                else { ov = __int_as_float(__builtin_amdgcn_update_dpp(0, __float_as_int(mv), 0x128, 0xf, 0xf, false)); oi = __builtin_amdgcn_update_dpp(0, mi, 0x128, 0xf, 0xf, false); }
                if (ov > mv || (ov == mv && oi < mi)) { mv = ov; mi = oi; } }
            { const float ov = shx(mv, 16, F.lane); const int oi = shxi(mi, 16, F.lane); if (ov > mv || (ov == mv && oi < mi)) { mv = ov; mi = oi; } }
            topv[k] = mv; tope[k] = mi; if (e_me == mi) lg = -INFINITY; }
        const float e1 = __expf(topv[1] - topv[0]), e2 = __expf(topv[2] - topv[0]), e3 = __expf(topv[3] - topv[0]); const float inv = 1.0f / (1.0f + e1 + e2 + e3);
        const int ks = F.lane & 31; const bool slot = ks < 4;
        const int my_e = ks == 0 ? tope[0] : (ks == 1 ? tope[1] : (ks == 2 ? tope[2] : tope[3]));
        const float my_g = (ks == 0 ? 1.0f : (ks == 1 ? e1 : (ks == 2 ? e2 : e3))) * inv;
        const int row = blk * 16 + F.wave * 2 + (F.lane >> 5);
        __syncthreads();
        int lrank = 0; if (slot) lrank = atomicAdd((int*)(hist + my_e), 1);
        __syncthreads();
        if (F.tid < 32) { const int n = hist[F.tid]; basew[F.tid] = n ? (int)atomicAdd(cntg + F.tid * 64, (unsigned)n) : 0; }
        __syncthreads();
        if (slot) { const int pos = basew[my_e] + lrank; int2 ent; ent.x = row * 4 + ks; ent.y = __float_as_int(my_g); lists[(size_t)my_e * LIST_CAP + pos] = ent; }
    }
    __syncthreads();
}
DI void load_row_fp8(const unsigned char* p, int lane, f32x4 (&v)[4]) {
#pragma unroll
    for (int j = 0; j < 4; ++j) { const unsigned w = *(const unsigned*)(p + 4 * lane + 256 * j); const f32x2 lo = __builtin_amdgcn_cvt_pk_f32_fp8((int)w, false), hi = __builtin_amdgcn_cvt_pk_f32_fp8((int)w, true); v[j] = (f32x4){lo[0], lo[1], hi[0], hi[1]}; }
}
DI void phase_n2(Frame& F, int l) {
    refresh(F);
    const kptr_t KA = kargs_now();
    const float* mod = (const float*)(F.ws + WS_MOD) + (size_t)l * NB * NMOD * D; const unsigned char* ys = F.ws + WS_YSLOT; bf16_t* xb = (bf16_t*)(F.ws + WS_XB);
    const int gw = F.bid * 8 + F.wave, NGW = F.G * 8;
    for (int r0 = gw * 2; r0 < T; r0 += NGW * 2) {
        f32x4 ya[2][4][4], xa[2][4];
#pragma unroll
        for (int rr = 0; rr < 2; ++rr) { const int r = r0 + rr;
#pragma unroll
            for (int k = 0; k < 4; ++k) load_row_fp8(ys + ((size_t)r * 4 + k) * D, F.lane, ya[rr][k]);
            load_row_bf16(xb + (size_t)r * D, F.lane, xa[rr]); }
        const float* mb = mod + (size_t)(r0 / SEQ) * NMOD * D;
        f32x4 gpf[4], gtf[4]; ModP mp;
#pragma unroll
        for (int j = 0; j < 4; ++j) { const int o = 4 * F.lane + 256 * j; gpf[j] = *(const f32x4*)(inp(KA, I_GPOSTFFN) + l * D + o); gtf[j] = *(const f32x4*)(mb + 5 * D + o); }
        if (l + 1 < DEPTH) { const float* mb2 = mb + (size_t)NB * NMOD * D; load_modp(mp, inp(KA, I_GPREMIX) + (l + 1) * D, mb2 + 1 * D, mb2 + 0 * D, F.lane); }
#pragma unroll
        for (int rr = 0; rr < 2; ++rr) { const int r = r0 + rr;
            f32x4 yv[4], hv[4]; f32x4 (&xv)[4] = xa[rr];
#pragma unroll
            for (int j = 0; j < 4; ++j) yv[j] = ((ya[rr][0][j] + ya[rr][1][j]) + (ya[rr][2][j] + ya[rr][3][j])) * (1.0f / YS8_SCALE);
            const float rstd_y = rsqrtf(sumsq(yv, F.lane) * (1.0f / D) + RMS_EPS);
#pragma unroll
            for (int j = 0; j < 4; ++j) { const int o = 4 * F.lane + 256 * j; const f32x4 gv = gpf[j], gt = gtf[j];
                xv[j] = xv[j] + gt * (yv[j] * rstd_y * gv);
                if (l + 1 < DEPTH) { u32x2 w; w.x = pk2(xv[j][0], xv[j][1]); w.y = pk2(xv[j][2], xv[j][3]); *(u32x2*)(xb + (size_t)r * D + o) = w; } else *(f32x4*)(F.out + (size_t)r * D + o) = xv[j]; }
            if (l + 1 < DEPTH) { const float rstd_x = rsqrtf(sumsq(xv, F.lane) * (1.0f / D) + RMS_EPS);
                mod_norm_store8(xv, rstd_x, mp, F.ws + WS_HF8 + (size_t)r * D, F.lane, hv); } }
    }
}
DI void phase_scan(Frame& F, int l) {
    refresh(F);
    const float* E = (const float*)(F.ws + WS_E); bf16_t* ua = (bf16_t*)(F.ws + WS_UA); const float* l32 = (const float*)(F.ws + WS_L32) + (size_t)l * NG * SP * 2;
    for (int u = F.bid; u < NG * 2; u += F.G) { const int g = u >> 1, b = (u & 1) * 8 + (F.tid >> 6), p = F.tid & 63;
        const float lr = l32[(g * SP + p) * 2], li = l32[(g * SP + p) * 2 + 1];
        const size_t row0 = (size_t)g * CROWS + b * NCH; float sr = 0.f, si = 0.f;
        f32x2 ev[NCH];
#pragma unroll
        for (int k = 0; k < NCH; ++k) ev[k] = *(const f32x2*)(E + (row0 + k) * 128 + 2 * p);
        asm volatile("" ::: "memory");
#pragma unroll
        for (int k = 0; k < NCH; ++k) {
            *(unsigned*)(ua + (row0 + k) * UAK + 512 + 2 * p) = pk2(sr, si);
            const float nr = lr * sr - li * si + ev[k][0], ni = lr * si + li * sr + ev[k][1]; sr = nr; si = ni; }
    }
}
constexpr float LOG2E = 1.4426950408889634f;
DI int t5_bucket(int n) { return n < 16 ? n : 16 + (n >= 19) + (n >= 21) + (n >= 24) + (n >= 27) + (n >= 31) + (n >= 35) + (n >= 40) + (n >= 46) + (n >= 52) + (n >= 59) + (n >= 67) + (n >= 77) + (n >= 87) + (n >= 99) + (n >= 113); }
#define MFMA32(a, b, c) __builtin_amdgcn_mfma_f32_32x32x16_bf16((a), (b), (c), 0, 0, 0)
DI void phase_attn(Frame& F, int l) {
    refresh(F);
    const kptr_t KA = kargs_now();
    const bf16_t* qb = (const bf16_t*)(F.ws + WS_Q); const bf16_t* kb = (const bf16_t*)(F.ws + WS_K); const bf16_t* vb = (const bf16_t*)(F.ws + WS_V);
    const float* kmean = (const float*)(F.ws + WS_KMEAN) + (size_t)l * NB * NBLK * AW; unsigned char* att = F.ws + WS_AZ;
    constexpr int ATT_BUF = 9216;
    LAS unsigned char* KS = F.lds; LAS unsigned char* VS = F.lds + 2 * ATT_BUF; LAS float* BIAS = (LAS float*)(F.lds + 4 * ATT_BUF); LAS float* KM = (LAS float*)(F.lds + 4 * ATT_BUF + 512); LAS int* OVF = (LAS int*)(F.lds + 4 * ATT_BUF + 512 + 2048);
    constexpr int ATT_RC = 208, ATT_RN = 280; LAS float* RT = (LAS float*)(F.lds + 4 * ATT_BUF + 512 + 2048 + 64);
    QState cq; cq.base = 0; cq.cnt = 8;
    constexpr int SLOT_ITEMS = 3;
    if (F.bid & 1) { __syncthreads(); run_items1(F, 1 + l, SLOT_ITEMS, cq); }
    for (int U = F.bid; U < NB * NH * NBLK; U += F.G) {
        refresh(F);
        const int lane = F.lane, wave = F.wave, qi = lane & 31, hh = lane >> 5;
        const int srow = F.tid >> 3, sch = F.tid & 7;
        const int c = U & 255, it = U >> 8, bh = c >> 1, set = c & 1;
        const int qblk = set ? (it == 0 ? 6 : (it == 1 ? 1 : (it == 2 ? 5 : 2))) : (it == 0 ? 7 : (it == 1 ? 0 : (it == 2 ? 4 : 3)));
        const int b = bh >> 3, h = bh & 7;
        const size_t qtok = (size_t)b * SEQ + qblk * 256 + 32 * wave + qi;
        bf16x8 qf[4];
#pragma unroll
        for (int s = 0; s < 4; ++s) qf[s] = *(const bf16x8*)(qb + qtok * AW + h * HD + 16 * s + 8 * hh);
        u32x4 kreg, vreg;
        { const size_t tok = (size_t)b * SEQ + qblk * 256 + srow; kreg = *(const u32x4*)(kb + tok * AW + h * HD + sch * 8); vreg = *(const u32x4*)(vb + tok * AW + h * HD + sch * 8); }
        const float km_v = kmean[((size_t)(b * NBLK + (F.tid >> 6))) * AW + h * HD + (F.tid & 63)] * (1.0f / 256.0f);
        const float bias_v = inp(KA, I_RELB)[t5_bucket(F.tid & 127) * NH + h] * LOG2E;
        __syncthreads();
        if (F.tid < 128) BIAS[F.tid] = bias_v;
        if (F.tid == 0) OVF[0] = 0;
        KM[F.tid] = km_v;
        *(LAS u32x4*)(KS + srow * 144 + sch * 16) = kreg; *(LAS u32x4*)(VS + srow * 144 + sch * 16) = vreg;
        { const size_t tok = (size_t)b * SEQ + qblk * 256 + 64 + srow; kreg = *(const u32x4*)(kb + tok * AW + h * HD + sch * 8); vreg = *(const u32x4*)(vb + tok * AW + h * HD + sch * 8); }
        __syncthreads();
        for (int e = F.tid; e < 4 * ATT_RN; e += 512) { const int cpy = e / ATT_RN, dist = ATT_RC - (e - cpy * ATT_RN + cpy); RT[e] = dist < 0 ? -1.0e30f : BIAS[dist > 127 ? 127 : dist]; }
        const float bfar = BIAS[127];
        unsigned selmask = 0;
        {
            float gsc[8];
#pragma unroll
            for (int j = 0; j < 8; ++j) { float a = 0.f;
#pragma unroll
                for (int s = 0; s < 4; ++s)
#pragma unroll
                    for (int e = 0; e < 8; ++e) a += __uint_as_float(((unsigned)(unsigned short)qf[s][e]) << 16) * KM[j * 64 + 16 * s + 8 * hh + e];
                a = half_sum(a); gsc[j] = (j < qblk) ? a : -INFINITY; }
#pragma unroll
            for (int rnd = 0; rnd < 3; ++rnd) { float bv = -INFINITY; int bi = -1;
#pragma unroll
                for (int j = 0; j < 8; ++j) if (gsc[j] > bv) { bv = gsc[j]; bi = j; }
                if (bi >= 0) selmask |= 1u << bi;
#pragma unroll
                for (int j = 0; j < 8; ++j) if (j == bi) gsc[j] = -INFINITY; }
        }
        f32x16 o[2]; float l_run;
        const int n_tiles = 4 * (qblk + 1);
        const int pv_q = (lane & 15) >> 2, pv_p = lane & 3, pv_c = (lane >> 4) & 1;
#define ATT_JB(T) ((T) < 4 ? qblk : qblk - 1 - (((T) - 4) >> 2))
#define ATT_KT(T) ((T) < 4 ? (T) : ((T) < 6 ? 7 - (T) : ((T) < 8 ? (T) - 6 : ((T) & 3))))
#define ATT_TOK(T) ((size_t)b * SEQ + ATT_JB(T) * 256 + ATT_KT(T) * 64 + srow)
#define ATT_PV_STEP(S_) do { const int ks_ = (S_) >> 1, r0_ = 8 * ((S_) & 1); u32x4 w_; \
            w_.x = pk2(st[ks_][r0_], st[ks_][r0_ + 1]); w_.y = pk2(st[ks_][r0_ + 2], st[ks_][r0_ + 3]); w_.z = pk2(st[ks_][r0_ + 4], st[ks_][r0_ + 5]); w_.w = pk2(st[ks_][r0_ + 6], st[ks_][r0_ + 7]); \
            const bf16x8 pfs_ = __builtin_bit_cast(bf16x8, w_); \
            _Pragma("unroll") for (int ds_ = 0; ds_ < 2; ++ds_) { const LAS unsigned char* base_ = VSb + (16 * (S_) + 4 * hh + pv_q) * 144 + (32 * ds_ + 16 * pv_c + 4 * pv_p) * 2; \
                const s16x4 lo_ = __builtin_amdgcn_ds_read_tr16_b64_v4i16((LAS s16x4*)base_), hi_ = __builtin_amdgcn_ds_read_tr16_b64_v4i16((LAS s16x4*)(base_ + 8 * 144)); \
                bf16x8 vf_; vf_[0] = lo_[0]; vf_[1] = lo_[1]; vf_[2] = lo_[2]; vf_[3] = lo_[3]; vf_[4] = hi_[0]; vf_[5] = hi_[1]; vf_[6] = hi_[2]; vf_[7] = hi_[3]; \
                o[ds_] = MFMA32(vf_, pfs_, o[ds_]); } } while (0)
#define ATT_BODY(NEAR_, RP_) do { \
            bf16x8 kf[8]; f32x16 st[2];                                                  \
            _Pragma("unroll") for (int ks_ = 0; ks_ < 2; ++ks_) _Pragma("unroll") for (int s_ = 0; s_ < 4; ++s_) kf[ks_ * 4 + s_] = *(const LAS bf16x8*)(KSb + (32 * ks_ + qi) * 144 + 32 * s_ + 16 * hh); \
            if (NEAR_) { \
                _Pragma("unroll") for (int ks_ = 0; ks_ < 2; ++ks_) _Pragma("unroll") for (int g_ = 0; g_ < 4; ++g_) { const f32x4 t_ = *(const LAS f32x4*)((RP_) + (32 * ks_ + 8 * g_) * 4); \
                    st[ks_][4 * g_] = t_[0]; st[ks_][4 * g_ + 1] = t_[1]; st[ks_][4 * g_ + 2] = t_[2]; st[ks_][4 * g_ + 3] = t_[3]; } \
                asm volatile("s_waitcnt lgkmcnt(0)" : "+v"(kf[0]), "+v"(kf[1]), "+v"(kf[2]), "+v"(kf[3]), "+v"(kf[4]), "+v"(kf[5]), "+v"(kf[6]), "+v"(kf[7]), "+v"(st[0]), "+v"(st[1]) :: "memory"); \
                _Pragma("unroll") for (int s_ = 0; s_ < 4; ++s_) _Pragma("unroll") for (int ks_ = 0; ks_ < 2; ++ks_) st[ks_] = MFMA32(kf[ks_ * 4 + s_], qf[s_], st[ks_]); \
            } else { \
                const float cbm = lane_sel ? bfar : -1.0e30f;                             \
                f32x16 negm; _Pragma("unroll") for (int i_ = 0; i_ < 16; ++i_) negm[i_] = cbm; \
                asm volatile("s_waitcnt lgkmcnt(0)" : "+v"(kf[0]), "+v"(kf[1]), "+v"(kf[2]), "+v"(kf[3]), "+v"(kf[4]), "+v"(kf[5]), "+v"(kf[6]), "+v"(kf[7]) :: "memory"); \
                _Pragma("unroll") for (int s_ = 0; s_ < 4; ++s_) _Pragma("unroll") for (int ks_ = 0; ks_ < 2; ++ks_) st[ks_] = MFMA32(kf[ks_ * 4 + s_], qf[s_], s_ == 0 ? negm : st[ks_]); } \
            s16x4 vlo[8], vhi[8];                                                        \
            _Pragma("unroll") for (int s_ = 0; s_ < 4; ++s_) _Pragma("unroll") for (int ds_ = 0; ds_ < 2; ++ds_) { const LAS unsigned char* base_ = VSb + (16 * s_ + 4 * hh + pv_q) * 144 + (32 * ds_ + 16 * pv_c + 4 * pv_p) * 2; \
                vlo[s_ * 2 + ds_] = __builtin_amdgcn_ds_read_tr16_b64_v4i16((LAS s16x4*)base_); vhi[s_ * 2 + ds_] = __builtin_amdgcn_ds_read_tr16_b64_v4i16((LAS s16x4*)(base_ + 8 * 144)); } \
            asm volatile("" ::: "memory"); \
            f32x2 ls2 = {0.f, 0.f}; \
            _Pragma("unroll") for (int s4_ = 0; s4_ < 4; ++s4_) { const int ks_ = s4_ >> 1, r0_ = 8 * (s4_ & 1);        \
                _Pragma("unroll") for (int j_ = 0; j_ < 8; j_ += 2) { const float p0_ = __builtin_amdgcn_exp2f(st[ks_][r0_ + j_]), p1_ = __builtin_amdgcn_exp2f(st[ks_][r0_ + j_ + 1]); st[ks_][r0_ + j_] = p0_; st[ks_][r0_ + j_ + 1] = p1_; ls2 += (f32x2){p0_, p1_}; } \
                if (s4_ == 0) asm volatile("s_waitcnt lgkmcnt(0)" : "+v"(vlo[0]), "+v"(vlo[1]), "+v"(vlo[2]), "+v"(vlo[3]), "+v"(vlo[4]), "+v"(vlo[5]), "+v"(vlo[6]), "+v"(vlo[7]), \
                         "+v"(vhi[0]), "+v"(vhi[1]), "+v"(vhi[2]), "+v"(vhi[3]), "+v"(vhi[4]), "+v"(vhi[5]), "+v"(vhi[6]), "+v"(vhi[7]) :: "memory"); \
                u32x4 w_; w_.x = pk2(st[ks_][r0_], st[ks_][r0_ + 1]); w_.y = pk2(st[ks_][r0_ + 2], st[ks_][r0_ + 3]); w_.z = pk2(st[ks_][r0_ + 4], st[ks_][r0_ + 5]); w_.w = pk2(st[ks_][r0_ + 6], st[ks_][r0_ + 7]); \
                const bf16x8 pfs_ = __builtin_bit_cast(bf16x8, w_); \
                _Pragma("unroll") for (int ds_ = 0; ds_ < 2; ++ds_) { const s16x4 lo_ = vlo[s4_ * 2 + ds_], hi_ = vhi[s4_ * 2 + ds_]; \
                    bf16x8 vf_; vf_[0] = lo_[0]; vf_[1] = lo_[1]; vf_[2] = lo_[2]; vf_[3] = lo_[3]; vf_[4] = hi_[0]; vf_[5] = hi_[1]; vf_[6] = hi_[2]; vf_[7] = hi_[3]; \
                    o[ds_] = MFMA32(vf_, pfs_, o[ds_]); } } \
            l_run += ls2[0] + ls2[1]; } while (0)
#define ATT_ADVANCE(T) do { if ((T) + 1 < n_tiles) { \
                LAS unsigned char* KSn = KS + (((T) + 1) & 1) * ATT_BUF; LAS unsigned char* VSn = VS + (((T) + 1) & 1) * ATT_BUF; \
                *(LAS u32x4*)(KSn + srow * 144 + sch * 16) = kreg; *(LAS u32x4*)(VSn + srow * 144 + sch * 16) = vreg; \
                if ((T) + 2 < n_tiles) { const int t2_ = (T) + 2; const size_t tok_ = ATT_TOK(t2_); \
                    kreg = *(const u32x4*)(kb + tok_ * AW + h * HD + sch * 8); vreg = *(const u32x4*)(vb + tok_ * AW + h * HD + sch * 8); } } \
            __syncthreads(); } while (0)
#define ATT_PRIME() \
            u32x4 kreg, vreg; \
            { const size_t tok = ATT_TOK(0); kreg = *(const u32x4*)(kb + tok * AW + h * HD + sch * 8); vreg = *(const u32x4*)(vb + tok * AW + h * HD + sch * 8); } \
            *(LAS u32x4*)(KS + srow * 144 + sch * 16) = kreg; *(LAS u32x4*)(VS + srow * 144 + sch * 16) = vreg; \
            { const size_t tok = ATT_TOK(1); kreg = *(const u32x4*)(kb + tok * AW + h * HD + sch * 8); vreg = *(const u32x4*)(vb + tok * AW + h * HD + sch * 8); } \
            __syncthreads();
        {
#pragma unroll
            for (int i = 0; i < 16; ++i) { o[0][i] = 0.f; o[1][i] = 0.f; }
            l_run = 0.f;
            __syncthreads();
            const int nA = n_tiles < 6 ? n_tiles : 6;
            int ti = 0;
            for (; ti < nA; ++ti) {
                LAS unsigned char* KSb = KS + (ti & 1) * ATT_BUF; LAS unsigned char* VSb = VS + (ti & 1) * ATT_BUF;
                const bool own = ti < 4; const int jb = ATT_JB(ti), kt = ATT_KT(ti);
                const bool lane_sel = own || (((selmask >> jb) & 1u) != 0u);
                const bool active = own ? (kt <= (wave >> 1)) : (__ballot(lane_sel) != 0ull);
                if (active) {
                    const int toff = (qblk - jb) * 256 + 32 * wave - 64 * kt;
                    if (toff - 63 < 113) {
                        const int y0 = ATT_RC - toff - qi + 4 * hh;
                        const LAS unsigned char* rp = (const LAS unsigned char*)RT + (lane_sel ? (y0 & 3) * (ATT_RN * 4) + (y0 & ~3) * 4 : (ATT_RC + 4) * 4);
                        ATT_BODY(1, rp);
                    } else { ATT_BODY(0, (const LAS unsigned char*)RT); }
                }
                ATT_ADVANCE(ti);
            }
            for (; ti < n_tiles; ++ti) {
                LAS unsigned char* KSb = KS + (ti & 1) * ATT_BUF; LAS unsigned char* VSb = VS + (ti & 1) * ATT_BUF;
                const int jb = ATT_JB(ti);
                const bool lane_sel = ((selmask >> jb) & 1u) != 0u;
                if (__ballot(lane_sel) != 0ull) ATT_BODY(0, (const LAS unsigned char*)RT);
                ATT_ADVANCE(ti);
            }
            { const float lchk = half_sum(l_run);
              if (__ballot(!(lchk > 5.5e-20f && lchk < 1.8e19f)) != 0ull && lane == 0) *(volatile LAS int*)OVF = 1; }
            __syncthreads();
        }
        if (*(volatile LAS int*)OVF != 0) {
            __syncthreads();
#pragma unroll
            for (int i = 0; i < 16; ++i) { o[0][i] = 0.f; o[1][i] = 0.f; }
            l_run = 0.f; float m_run = -INFINITY;
            ATT_PRIME()
            for (int ti = 0; ti < n_tiles; ++ti) {
                LAS unsigned char* KSb = KS + (ti & 1) * ATT_BUF; LAS unsigned char* VSb = VS + (ti & 1) * ATT_BUF;
                const bool own = ti < 4; const int jb = ATT_JB(ti), kt = ATT_KT(ti);
                const bool lane_sel = own || (((selmask >> jb) & 1u) != 0u);
                const bool active = own ? (kt <= (wave >> 1)) : (__ballot(lane_sel) != 0ull);
                if (active) {
                    f32x16 st[2]; float ls = 0.f;
#pragma unroll
                    for (int ks = 0; ks < 2; ++ks) {
#pragma unroll
                        for (int i = 0; i < 16; ++i) st[ks][i] = 0.f;
#pragma unroll
                        for (int s = 0; s < 4; ++s) { const bf16x8 a = *(const LAS bf16x8*)(KSb + (32 * ks + qi) * 144 + 32 * s + 16 * hh); st[ks] = MFMA32(a, qf[s], st[ks]); } }
                    const int dbase = (qblk - jb) * 256 + 32 * wave + qi - 64 * kt - 4 * hh;
                    float mx = -INFINITY;
#pragma unroll
                    for (int ks = 0; ks < 2; ++ks)
#pragma unroll
                        for (int i = 0; i < 16; ++i) { const int dist = dbase - (32 * ks + (i & 3) + 8 * (i >> 2));
                            const float bias = ((volatile LAS float*)BIAS)[dist < 0 ? 0 : (dist > 127 ? 127 : dist)];
                            const bool valid = lane_sel && (!own || dist >= 0);
                            const float sv = valid ? st[ks][i] + bias : -INFINITY; st[ks][i] = sv; mx = fmaxf(mx, sv); }
                    mx = half_max(mx);
                    const float m_new = fmaxf(m_run, mx);
                    const float m_use = (m_new > -1.0e37f) ? m_new : 0.f;
                    const float alpha = __builtin_amdgcn_exp2f(m_run - m_use); m_run = m_new;
#pragma unroll
                    for (int ks = 0; ks < 2; ++ks)
#pragma unroll
                        for (int i = 0; i < 16; ++i) { const float p = __builtin_amdgcn_exp2f(st[ks][i] - m_use); st[ks][i] = p; ls += p; }
                    l_run = l_run * alpha + ls;
#pragma unroll
                    for (int i = 0; i < 16; ++i) { o[0][i] *= alpha; o[1][i] *= alpha; }
#pragma unroll
                    for (int s4 = 0; s4 < 4; ++s4) ATT_PV_STEP(s4);
                }
                ATT_ADVANCE(ti);
            }
        }
#undef ATT_PV_STEP
#undef ATT_BODY
#undef ATT_ADVANCE
#undef ATT_PRIME
#undef ATT_JB
#undef ATT_KT
#undef ATT_TOK
        const float ltot = half_sum(l_run); const float inv = AZ8_SCALE / ltot;
#pragma unroll
        for (int ds = 0; ds < 2; ++ds)
#pragma unroll
            for (int g4 = 0; g4 < 4; ++g4)
                *(unsigned*)(att + qtok * D + h * HD + 32 * ds + 8 * g4 + 4 * hh) = pk4_fp8(o[ds][4 * g4] * inv, o[ds][4 * g4 + 1] * inv, o[ds][4 * g4 + 2] * inv, o[ds][4 * g4 + 3] * inv);
        if (!((F.bid & 1) && it == 3)) { __syncthreads(); run_items1(F, 1 + l, SLOT_ITEMS, cq); }
    }
    __syncthreads();
    run_items1(F, 1 + l, -1, cq);
    __syncthreads();
}

#define DUP_PHASE 0
#define REP(k) for (int _r = 0; _r < ((DUP_PHASE == (k)) ? 2 : 1); ++_r)
struct Args { const float* in[28]; float* out; unsigned char* ws; };
__global__ void __launch_bounds__(512, 2) fwd_kernel(Args args) {
    extern __shared__ __attribute__((aligned(16))) unsigned char lds_raw[];
    Frame F;
    F.lds = (LAS unsigned char*)lds_raw; F.MISC = (volatile LAS unsigned*)(F.lds + LDS_MISC);
    F.tid = threadIdx.x; F.lane = F.tid & 63; F.wave = __builtin_amdgcn_readfirstlane(F.tid >> 6); F.G = gridDim.x; F.bid = blockIdx.x;
    F.ws = (unsigned char*)(GAS unsigned char*)args.ws; F.ctl = (unsigned*)(GAS unsigned*)(args.ws + WS_CTL); F.out = (float*)(GAS float*)args.out;
    for (int u = F.tid; u < (LDS_BYTES - LDS_MISC) / 4; u += 512) F.MISC[u] = 0u;
    __syncthreads();
    XcdBarrier bar = xcd_barrier_post(F.ctl + CW_BAR, F.MISC + 0, F.tid == 0);
#define GRID_BAR() do { XcdBarrier _b = bar; asm volatile("" : "+s"(_b.bar), "+s"(_b.x)); refresh(F); xcd_barrier(_b, F.tid == 0); } while (0)

    REP(1) { for (int u = F.bid; u < 256; u += F.G) { if (u < 64) p_ssm_unit(F, u); else p_adaln_unit(F, u - 64); }
    p_transposes(F); __syncthreads(); }
    GRID_BAR();
    REP(2) phase_n0(F, 0);
    GRID_BAR();

    for (int l = 0; l < DEPTH; ++l) {
        REP(3) { unsigned char* ws = opaque_ws(F); constexpr float dq8 = 1.0f / (W8_SCALE * H8_SCALE);
          { PlainSched S; S.init(ws + WS_HF8, ws + WS_WIN + (size_t)l * INW * D, T, INW, D / 2, D / 2, F.G, F.bid);
            EpiG1 E{EpiQK{(bf16_t*)(ws + WS_Q), (bf16_t*)(ws + WS_K), (float*)(ws + WS_KMEAN) + (size_t)l * NB * NBLK * AW, dq8}, EpiVUG{(bf16_t*)(ws + WS_V), (bf16_t*)(ws + WS_UA), ws + WS_GATT, ws + WS_GSSM, dq8}};
            pg8::gemm_phase<EpiG1, PlainSched, false, true>(F.lds, S, E, D / 128, D / 2, D / 2, F.wave); } }
        GRID_BAR();
        REP(4) { unsigned char* ws = opaque_ws(F); GroupSched S; S.init(ws + WS_UA, (bf16_t*)(ws + WS_BE) + (size_t)l * NG * 256 * 512, 4, 1, UAK, 512, 256, F.G, F.bid);
          EpiState E{(float*)(ws + WS_E)};
          pg8::gemm_phase<EpiState, GroupSched, false>(F.lds, S, E, 512 / 64, UAK, 512, F.wave); }
        GRID_BAR();
        REP(5) { phase_scan(F, l);
        phase_attn(F, l); }
        GRID_BAR();
        REP(6) { unsigned char* ws = opaque_ws(F); GroupSched S; S.init(ws + WS_UA, (bf16_t*)(ws + WS_BSSM) + (size_t)l * NG * 512 * UAK, 4, 2, UAK, UAK, 512, F.G, F.bid);
          EpiSsmOut E{(bf16_t*)(ws + WS_Y)};
          pg8::gemm_phase<EpiSsmOut, GroupSched, false>(F.lds, S, E, UAK / 64, UAK, UAK, F.wave); }
        GRID_BAR();
        REP(7) { unsigned char* ws = opaque_ws(F); PlainSched S; S.init(ws + WS_Y, (bf16_t*)(ws + WS_WGLU) + (size_t)l * 1024 * SW, T, 1024, SW, SW, F.G, F.bid);
          EpiGlu E{ws + WS_AZ};
          pg8::gemm_phase<EpiGlu, PlainSched, false>(F.lds, S, E, SW / 64, SW, SW, F.wave); }
        GRID_BAR();
        REP(8) { unsigned char* ws = opaque_ws(F); PlainSched S; S.init(ws + WS_AZ, ws + WS_WCAT + (size_t)l * D * D, T, D, D / 2, D / 2, F.G, F.bid);
          LAS float* T1 = (LAS float*)(F.lds + LDS_MISC + 1024); LAS float* T2 = T1 + 256;
          refresh(F);
          if (F.tid < 256) { const float x = __builtin_amdgcn_cvt_pk_f32_fp8((int)F.tid, false)[0]; const float e1 = 1.0f + __builtin_amdgcn_exp2f(x * (-1.4426950408889634f / GATE8_SCALE)); T1[F.tid] = __builtin_amdgcn_rcpf(e1); T2[F.tid] = e1; }
          __syncthreads();
          EpiMerge E{ws + WS_MRG, ws + WS_GATT, ws + WS_GSSM, T1, T2};
          pg8::gemm_phase<EpiMerge, PlainSched, false, true>(F.lds, S, E, D / 128, D / 2, D / 2, F.wave); }
        GRID_BAR();
        REP(10) { unsigned char* ws = opaque_ws(F); PlainSched S; S.init(ws + WS_MRG, ws + WS_WOUT + (size_t)l * D * D, T, D, D / 2, D / 2, F.G, F.bid);
          EpiPlain E{(bf16_t*)(ws + WS_YMIX), D, 1.0f / (W8_SCALE * MRG8_SCALE)};
          pg8::gemm_phase<EpiPlain, PlainSched, false, true>(F.lds, S, E, D / 128, D / 2, D / 2, F.wave); }
        GRID_BAR();
        phase_n1(F, l);
        GRID_BAR();
        volatile LAS int* tbw = (volatile LAS int*)(F.MISC + 16); volatile LAS int* cntw = (volatile LAS int*)(F.MISC + 128);
        if (F.tid < 32) cntw[F.tid] = (int)__hip_atomic_load(F.ctl + CW_CNT + (l * NE + F.tid) * 64, __ATOMIC_RELAXED, __HIP_MEMORY_SCOPE_AGENT);
        __syncthreads();
        if (F.tid == 0) { int s = 0; for (int e = 0; e < NE; ++e) { tbw[e] = s; s += (cntw[e] + 255) >> 8; } tbw[32] = s; }
        __syncthreads();
        REP(12) { unsigned char* ws = opaque_ws(F); const kptr_t KA = kargs_now(); MoeSched S; S.A = (const char*)(ws + WS_H8); S.B = (const char*)(ws + WS_W1 + (size_t)l * NE * 2048 * D); S.lists = (const int2*)(ws + WS_LISTS);
          S.tb = (const LAS int*)(F.MISC + 16); S.cnt = (const LAS int*)(F.MISC + 128); S.nN = 8; S.GM = 4; S.G = F.G; S.c = F.bid; S.eB = (size_t)2048 * D; S.tB = (size_t)256 * D; S.tA = 0; S.gather = true; S.ul = (const LAS int*)(F.MISC + 192);
          refresh(F); __syncthreads(); S.build((volatile LAS int*)(F.MISC + 192), F.tid); __syncthreads();
          EpiSwiglu E{ws + WS_ACT, inp(KA, I_BEXPIN) + (size_t)l * NE * 2048};
          pg8::gemm_phase<EpiSwiglu, MoeSched, true, true>(F.lds, S, E, (D / 128) * PROBE_KREP, D / 2, D / 2, F.wave, PROBE_KREP > 1 ? D / 128 : 0); }
        GRID_BAR();
        REP(13) { unsigned char* ws = opaque_ws(F); const kptr_t KA = kargs_now(); MoeSched S; S.A = (const char*)(ws + WS_ACT); S.B = (const char*)(ws + WS_W2 + (size_t)l * NE * D * DFF); S.lists = (const int2*)(ws + WS_LISTS);
          S.tb = (const LAS int*)(F.MISC + 16); S.cnt = (const LAS int*)(F.MISC + 128); S.nN = 4; S.GM = 8; S.G = F.G; S.c = F.bid; S.eB = (size_t)D * DFF; S.tB = (size_t)256 * DFF; S.tA = (size_t)256 * DFF; S.gather = false; S.ul = (const LAS int*)(F.MISC + 192);
          refresh(F); __syncthreads(); S.build((volatile LAS int*)(F.MISC + 192), F.tid); __syncthreads();
          EpiMoeOut E{(bf16_t*)(ws + WS_YSLOT), inp(KA, I_BEXPOUT) + (size_t)l * NE * D, (const int2*)(ws + WS_LISTS)};
          pg8::gemm_phase<EpiMoeOut, MoeSched, false, true>(F.lds, S, E, DFF / 128, DFF / 2, DFF / 2, F.wave); }
        GRID_BAR();
        phase_n2(F, l);
        GRID_BAR();
    }
}

extern "C" void kernel_launch(void* const* d_in, const int* in_sizes, int n_in, void* d_out, int out_size, void* d_ws, size_t ws_size, hipStream_t stream) {
    static int grid = 0;
    if (grid == 0) {
        if (n_in != 28 || out_size != T * D || ws_size < WS_END) { fprintf(stderr, "kernel_launch: unexpected shapes (n_in %d, out %d, ws %zu < %zu)\n", n_in, out_size, ws_size, (size_t)WS_END); grid = -1; return; }
        int dev = 0, cus = 0, per_cu = 0;
        if (hipGetDevice(&dev) != hipSuccess || hipDeviceGetAttribute(&cus, hipDeviceAttributeMultiprocessorCount, dev) != hipSuccess) { grid = -1; return; }
        if (hipFuncSetAttribute((const void*)fwd_kernel, hipFuncAttributeMaxDynamicSharedMemorySize, LDS_BYTES) != hipSuccess) { fprintf(stderr, "kernel_launch: hipFuncSetAttribute failed\n"); grid = -1; return; }
        if (hipOccupancyMaxActiveBlocksPerMultiprocessor(&per_cu, (const void*)fwd_kernel, 512, LDS_BYTES) != hipSuccess || per_cu < 1) { fprintf(stderr, "kernel_launch: occupancy query says %d\n", per_cu); }
        (void)hipGetLastError();
        grid = cus;
    }
    if (grid < 0) return;
    if (hipMemsetAsync(d_ws, 0, WS_ZERO_BYTES, stream) != hipSuccess) { fprintf(stderr, "kernel_launch: memset failed\n"); return; }
    Args a{};
    for (int i = 0; i < 28; ++i) a.in[i] = (const float*)d_in[i];
    a.out = (float*)d_out; a.ws = (unsigned char*)d_ws;
    hipLaunchKernelGGL(fwd_kernel, dim3(grid), dim3(512), LDS_BYTES, stream, a);
    const hipError_t le = hipPeekAtLastError();
    if (le != hipSuccess) fprintf(stderr, "kernel_launch: launch failed: %s\n", hipGetErrorName(le));
}
```

```cpp
#include <hip/hip_runtime.h>
#include <cstdio>
#include <cstdint>

#define LAS __attribute__((address_space(3)))
#define GAS __attribute__((address_space(1)))
typedef unsigned short bf16_t;
typedef short bf16x8 __attribute__((ext_vector_type(8)));
typedef short s16x4 __attribute__((ext_vector_type(4)));
typedef float f32x4 __attribute__((ext_vector_type(4)));
typedef float f32x2 __attribute__((ext_vector_type(2)));
typedef float f32x16 __attribute__((ext_vector_type(16)));
typedef unsigned u32x4 __attribute__((ext_vector_type(4)));
typedef unsigned u32x2 __attribute__((ext_vector_type(2)));
typedef __bf16 bf16x2v __attribute__((ext_vector_type(2)));
typedef int i32x4 __attribute__((ext_vector_type(4)));
typedef int i32x8 __attribute__((ext_vector_type(8)));
#define DI __device__ __forceinline__

#define PROBE_KREP 1
constexpr int D = 1024, NB = 16, SEQ = 2048, T = NB * SEQ, DEPTH = 2;
constexpr int AW = 512, NH = 8, HD = 64, MBLK = 256, NBLK = SEQ / MBLK;
constexpr int SW = 512, SG = 16, NG = 32, SP = 64, CH = 32  , NCH = SEQ / CH  ;
constexpr int INW = 4096, NE = 32, TOPK = 4, DFF = 1024, NMOD = 6;
constexpr int UAK = 640;
constexpr int CROWS = NB * NCH;
constexpr float RMS_EPS = 1e-6f, LOG2E_C = 1.4426950408889634f;

constexpr size_t MiB = 1u << 20;
constexpr size_t WS_CTL = 0;
constexpr size_t WS_KMEAN = 1 * MiB;
constexpr size_t WS_ZERO_BYTES = 2 * MiB;
constexpr size_t WS_MOD = 2 * MiB;
constexpr size_t WS_L32 = 3 * MiB;
constexpr size_t WS_LISTS = 4 * MiB;
constexpr size_t WS_WIN = 12 * MiB;
constexpr size_t WS_WGLU = 28 * MiB;
constexpr size_t WS_WATT = 30 * MiB;
constexpr size_t WS_WSSM = 32 * MiB;
constexpr size_t WS_WOUT = 34 * MiB;
constexpr size_t WS_BSSM = 38 * MiB;
constexpr size_t WS_BE = 80 * MiB;
constexpr size_t WS_W1 = 98 * MiB;
constexpr size_t WS_W2 = 354 * MiB;
constexpr size_t WS_H = 482 * MiB;
constexpr size_t WS_Q = 546 * MiB, WS_K = 578 * MiB, WS_V = 610 * MiB;
constexpr size_t WS_H8 = WS_Q;
constexpr size_t WS_UA = 642 * MiB;
constexpr size_t WS_GATT = 684 * MiB, WS_GSSM = 748 * MiB;
constexpr size_t WS_ATT = 812 * MiB;
constexpr size_t WS_E = 844 * MiB;
constexpr size_t WS_Y = 860 * MiB;
constexpr size_t WS_Z = 892 * MiB;
constexpr size_t WS_MRG = 924 * MiB;
constexpr size_t WS_YMIX = 988 * MiB;
constexpr size_t WS_ACT = 1052 * MiB;
constexpr size_t WS_YSLOT = 1338 * MiB;
constexpr size_t WS_XB = 1594 * MiB;
constexpr size_t WS_HF8 = 1658 * MiB;
constexpr size_t WS_WIN8 = 1690 * MiB;
constexpr size_t WS_AZ = 1696 * MiB;
constexpr size_t WS_WCAT = 1760 * MiB;
constexpr size_t WS_END = 1764 * MiB;
constexpr int LIST_CAP = T;

constexpr int CW_BAR = 4096;
constexpr int CW_QUEUE = 8192;
constexpr int CW_CNT = 16384;

constexpr int RING_BYTES = 131072;
constexpr int LDS_MISC = RING_BYTES;
constexpr int LDS_BYTES = RING_BYTES + 8192;

DI unsigned pk2(float lo, float hi) { f32x2 v = {lo, hi}; bf16x2v r = __builtin_convertvector(v, bf16x2v); return __builtin_bit_cast(unsigned, r); }
DI float sat8(float x) { return __builtin_amdgcn_fmed3f(x, -448.0f, 448.0f); }
DI unsigned pk4_fp8(float a, float b, float c, float d) { int r = 0; r = __builtin_amdgcn_cvt_pk_fp8_f32(sat8(a), sat8(b), r, false); r = __builtin_amdgcn_cvt_pk_fp8_f32(sat8(c), sat8(d), r, true); return (unsigned)r; }
constexpr float W8_SCALE = 64.0f, H8_SCALE = 16.0f, ACT8_SCALE = 8.0f, GATE8_SCALE = 16.0f, YS8_SCALE = 64.0f, MRG8_SCALE = 32.0f, AZ8_SCALE = 8.0f;
DI void unpack8_fp8(const u32x2& w, f32x4& a, f32x4& b) { const f32x2 p0 = __builtin_amdgcn_cvt_pk_f32_fp8((int)w.x, false), p1 = __builtin_amdgcn_cvt_pk_f32_fp8((int)w.x, true), p2 = __builtin_amdgcn_cvt_pk_f32_fp8((int)w.y, false), p3 = __builtin_amdgcn_cvt_pk_f32_fp8((int)w.y, true);
    a = (f32x4){p0[0], p0[1], p1[0], p1[1]}; b = (f32x4){p2[0], p2[1], p3[0], p3[1]}; }
DI float bflo(unsigned w) { return __uint_as_float(w << 16); }
DI float bfhi(unsigned w) { return __uint_as_float(w & 0xffff0000u); }
DI float sigmoidf_(float x) { return __builtin_amdgcn_rcpf(1.0f + __builtin_amdgcn_exp2f(-1.4426950408889634f * x)); }
DI float gelu_tanh(float x) { const float u = 0.7978845608028654f * (x + 0.044715f * x * x * x); return x * __builtin_amdgcn_rcpf(1.0f + __builtin_amdgcn_exp2f(-2.8853900817779268f * u)); }
DI float shx(float v, int m, int lane) { return __int_as_float(__builtin_amdgcn_ds_bpermute((lane ^ m) << 2, __float_as_int(v))); }
DI int shxi(int v, int m, int lane) { return __builtin_amdgcn_ds_bpermute((lane ^ m) << 2, v); }
DI float half_max(float v) { const auto rr = __builtin_amdgcn_permlane32_swap(__float_as_uint(v), __float_as_uint(v), false, false); return fmaxf(__uint_as_float(rr[0]), __uint_as_float(rr[1])); }
DI float half_sum(float v) { const auto rr = __builtin_amdgcn_permlane32_swap(__float_as_uint(v), __float_as_uint(v), false, false); return __uint_as_float(rr[0]) + __uint_as_float(rr[1]); }
DI float wave_sum(float v, int lane) {
#pragma unroll
    for (int o = 1; o < 64; o <<= 1) v += shx(v, o, lane);
    return v;
}
#define LDS_WAIT() asm volatile("s_waitcnt lgkmcnt(0)" ::: "memory")
#define VM_WAIT() asm volatile("s_waitcnt vmcnt(0)" ::: "memory")

#define XB_TMO      128
#define XB_XCNT(j)  (256  + 64 * (j))
#define XB_XSUB(j)  (1280 + 64 * (j))
#define XB_XGEN(j)  (2304 + 64 * (j))
#define XB_TOP      3328
#define XB_TOPGEN   3392
#define XCD_BAR_WORDS 3456
#define XB_SPIN_CAP (1u << 18)
__device__ __forceinline__ unsigned xb_ld(unsigned* p)              { return __hip_atomic_load(p, __ATOMIC_RELAXED, __HIP_MEMORY_SCOPE_AGENT); }
__device__ __forceinline__ unsigned xb_add(unsigned* p, unsigned v) { return __hip_atomic_fetch_add(p, v, __ATOMIC_RELAXED, __HIP_MEMORY_SCOPE_AGENT); }
__device__ __forceinline__ unsigned xb_xcc_id() { return (unsigned)__builtin_amdgcn_s_getreg((3 << 11) | 20) & 0xFu; }
#define XB_SPIN(cond, bar) do { unsigned _sp = 0; while (cond) { __builtin_amdgcn_s_sleep(1); \
    if ((++_sp & 255u) == 0u) { if (xb_ld(&(bar)[XB_TMO])) break; if (_sp > XB_SPIN_CAP) { atomicAdd(&(bar)[XB_TMO], 1u); break; } } } } while (0)
struct XcdBarrier { unsigned* bar; unsigned x; volatile LAS unsigned* st; };
__device__ __forceinline__ XcdBarrier xcd_barrier_post(unsigned* bar, volatile LAS unsigned* st, bool t0) {
    XcdBarrier b; b.bar = bar; b.x = xb_xcc_id(); b.st = st;
    if (t0) (void)xb_add(&bar[XB_XCNT(b.x)], 1u);
    return b;
}
__device__ __forceinline__ void xcd_barrier_complete(unsigned* bar, unsigned x, unsigned& nloc, unsigned& nx) {
    const unsigned G = gridDim.x * gridDim.y * gridDim.z;
    unsigned sum, cnt, mine, sp = 0u;
    for (;;) {
        sum = 0u; cnt = 0u; mine = 0u;
#pragma unroll
        for (unsigned j = 0; j < 16; ++j) { const unsigned c = xb_ld(&bar[XB_XCNT(j)]); sum += c; cnt += (c > 0u) ? 1u : 0u; mine = (j == x) ? c : mine; }
        if (sum == G) break;
        __builtin_amdgcn_s_sleep(1);
        if ((++sp & 255u) == 0u) { if (xb_ld(&bar[XB_TMO])) break; if (sp > XB_SPIN_CAP) { atomicAdd(&bar[XB_TMO], 1u); break; } }
    }
    nloc = mine > 0u ? mine : 1u; nx = cnt > 0u ? cnt : 1u;
}
__device__ __forceinline__ void xcd_barrier(const XcdBarrier& b, bool t0) {
    asm volatile("s_waitcnt vmcnt(0)" ::: "memory");
    __syncthreads();
    if (t0) {
        unsigned* bar = b.bar;
        __builtin_amdgcn_s_waitcnt(0);
        unsigned nloc = b.st[0], nx = b.st[1];
        if (nloc == 0u) { xcd_barrier_complete(bar, b.x, nloc, nx); b.st[0] = nloc; b.st[1] = nx; }
        const unsigned old = xb_add(&bar[XB_XSUB(b.x)], 1u);
        const unsigned gen = old / nloc;
        if (old + 1u == (gen + 1u) * nloc) {
            __builtin_amdgcn_fence(__ATOMIC_RELEASE, "agent");
            asm volatile("s_waitcnt vmcnt(0)" ::: "memory");
            const unsigned og = xb_add(&bar[XB_TOP], 1u);
            const unsigned tg = og / nx;
            if (og + 1u == (tg + 1u) * nx) xb_add(&bar[XB_TOPGEN], 1u);
            else XB_SPIN(xb_ld(&bar[XB_TOPGEN]) == tg, bar);
            __builtin_amdgcn_fence(__ATOMIC_ACQUIRE, "agent");
            xb_add(&bar[XB_XGEN(b.x)], 1u);
            asm volatile("s_waitcnt vmcnt(0)" ::: "memory");
        } else {
            XB_SPIN(xb_ld(&bar[XB_XGEN(b.x)]) == gen, bar);
            __builtin_amdgcn_fence(__ATOMIC_ACQUIRE, "agent");
            asm volatile("s_waitcnt vmcnt(0)" ::: "memory");
        }
    }
    __syncthreads();
}

namespace pg8 {
constexpr int BM = 256, BK = 64, HALF = 128, HTB = HALF * BK * 2, STAGE_BYTES = 8 * HTB;
__host__ __device__ __forceinline__ int lds_byte(int r, int c) { const int st = (r >> 4) * 2 + (c >> 5), rr = r & 15, cc = c & 31, ob = rr * 64 + cc * 2; return st * 1024 + (ob ^ (((ob >> 9) & 1) << 5)); }
__host__ __device__ __forceinline__ void stage_rc(int b, int& R, int& C) { const int st = b / 1024, sb = b % 1024, swz = sb ^ (((sb >> 9) & 1) << 5); R = (st >> 1) * 16 + swz / 64; C = (st & 1) * 32 + (swz % 64) / 2; }
__host__ __device__ __forceinline__ int perm32(int rho) { const int n = rho >> 4, i = rho & 15; return 8 * (i >> 2) + 4 * n + (i & 3); }

struct Unit { int pm, pn, e, j, n, half; const char* A; const char* B; };
template <class...> struct voider { typedef void type; };
template <class E, class = void> struct MidT { static constexpr int v = -1; };
template <class E> struct MidT<E, typename voider<decltype(E::MID_T)>::type> { static constexpr int v = E::MID_T; };

template <class Epi, class Sched, bool GATHER, bool F8 = false>
__device__ __forceinline__ void gemm_phase(LAS unsigned char* lds, const Sched& S, const Epi& E, const int nt, const int lda, const int ldb, int wave_s, const int kmod = 0) {
    unsigned ones_ = ~0u; asm volatile("" : "+s"(wave_s), "+s"(ones_)); int tid = wave_s * 64 + (int)__builtin_amdgcn_mbcnt_hi(ones_, __builtin_amdgcn_mbcnt_lo(ones_, 0u)); asm volatile("" : "+v"(tid));
    const int wid = __builtin_amdgcn_readfirstlane(tid >> 6), lane = tid & 63, wr = wid >> 2, wc = wid & 3, fr = lane & 15, fq = lane >> 4;
    unsigned voffA, voffB;
    { int R, C; stage_rc(tid * 16, R, C); const int Rb = Epi::PERM ? ((R & ~31) + perm32(R & 31)) : R;
        voffA = (unsigned)(R * lda + C) * 2u; voffB = (unsigned)(Rb * ldb + C) * 2u; }
    const size_t qstepA = (size_t)64 * lda * 2, qstepB = (size_t)64 * ldb * 2;
    const size_t kstep = (size_t)(BK * 2);
    const size_t hstepA = (size_t)HALF * lda * 2, hstepB = (size_t)HALF * ldb * 2;
    const unsigned ldsw = (unsigned)wid * 1024u;
    const int aoff = lds_byte(wr * 64 + fr, fq * 8), boff = lds_byte(wc * 32 + fr, fq * 8);
#define PG8_SA(b, h) (((b) * 2 + (h)) * HTB)
#define PG8_SB(b, h) ((4 + (b) * 2 + (h)) * HTB)
#define PG8_STAGE(bufoff, gbase, voff) do { _Pragma("unroll") for (int _i = 0; _i < 2; ++_i) { unsigned _vo = (voff)[_i]; asm volatile("" : "+v"(_vo));     \
        __builtin_amdgcn_global_load_lds((const unsigned*)((const char*)(gbase) + _vo), (LAS unsigned*)(lds + (bufoff) + ldsw + _i * 8192), 16, 0, 0); } } while (0)
#define PG8_STAGE_U(bufoff, gbase, voff, qstep) do { _Pragma("unroll") for (int _i = 0; _i < 2; ++_i) { unsigned _vo = (voff); asm volatile("" : "+v"(_vo)); \
        __builtin_amdgcn_global_load_lds((const unsigned*)((const char*)(gbase) + _i * (qstep) + _vo), (LAS unsigned*)(lds + (bufoff) + ldsw + _i * 8192), 16, 0, 0); } } while (0)
#define PG8_STAGE_B(bufoff, gbase) PG8_STAGE_U(bufoff, gbase, voffB, qstepB)
#define PG8_STAGE_A(bufoff, gbase, h, GO) do { if constexpr (GATHER) { PG8_STAGE(bufoff, gbase, (GO)[h]); } else { PG8_STAGE_U(bufoff, (const char*)(gbase) + (h) * hstepA, voffA, qstepA); } } while (0)
#define PG8_LDA(dst, b, h) do { _Pragma("unroll") for (int m = 0; m < 4; ++m) _Pragma("unroll") for (int k = 0; k < 2; ++k) dst[m][k] = *(const LAS bf16x8*)(lds + PG8_SA(b, h) + aoff + m * 2048 + k * 1024); } while (0)
#define PG8_LDB(dst, b, h) do { _Pragma("unroll") for (int n = 0; n < 2; ++n) _Pragma("unroll") for (int k = 0; k < 2; ++k) dst[n][k] = *(const LAS bf16x8*)(lds + PG8_SB(b, h) + boff + n * 2048 + k * 1024); } while (0)
#define PG8_MMA(ai, bj, At, Bt) do { __builtin_amdgcn_s_setprio(1); if constexpr (F8) { _Pragma("unroll") for (int m = 0; m < 4; ++m) _Pragma("unroll") for (int n = 0; n < 2; ++n) { \
            const i32x8 a8 = __builtin_shufflevector(__builtin_bit_cast(i32x4, Bt[n][0]), __builtin_bit_cast(i32x4, Bt[n][1]), 0, 1, 2, 3, 4, 5, 6, 7); \
            const i32x8 b8 = __builtin_shufflevector(__builtin_bit_cast(i32x4, At[m][0]), __builtin_bit_cast(i32x4, At[m][1]), 0, 1, 2, 3, 4, 5, 6, 7); \
            acc[ai][bj][m][n] = __builtin_amdgcn_mfma_scale_f32_16x16x128_f8f6f4(a8, b8, acc[ai][bj][m][n], 0, 0, 0, 0, 0, 0); } } \
        else { _Pragma("unroll") for (int m = 0; m < 4; ++m) _Pragma("unroll") for (int n = 0; n < 2; ++n) _Pragma("unroll") for (int k = 0; k < 2; ++k) \
        acc[ai][bj][m][n] = __builtin_amdgcn_mfma_f32_16x16x32_bf16(Bt[n][k], At[m][k], acc[ai][bj][m][n], 0, 0, 0); } __builtin_amdgcn_s_setprio(0); } while (0)
#define PG8_WAIT_V(n) asm volatile("s_waitcnt vmcnt(" #n ")" ::: "memory")
#define PG8_WAIT_L(n) asm volatile("s_waitcnt lgkmcnt(" #n ")" ::: "memory")
#define PG8_BAR __builtin_amdgcn_s_barrier()
#define PG8_SCHED __builtin_amdgcn_sched_barrier(0)
    Unit cur, nxt; int ui = 0;
    if (!S.next(0, cur)) return;
    f32x4 acc[2][2][4][2];
#pragma unroll
    for (int a = 0; a < 2; ++a)
#pragma unroll
        for (int b = 0; b < 2; ++b)
#pragma unroll
            for (int m = 0; m < 4; ++m)
#pragma unroll
                for (int n = 0; n < 2; ++n) acc[a][b][m][n] = (f32x4){0.f, 0.f, 0.f, 0.f};
    bf16x8 At[4][2], B0[2][2], B1[2][2];
    const char* cA = cur.A; const char* cB = cur.B;
    unsigned gc[2][2], gn[2][2];
#define PG8_GOFF(dst, U) do { _Pragma("unroll") for (int _h = 0; _h < 2; ++_h) _Pragma("unroll") for (int _i = 0; _i < 2; ++_i) { int _R, _C; stage_rc(tid * 16 + _i * 8192, _R, _C); dst[_h][_i] = (unsigned)S.gather_row(U, _h * HALF + _R); } } while (0)
#define PG8_GCVT(dst) do { _Pragma("unroll") for (int _h = 0; _h < 2; ++_h) _Pragma("unroll") for (int _i = 0; _i < 2; ++_i) { int _R, _C; stage_rc(tid * 16 + _i * 8192, _R, _C); dst[_h][_i] = dst[_h][_i] * (unsigned)(lda * 2) + (unsigned)(_C * 2); } } while (0)
#pragma unroll
    for (int h = 0; h < 2; ++h)
#pragma unroll
        for (int i = 0; i < 2; ++i) { gc[h][i] = 0; gn[h][i] = 0; }
    if constexpr (GATHER) { PG8_GOFF(gc, cur); PG8_GCVT(gc); }
    PG8_STAGE_B(PG8_SB(0, 0), cB); PG8_STAGE_B(PG8_SB(0, 1), cB + hstepB); PG8_STAGE_A(PG8_SA(0, 0), cA, 0, gc); PG8_STAGE_A(PG8_SA(0, 1), cA, 1, gc);
    if (wr == 1) PG8_BAR;
    PG8_WAIT_V(2); PG8_BAR;
    PG8_STAGE_B(PG8_SB(1, 0), cB + kstep); PG8_STAGE_A(PG8_SA(1, 0), cA + kstep, 0, gc); PG8_STAGE_B(PG8_SB(1, 1), cB + hstepB + kstep);
    PG8_WAIT_V(6); PG8_BAR;
    for (;;) {
        const bool has_next = S.next(ui + 1, nxt);
        const char* nA = has_next ? nxt.A : cA; const char* nB = has_next ? nxt.B : cB;
        if constexpr (GATHER) { if (has_next) PG8_GOFF(gn, nxt); }
#pragma unroll 1
        for (int t = 0; t < nt; t += 2) {
            const bool last = (t == nt - 2);
            const int t1 = kmod ? (t + 1) % kmod : t + 1, t2 = kmod ? (t + 2) % kmod : t + 2;
            const char* a1 = cA + (size_t)t1 * kstep;
            const char* a2 = last ? nA : cA + (size_t)t2 * kstep; const char* b2 = last ? nB : cB + (size_t)t2 * kstep;
            const char* a3 = a2 + kstep; const char* b3 = b2 + kstep;
            if constexpr (MidT<Epi>::v >= 0) { if (t == MidT<Epi>::v) { unsigned o2 = ~0u; int w2 = wave_s; asm volatile("" : "+s"(w2), "+s"(o2)); int l2 = (int)__builtin_amdgcn_mbcnt_hi(o2, __builtin_amdgcn_mbcnt_lo(o2, 0u)); asm volatile("" : "+v"(l2));
                E.mid(acc, cur, w2 >> 2, w2 & 3, l2 & 15, l2 >> 4); } }
            PG8_LDB(B0, 0, 0); PG8_LDB(B1, 0, 1); PG8_SCHED; PG8_LDA(At, 0, 0); PG8_STAGE_A(PG8_SA(1, 1), a1, 1, gc);
            if constexpr (GATHER) { if (last && has_next) {
#pragma unroll
                for (int h = 0; h < 2; ++h)
#pragma unroll
                    for (int i = 0; i < 2; ++i) { int _R, _C; stage_rc(tid * 16 + i * 8192, _R, _C); gc[h][i] = gn[h][i] * (unsigned)(lda * 2) + (unsigned)(_C * 2); } } }
            PG8_WAIT_V(8); PG8_WAIT_L(0); PG8_BAR; if (cur.half != 2) { PG8_MMA(0, 0, At, B0); PG8_MMA(0, 1, At, B1); } PG8_BAR; PG8_SCHED;
            PG8_LDA(At, 0, 1); PG8_STAGE_B(PG8_SB(0, 0), b2); PG8_STAGE_B(PG8_SB(0, 1), b2 + hstepB); PG8_STAGE_A(PG8_SA(0, 0), a2, 0, gc);
            PG8_WAIT_V(8); PG8_WAIT_L(0); PG8_BAR; if (cur.half != 1) { PG8_MMA(1, 0, At, B0); PG8_MMA(1, 1, At, B1); } PG8_BAR; PG8_SCHED;
            PG8_LDB(B0, 1, 0); PG8_LDB(B1, 1, 1); PG8_SCHED; PG8_LDA(At, 1, 0); PG8_STAGE_A(PG8_SA(0, 1), a2, 1, gc);
            PG8_WAIT_V(8); PG8_WAIT_L(0); PG8_BAR; if (cur.half != 2) { PG8_MMA(0, 0, At, B0); PG8_MMA(0, 1, At, B1); } PG8_BAR; PG8_SCHED;
            PG8_LDA(At, 1, 1); PG8_STAGE_B(PG8_SB(1, 0), b3); PG8_STAGE_B(PG8_SB(1, 1), b3 + hstepB); PG8_STAGE_A(PG8_SA(1, 0), a3, 0, gc);
            PG8_WAIT_V(8); PG8_WAIT_L(0); PG8_BAR; if (cur.half != 1) { PG8_MMA(1, 0, At, B0); PG8_MMA(1, 1, At, B1); } PG8_BAR; PG8_SCHED;
        }
        if (wr == 0) PG8_BAR;
        { unsigned o2 = ~0u; int w2 = wave_s; asm volatile("" : "+s"(w2), "+s"(o2)); int l2 = (int)__builtin_amdgcn_mbcnt_hi(o2, __builtin_amdgcn_mbcnt_lo(o2, 0u)); asm volatile("" : "+v"(l2));
          E(acc, cur, w2 >> 2, w2 & 3, l2 & 15, l2 >> 4); }
        if (!has_next) break;
#pragma unroll
        for (int a = 0; a < 2; ++a)
#pragma unroll
            for (int b = 0; b < 2; ++b)
#pragma unroll
                for (int m = 0; m < 4; ++m)
#pragma unroll
                    for (int n = 0; n < 2; ++n) acc[a][b][m][n] = (f32x4){0.f, 0.f, 0.f, 0.f};
        cur = nxt; cA = nA; cB = nB; ++ui;
        if (wr == 1) PG8_BAR;
    }
    PG8_WAIT_V(0);
    PG8_BAR;
#undef PG8_SA
#undef PG8_SB
#undef PG8_STAGE
#undef PG8_STAGE_A
#undef PG8_STAGE_U
#undef PG8_STAGE_B
#undef PG8_GOFF
#undef PG8_GCVT
#undef PG8_LDA
#undef PG8_LDB
#undef PG8_MMA
#undef PG8_WAIT_V
#undef PG8_WAIT_L
#undef PG8_BAR
#undef PG8_SCHED
}
}
using pg8::Unit;

struct PlainSched {
    const char* A; const char* B; int nM, nN, nwg, G, c; size_t tA, tB;
    DI void init(const void* A_, const void* B_, int M, int N, int lda, int ldb, int G_, int c_) { A = (const char*)A_; B = (const char*)B_; nM = M / 256; nN = N / 256; nwg = nM * nN; G = G_; c = c_; tA = (size_t)256 * lda * 2; tB = (size_t)256 * ldb * 2; }
    DI bool next(int i, Unit& u) const {
        const long L = (long)i * G + c; if (L >= nwg) return false;
        int wgid = (int)L; { const int q = nwg / 8, r = nwg % 8, xcd = wgid % 8, off = wgid / 8; wgid = (xcd < r ? xcd * (q + 1) : r * (q + 1) + (xcd - r) * q) + off; }
        const int nig = 8 * nN, gid = wgid / nig, fm = gid * 8, gsz = (nM - fm) < 8 ? (nM - fm) : 8;
        u.pm = fm + ((wgid % nig) % gsz); u.pn = (wgid % nig) / gsz; u.e = 0; u.j = 0; u.n = 0; u.half = 0;
        u.A = A + (size_t)u.pm * tA; u.B = B + (size_t)u.pn * tB; return true;
    }
    DI int gather_row(const Unit&, int) const { return 0; }
};
struct GroupSched {
    const char* A; const char* B; int nM, nN, G, c, split; size_t gA, gB, tA, tB;
    DI void init(const void* A_, const void* B_, int nM_, int nN_, int lda, int ldb, int brows, int G_, int c_, int split_ = 0) { A = (const char*)A_; B = (const char*)B_; nM = nM_; nN = nN_; G = G_; c = c_; split = split_;
        gA = (size_t)CROWS * lda * 2; gB = (size_t)brows * ldb * 2; tA = (size_t)256 * lda * 2; tB = (size_t)256 * ldb * 2; }
    DI bool next(int i, Unit& u) const {
        const int L0 = i * G + c; const int L = L0 >> split; const int per = nM * nN; if (L >= NG * per) return false;
        const int g = L / per, r = L % per; u.e = g; u.pm = r % nM; u.pn = r / nM; u.j = 0; u.n = 0; u.half = split ? 1 + (L0 & 1) : 0;
        u.A = A + (size_t)g * gA + (size_t)u.pm * tA; u.B = B + (size_t)g * gB + (size_t)u.pn * tB; return true;
    }
    DI int gather_row(const Unit&, int) const { return 0; }
};
struct MoeSched {
    const char* A; const char* B; const int2* lists; const LAS int* tb; const LAS int* cnt;
    int nN, GM, G, c; size_t eB, tB, tA; bool gather;
    const LAS int* ul;
    DI void build(volatile LAS int* ulw, int tid) const {
        if (tid < 32) { const int L = tid * G + c; const int xcd = L & 7, q = L >> 3; const int sr = (q >> 5) * 8 + xcd, slot = q & 31;
            int mt = sr * GM + (slot % GM), nt_ = slot / GM; const int Mt = tb[32];
            bool ok = mt < Mt; int half = 0;
            const int rl = (Mt + 8 * GM - 1) / (8 * GM) - 1, m0 = rl * 8 * GM, Vm = Mt - m0, V = Vm * nN;
            if (tid == rl && 2 * V <= G) { ok = c < 2 * V; const int v = c >> 1; mt = m0 + (ok ? v % Vm : 0); nt_ = ok ? v / Vm : 0; half = 1 + (c & 1); }
            int e = 0; for (int k = 1; k < 32; ++k) e += (tb[k] <= mt) ? 1 : 0;
            ulw[tid * 8 + 0] = ok ? mt : -1; ulw[tid * 8 + 1] = e; ulw[tid * 8 + 2] = mt - tb[e]; ulw[tid * 8 + 3] = cnt[e]; ulw[tid * 8 + 4] = nt_; ulw[tid * 8 + 5] = half; }
    }
    DI bool next(int i, Unit& u) const {
        if (i >= 32) return false;
        const int mt = __builtin_amdgcn_readfirstlane(ul[i * 8 + 0]);
        if (mt < 0) return false;
        const int e = __builtin_amdgcn_readfirstlane(ul[i * 8 + 1]), nt_ = __builtin_amdgcn_readfirstlane(ul[i * 8 + 4]);
        u.e = e; u.pm = mt; u.pn = nt_; u.j = __builtin_amdgcn_readfirstlane(ul[i * 8 + 2]); u.n = __builtin_amdgcn_readfirstlane(ul[i * 8 + 3]); u.half = __builtin_amdgcn_readfirstlane(ul[i * 8 + 5]);
        u.A = gather ? A : A + (size_t)mt * tA;
        u.B = B + (size_t)e * eB + (size_t)nt_ * tB; return true;
    }
    DI int gather_row(const Unit& u, int r) const {
        const int li = u.j * 256 + r; const int n = u.n;
        const char* lb = (const char*)lists + (size_t)u.e * LIST_CAP * 8;
        int tok = 0; if (li < n) tok = *(const int*)(lb + (unsigned)li * 8u) >> 2;
        return tok;
    }
};

#define EPI_ROWS_BEGIN _Pragma("unroll") for (int ai = 0; ai < 2; ++ai) _Pragma("unroll") for (int m = 0; m < 4; ++m) { const int rt = 128 * ai + 64 * wr + 16 * m + fr;
#define EPI_ROWS_END }
DI u32x4 pack8(const f32x4& a, const f32x4& b) { u32x4 w; w.x = pk2(a[0], a[1]); w.y = pk2(a[2], a[3]); w.z = pk2(b[0], b[1]); w.w = pk2(b[2], b[3]); return w; }
DI void unpack8(const u32x4& w, f32x4& a, f32x4& b) { a[0] = bflo(w.x); a[1] = bfhi(w.x); a[2] = bflo(w.y); a[3] = bfhi(w.y); b[0] = bflo(w.z); b[1] = bfhi(w.z); b[2] = bflo(w.w); b[3] = bfhi(w.w); }

struct EpiScaled {
    static constexpr bool PERM = true;
    bf16_t* o; int ldc; float sc;
    DI void operator()(const f32x4 (&acc)[2][2][4][2], const Unit& u, int wr, int wc, int fr, int fq) const {
        EPI_ROWS_BEGIN
            const size_t row = (size_t)u.pm * 256 + rt;
#pragma unroll
            for (int bj = 0; bj < 2; ++bj) *(u32x4*)(o + row * ldc + u.pn * 256 + bj * 128 + 32 * wc + 8 * fq) = pack8(acc[ai][bj][m][0] * sc, acc[ai][bj][m][1] * sc);
        EPI_ROWS_END
    }
};
struct EpiK {
    static constexpr bool PERM = true;
    bf16_t* k; float* kmean; float sc;
    DI void operator()(const f32x4 (&acc)[2][2][4][2], const Unit& u, int wr, int wc, int fr, int fq) const {
        const int c0 = u.pn * 256 + 32 * wc + 8 * fq; const int ln = fq * 16 + fr;
        EPI_ROWS_BEGIN
            const size_t row = (size_t)u.pm * 256 + rt;
#pragma unroll
            for (int bj = 0; bj < 2; ++bj) *(u32x4*)(k + row * AW + c0 + bj * 128) = pack8(acc[ai][bj][m][0] * sc, acc[ai][bj][m][1] * sc);
        EPI_ROWS_END
#pragma unroll
        for (int bj = 0; bj < 2; ++bj)
#pragma unroll
            for (int n = 0; n < 2; ++n) { f32x4 s = (f32x4){0.f, 0.f, 0.f, 0.f};
#pragma unroll
                for (int ai = 0; ai < 2; ++ai)
#pragma unroll
                    for (int m = 0; m < 4; ++m) s += acc[ai][bj][m][n];
#pragma unroll
                for (int j = 0; j < 4; ++j) { float x = s[j]; x += shx(x, 1, ln); x += shx(x, 2, ln); x += shx(x, 4, ln); x += shx(x, 8, ln); s[j] = x; }
                if (fr == 0) { float* dst = kmean + (size_t)u.pm * AW + c0 + bj * 128 + 4 * n;
#pragma unroll
                    for (int j = 0; j < 4; ++j) unsafeAtomicAdd(dst + j, s[j] * sc); }
                asm volatile("" ::: "memory"); }
    }
};
struct EpiU {
    static constexpr bool PERM = true;
    bf16_t* ua; float sc;
    DI void operator()(const f32x4 (&acc)[2][2][4][2], const Unit& u, int wr, int wc, int fr, int fq) const {
        EPI_ROWS_BEGIN
            const int row = u.pm * 256 + rt;
#pragma unroll
            for (int bj = 0; bj < 2; ++bj) { const int ch = u.pn * 256 + bj * 128 + 32 * wc + 8 * fq; const int g = ch >> 4, c0 = ch & 15;
                *(u32x4*)(ua + ((size_t)g * CROWS + (row >> 5)) * UAK + (row & 31) * 16 + c0) = pack8(acc[ai][bj][m][0] * sc, acc[ai][bj][m][1] * sc); }
        EPI_ROWS_END
    }
};
DI void store_pair8(unsigned char* base, size_t off0, size_t off1, const u32x2& w0, const u32x2& w1, bool oddq) {
    const auto rx = __builtin_amdgcn_permlane16_swap(w0.x, w1.x, false, false), ry = __builtin_amdgcn_permlane16_swap(w0.y, w1.y, false, false);
    u32x4 ww; ww.x = rx[0]; ww.y = ry[0]; ww.z = rx[1]; ww.w = ry[1];
    *(u32x4*)(base + (oddq ? off1 - 8 : off0)) = ww;
}
struct EpiSig {
    static constexpr bool PERM = true;
    unsigned char* o; float sc;
    DI void operator()(const f32x4 (&acc)[2][2][4][2], const Unit& u, int wr, int wc, int fr, int fq) const {
        const float s2 = sc * GATE8_SCALE; const bool oddq = (fq & 1) != 0;
#pragma unroll
        for (int ai = 0; ai < 2; ++ai)
#pragma unroll
            for (int p2 = 0; p2 < 2; ++p2) { const size_t row0 = (size_t)u.pm * 256 + 128 * ai + 64 * wr + 32 * p2 + fr;
#pragma unroll
                for (int bj = 0; bj < 2; ++bj) { u32x2 w[2];
#pragma unroll
                    for (int r2 = 0; r2 < 2; ++r2) { const f32x4 a = acc[ai][bj][2 * p2 + r2][0] * s2, b = acc[ai][bj][2 * p2 + r2][1] * s2; w[r2].x = pk4_fp8(a[0], a[1], a[2], a[3]); w[r2].y = pk4_fp8(b[0], b[1], b[2], b[3]); }
                    const size_t c = (size_t)(u.pn * 256 + bj * 128 + 32 * wc + 8 * fq);
                    store_pair8(o, row0 * D + c, (row0 + 16) * D + c, w[0], w[1], oddq); } }
    }
};
struct EpiQK {
    static constexpr bool PERM = true;
    bf16_t *q, *k; float* kmean; float sc;
    DI void operator()(const f32x4 (&acc)[2][2][4][2], const Unit& u, int wr, int wc, int fr, int fq) const {
        Unit u2 = u; u2.pn = u.pn & 1;
        if (u.pn < 2) { EpiScaled E{q, AW, sc * (0.125f * LOG2E_C)}; E(acc, u2, wr, wc, fr, fq); }
        else { EpiK E{k, kmean, sc}; E(acc, u2, wr, wc, fr, fq); }
    }
};
struct EpiVUG {
    static constexpr bool PERM = true;
    bf16_t *v, *ua; unsigned char *ga, *gs; float sc;
    DI void operator()(const f32x4 (&acc)[2][2][4][2], const Unit& u, int wr, int wc, int fr, int fq) const {
        Unit u2 = u;
        if (u.pn < 2) { EpiScaled E{v, AW, sc}; E(acc, u2, wr, wc, fr, fq); }
        else if (u.pn < 4) { u2.pn = u.pn - 2; EpiU E{ua, sc}; E(acc, u2, wr, wc, fr, fq); }
        else { u2.pn = (u.pn - 4) & 3; EpiSig E{u.pn < 8 ? ga : gs, sc}; E(acc, u2, wr, wc, fr, fq); }
    }
};
struct EpiG1 {
    static constexpr bool PERM = true;
    EpiQK a; EpiVUG b;
    DI void operator()(const f32x4 (&acc)[2][2][4][2], const Unit& u, int wr, int wc, int fr, int fq) const {
        if (u.pn < 4) a(acc, u, wr, wc, fr, fq); else { Unit u2 = u; u2.pn = u.pn - 4; b(acc, u2, wr, wc, fr, fq); }
    }
};
struct EpiState {
    static constexpr bool PERM = false;
    float* e;
    DI void operator()(const f32x4 (&acc)[2][2][4][2], const Unit& u, int wr, int wc, int fr, int fq) const {
        EPI_ROWS_BEGIN
            if (u.half == 2 - ai) continue;
            float* rowp = e + ((size_t)u.e * CROWS + u.pm * 256 + rt) * 128 + 32 * wc + 4 * fq;
#pragma unroll
            for (int n = 0; n < 2; ++n) *(f32x4*)(rowp + 16 * n) = acc[ai][0][m][n];
        EPI_ROWS_END
    }
};
struct EpiSsmOut {
    static constexpr bool PERM = true;
    bf16_t* y;
    DI void operator()(const f32x4 (&acc)[2][2][4][2], const Unit& u, int wr, int wc, int fr, int fq) const {
        EPI_ROWS_BEGIN
            const int R = u.pm * 256 + rt;
#pragma unroll
            for (int bj = 0; bj < 2; ++bj) { const int col = u.pn * 256 + bj * 128 + 32 * wc + 8 * fq; const int j = col >> 4, c0 = col & 15;
                f32x4 a = acc[ai][bj][m][0], b = acc[ai][bj][m][1];
#pragma unroll
                for (int q = 0; q < 4; ++q) { a[q] = gelu_tanh(a[q]); b[q] = gelu_tanh(b[q]); }
                *(u32x4*)(y + ((size_t)R * 32 + j) * SW + u.e * 16 + c0) = pack8(a, b); }
        EPI_ROWS_END
    }
};
struct EpiGlu {
    static constexpr bool PERM = true;
    unsigned char* z;
    DI void operator()(const f32x4 (&acc)[2][2][4][2], const Unit& u, int wr, int wc, int fr, int fq) const {
        const bool oddq = (fq & 1) != 0;
#pragma unroll
        for (int ai = 0; ai < 2; ++ai)
#pragma unroll
            for (int p2 = 0; p2 < 2; ++p2) { const size_t row0 = (size_t)u.pm * 256 + 128 * ai + 64 * wr + 32 * p2 + fr; u32x2 w[2];
#pragma unroll
                for (int r2 = 0; r2 < 2; ++r2) { const int m = 2 * p2 + r2; f32x4 a = acc[ai][0][m][0], b = acc[ai][0][m][1]; const f32x4 ga = acc[ai][1][m][0], gb = acc[ai][1][m][1];
#pragma unroll
                    for (int q = 0; q < 4; ++q) { a[q] *= AZ8_SCALE * sigmoidf_(ga[q]); b[q] *= AZ8_SCALE * sigmoidf_(gb[q]); }
                    w[r2].x = pk4_fp8(a[0], a[1], a[2], a[3]); w[r2].y = pk4_fp8(b[0], b[1], b[2], b[3]); }
                const size_t c = (size_t)(AW + u.pn * 128 + 32 * wc + 8 * fq);
                store_pair8(z, row0 * D + c, (row0 + 16) * D + c, w[0], w[1], oddq); }
    }
};
struct EpiMerge {
    static constexpr bool PERM = true; static constexpr int MID_T = 4;
    unsigned char* mrg; const unsigned char* gatt; const unsigned char* gssm;
    const LAS float* t1; const LAS float* t2;
    DI void mid(f32x4 (&acc)[2][2][4][2], const Unit& u, int wr, int wc, int fr, int fq) const {
#pragma unroll
        for (int ai = 0; ai < 2; ++ai) {
            u32x2 ga[4][2], gs[4][2];
#pragma unroll
            for (int m = 0; m < 4; ++m) { const size_t row = (size_t)u.pm * 256 + 128 * ai + 64 * wr + 16 * m + fr;
#pragma unroll
                for (int bj = 0; bj < 2; ++bj) { const size_t off = row * D + u.pn * 256 + bj * 128 + 32 * wc + 8 * fq; ga[m][bj] = *(const u32x2*)(gatt + off); gs[m][bj] = *(const u32x2*)(gssm + off); } }
            asm volatile("" ::: "memory");
#pragma unroll
            for (int m = 0; m < 4; ++m)
#pragma unroll
                for (int bj = 0; bj < 2; ++bj) {
#pragma unroll
                    for (int q = 0; q < 4; ++q) {
                        acc[ai][bj][m][0][q] *= t2[(gs[m][bj].x >> (8 * q)) & 255u] * t1[(ga[m][bj].x >> (8 * q)) & 255u];
                        acc[ai][bj][m][1][q] *= t2[(gs[m][bj].y >> (8 * q)) & 255u] * t1[(ga[m][bj].y >> (8 * q)) & 255u]; } }
            asm volatile("" ::: "memory"); }
    }
    DI void operator()(const f32x4 (&acc)[2][2][4][2], const Unit& u, int wr, int wc, int fr, int fq) const {
#pragma unroll
        for (int ai = 0; ai < 2; ++ai) {
            u32x2 gs[4][2];
#pragma unroll
            for (int m = 0; m < 4; ++m) { const size_t row = (size_t)u.pm * 256 + 128 * ai + 64 * wr + 16 * m + fr;
#pragma unroll
                for (int bj = 0; bj < 2; ++bj) gs[m][bj] = *(const u32x2*)(gssm + row * D + u.pn * 256 + bj * 128 + 32 * wc + 8 * fq); }
            asm volatile("" ::: "memory");
#pragma unroll
            for (int p2 = 0; p2 < 2; ++p2) { const size_t row0 = (size_t)u.pm * 256 + 128 * ai + 64 * wr + 32 * p2 + fr;
#pragma unroll
                for (int bj = 0; bj < 2; ++bj) { u32x2 wq[2];
#pragma unroll
                    for (int r2 = 0; r2 < 2; ++r2) { const int m = 2 * p2 + r2; f32x4 sa, sb;
#pragma unroll
                        for (int q = 0; q < 4; ++q) { sa[q] = (MRG8_SCALE / (W8_SCALE * AZ8_SCALE)) * t1[(gs[m][bj].x >> (8 * q)) & 255u]; sb[q] = (MRG8_SCALE / (W8_SCALE * AZ8_SCALE)) * t1[(gs[m][bj].y >> (8 * q)) & 255u]; }
                        const f32x4 va = acc[ai][bj][m][0] * sa, vb = acc[ai][bj][m][1] * sb;
                        wq[r2].x = pk4_fp8(va[0], va[1], va[2], va[3]); wq[r2].y = pk4_fp8(vb[0], vb[1], vb[2], vb[3]); }
                    const size_t c = (size_t)(u.pn * 256 + bj * 128 + 32 * wc + 8 * fq);
                    store_pair8(mrg, row0 * D + c, (row0 + 16) * D + c, wq[0], wq[1], (fq & 1) != 0); } }
            asm volatile("" ::: "memory"); }
    }
};
template <bool ADD> struct EpiGate {
    static constexpr bool PERM = true;
    bf16_t* mrg; const bf16_t* gate;
    DI void operator()(const f32x4 (&acc)[2][2][4][2], const Unit& u, int wr, int wc, int fr, int fq) const {
        EPI_ROWS_BEGIN
            const size_t row = (size_t)u.pm * 256 + rt;
#pragma unroll
            for (int bj = 0; bj < 2; ++bj) { const size_t off = row * D + u.pn * 256 + bj * 128 + 32 * wc + 8 * fq;
                f32x4 ga, gb; unpack8(*(const u32x4*)(gate + off), ga, gb);
                f32x4 a = acc[ai][bj][m][0] * ga, b = acc[ai][bj][m][1] * gb;
                if (ADD) { f32x4 pa, pb; unpack8(*(const u32x4*)(mrg + off), pa, pb); a += pa; b += pb; }
                *(u32x4*)(mrg + off) = pack8(a, b); }
        EPI_ROWS_END
    }
};
struct EpiPlain {
    static constexpr bool PERM = true;
    bf16_t* o; int ldc; float sc;
    DI void operator()(const f32x4 (&acc)[2][2][4][2], const Unit& u, int wr, int wc, int fr, int fq) const {
        EPI_ROWS_BEGIN
            const size_t row = (size_t)u.pm * 256 + rt;
#pragma unroll
            for (int bj = 0; bj < 2; ++bj) *(u32x4*)(o + row * ldc + u.pn * 256 + bj * 128 + 32 * wc + 8 * fq) = pack8(acc[ai][bj][m][0] * sc, acc[ai][bj][m][1] * sc);
        EPI_ROWS_END
    }
};
struct EpiSwiglu {
    static constexpr bool PERM = true; static constexpr int MID_T = 2;
    unsigned char* act; const float* b1; LAS float* bl;
    DI void mid(f32x4 (&)[2][2][4][2], const Unit& u, int wr, int wc, int fr, int fq) const {
        if (wr * 4 + wc == 0) { const int lane = fq * 16 + fr; const float* src = b1 + (size_t)u.e * 2048 + u.pn * 128 + (lane >> 5) * 1024 + (lane & 31) * 4;
            __builtin_amdgcn_global_load_lds((const GAS unsigned*)src, (LAS unsigned*)bl, 16, 0, 0); }
    }
    DI void operator()(const f32x4 (&acc)[2][2][4][2], const Unit& u, int wr, int wc, int fr, int fq) const {
        int lrow = 64 * wr + fr; asm volatile("" : "+v"(lrow));
        const int cj = u.pn * 128 + 32 * wc + 8 * fq; const LAS float* bb = bl + 32 * wc + 8 * fq;
        const f32x4 bg0 = *(const LAS f32x4*)(bb), bg1 = *(const LAS f32x4*)(bb + 4), bu0 = *(const LAS f32x4*)(bb + 128), bu1 = *(const LAS f32x4*)(bb + 132);
        unsigned char* abase = act + (size_t)u.pm * 256 * DFF;
        constexpr float dq = 1.0f / (W8_SCALE * H8_SCALE * PROBE_KREP);
#pragma unroll
        for (int ai = 0; ai < 2; ++ai) { if (u.half == 2 - ai) continue;
            u32x2 wprev = {0u, 0u}; const bool oddq = (fq & 1) != 0;
#pragma unroll
            for (int m = 0; m < 4; ++m) {
            f32x4 g0 = acc[ai][0][m][0] * dq + bg0, g1 = acc[ai][0][m][1] * dq + bg1, u0 = acc[ai][1][m][0] * dq + bu0, u1 = acc[ai][1][m][1] * dq + bu1;
            unsigned wv[2];
#pragma unroll
            for (int hv = 0; hv < 2; ++hv) { const f32x4 gq = hv ? g1 : g0, uq = hv ? u1 : u0; int r = 0;
#pragma unroll
                for (int q = 0; q < 4; q += 2) {
                    f32x2 g = {fminf(gq[q], 7.0f), fminf(gq[q + 1], 7.0f)};
                    const f32x2 up = {fminf(fmaxf(uq[q], -7.0f), 7.0f), fminf(fmaxf(uq[q + 1], -7.0f), 7.0f)};
                    f32x2 t = __builtin_elementwise_fma(up, (f32x2){ACT8_SCALE, ACT8_SCALE}, (f32x2){ACT8_SCALE, ACT8_SCALE}) * g;
                    const f32x2 a = g * (f32x2){-1.702f * 1.4426950408889634f, -1.702f * 1.4426950408889634f};
                    f32x2 e = {__builtin_amdgcn_exp2f(a[0]), __builtin_amdgcn_exp2f(a[1])}; e = e + (f32x2){1.0f, 1.0f};
                    const f32x2 rc = {__builtin_amdgcn_rcpf(e[0]), __builtin_amdgcn_rcpf(e[1])};
                    t = t * rc;
                    r = q ? __builtin_amdgcn_cvt_pk_fp8_f32(t[0], t[1], r, true) : __builtin_amdgcn_cvt_pk_fp8_f32(t[0], t[1], r, false); }
                wv[hv] = (unsigned)r; }
            u32x2 w; w.x = wv[0]; w.y = wv[1];
            if ((m & 1) == 0) wprev = w;
            else {
                const auto rx = __builtin_amdgcn_permlane16_swap(wprev.x, w.x, false, false), ry = __builtin_amdgcn_permlane16_swap(wprev.y, w.y, false, false);
                u32x4 ww; ww.x = rx[0]; ww.y = ry[0]; ww.z = rx[1]; ww.w = ry[1];
                const unsigned off = (unsigned)((128 * ai + 16 * (m - 1 + (oddq ? 1 : 0)) + lrow) * DFF + cj - (oddq ? 8 : 0));
                *(u32x4*)(abase + off) = ww; }
            asm volatile("" ::: "memory"); } }
    }
};
struct EpiMoeOut {
    static constexpr bool PERM = true; static constexpr int MID_T = 2;
    bf16_t* yslot; const float* b2; const int2* lists; LAS int2* entl; LAS float* bl;
    DI void mid(f32x4 (&)[2][2][4][2], const Unit& u, int wr, int wc, int fr, int fq) const {
        const int wid = wr * 4 + wc;
        if (wid < 2) { const int lane = fq * 16 + fr; const char* src = (const char*)lists + ((size_t)u.e * LIST_CAP + u.j * 256 + wid * 128 + lane * 2) * 8;
            __builtin_amdgcn_global_load_lds((const GAS unsigned*)src, (LAS unsigned*)(entl + wid * 128), 16, 0, 0); }
        else if (wid == 2) { const int lane = fq * 16 + fr; const float* src = b2 + (size_t)u.e * D + u.pn * 256 + lane * 4;
            __builtin_amdgcn_global_load_lds((const GAS unsigned*)src, (LAS unsigned*)bl, 16, 0, 0); }
    }
    DI void operator()(const f32x4 (&acc)[2][2][4][2], const Unit& u, int wr, int wc, int fr, int fq) const {
        int lrow = 64 * wr + fr, cwl = 32 * wc + 8 * fq; asm volatile("" : "+v"(lrow), "+v"(cwl));
        const int n = u.n; const int cw = u.pn * 256 + cwl;
        const char* lb = (const char*)lists + (size_t)u.e * LIST_CAP * 8;
        f32x4 bv[2][2];
#pragma unroll
        for (int bj = 0; bj < 2; ++bj) { const LAS float* bb = bl + cwl + bj * 128; bv[bj][0] = *(const LAS f32x4*)bb; bv[bj][1] = *(const LAS f32x4*)(bb + 4); }
        constexpr float dq = 1.0f / (W8_SCALE * ACT8_SCALE);
#pragma unroll
        for (int ai = 0; ai < 2; ++ai) { if (u.half == 2 - ai) continue;
            const bool oddq = (fq & 1) != 0;
#pragma unroll
            for (int p2 = 0; p2 < 2; ++p2) { u32x2 wq[2][2];
                const u32x2 en0 = *(const LAS u32x2*)((const LAS unsigned char*)entl + (128 * ai + 32 * p2 + lrow) * 8), en1 = *(const LAS u32x2*)((const LAS unsigned char*)entl + (128 * ai + 32 * p2 + 16 + lrow) * 8);
#pragma unroll
                for (int r2 = 0; r2 < 2; ++r2) { const int m = 2 * p2 + r2; const float gs = __uint_as_float(r2 ? en1.y : en0.y) * YS8_SCALE;
                    const f32x4 a0 = (acc[ai][0][m][0] * dq + bv[0][0]) * gs, a1 = (acc[ai][0][m][1] * dq + bv[0][1]) * gs, b0 = (acc[ai][1][m][0] * dq + bv[1][0]) * gs, b1 = (acc[ai][1][m][1] * dq + bv[1][1]) * gs;
                    wq[r2][0].x = pk4_fp8(a0[0], a0[1], a0[2], a0[3]); wq[r2][0].y = pk4_fp8(a1[0], a1[1], a1[2], a1[3]); wq[r2][1].x = pk4_fp8(b0[0], b0[1], b0[2], b0[3]); wq[r2][1].y = pk4_fp8(b1[0], b1[1], b1[2], b1[3]); }
                const int msel = 2 * p2 + (oddq ? 1 : 0); const int li = u.j * 256 + 128 * ai + 16 * msel + lrow;
                char* dst = (char*)yslot + ((oddq ? en1.x : en0.x) * (unsigned)D + (unsigned)(cw - (oddq ? 8 : 0)));
#pragma unroll
                for (int bj = 0; bj < 2; ++bj) { const auto rx = __builtin_amdgcn_permlane16_swap(wq[0][bj].x, wq[1][bj].x, false, false), ry = __builtin_amdgcn_permlane16_swap(wq[0][bj].y, wq[1][bj].y, false, false);
                    u32x4 w; w.x = rx[0]; w.y = ry[0]; w.z = rx[1]; w.w = ry[1];
                    if (li < n) *(u32x4*)(dst + 128 * bj) = w; } }
            asm volatile("" ::: "memory"); }
    }
};

struct Frame {
    LAS unsigned char* lds; volatile LAS unsigned* MISC; unsigned* ctl;
    int tid, lane, wave, G, bid;
    float* out; unsigned char* ws;
};
enum { I_X = 0, I_C, I_RELB, I_WADA, I_BADA, I_GPREMIX, I_GPOSTMIX, I_GPREFFN, I_GPOSTFFN, I_WIN, I_ARE, I_AIM, I_LOGDT, I_BRE, I_BIM, I_CRE, I_CIM, I_DSKIP,
       I_WGLU, I_WSSMO, I_WATTO, I_WOUT, I_WROUTER, I_BROUTER, I_WEXPIN, I_BEXPIN, I_WEXPOUT, I_BEXPOUT };
typedef const GAS float* __attribute__((address_space(4))) * kptr_t;
DI kptr_t kargs_now() { kptr_t p = (kptr_t)__builtin_amdgcn_kernarg_segment_ptr(); asm volatile("" : "+s"(p)); return p; }
DI const float* inp(kptr_t k, int i) { return (const float*)k[i]; }
DI unsigned char* opaque_ws(Frame& F) { GAS unsigned char* w = (GAS unsigned char*)F.ws; asm volatile("" : "+s"(w)); return (unsigned char*)w; }
DI void refresh(Frame& F) { int w = F.wave; unsigned ones_ = ~0u; asm volatile("" : "+s"(w), "+s"(ones_)); int ln = (int)__builtin_amdgcn_mbcnt_hi(ones_, __builtin_amdgcn_mbcnt_lo(ones_, 0u)); asm volatile("" : "+v"(ln)); F.tid = w * 64 + ln; F.lane = ln; F.wave = w; int b = blockIdx.x; asm volatile("" : "+s"(b)); F.bid = b; }

struct TItem { const float* W; unsigned char* WT; int N, Kd, kofs, drow0, k0, n0; bool f8, valid; };
DI void item_load(const TItem& d, f32x4 (&v)[16], int lane) {
    const int r4 = lane >> 4, c4 = lane & 15;
    const char* base = (const char*)(d.W + (size_t)d.k0 * d.N + d.n0);
    unsigned voff = (unsigned)(r4 * d.N + 4 * c4) * 4u; asm volatile("" : "+v"(voff));
    const size_t rstep = (size_t)d.N * 16;
#pragma unroll
    for (int i = 0; i < 16; ++i) v[i] = __builtin_nontemporal_load((const f32x4*)(base + i * rstep + voff));
}
DI void item_scatter(const f32x4 (&v)[16], LAS float* scr, int lane) {
    const int r4 = lane >> 4, c4 = lane & 15;
#pragma unroll
    for (int i = 0; i < 16; ++i) { const int k = 4 * i + r4;
#pragma unroll
        for (int j = 0; j < 4; ++j) scr[(4 * c4 + j) * 64 + (k ^ (4 * (c4 ^ j)))] = v[i][j]; }
    LDS_WAIT(); asm volatile("" ::: "memory");
}
template <bool F8> DI void item_gather(const TItem& d, LAS float* scr, int lane) {
    if constexpr (F8) {
        const int nl = lane >> 2, kc = lane & 3;
        unsigned char* base = d.WT + (size_t)d.drow0 * d.Kd + d.kofs + d.k0;
        unsigned voff = (unsigned)(nl * d.Kd + 16 * kc); asm volatile("" : "+v"(voff));
        f32x4 x[16];
#pragma unroll
        for (int t = 0; t < 4; ++t) { const int n = nl + 16 * t; const int sw = 4 * (((n >> 2) & 15) ^ (n & 3));
#pragma unroll
            for (int q = 0; q < 4; ++q) { const int kq = 16 * kc + 4 * q; x[t * 4 + q] = *(const LAS f32x4*)(scr + n * 64 + (kq ^ sw)); } }
        asm volatile("s_waitcnt lgkmcnt(0)" : "+v"(x[0]), "+v"(x[1]), "+v"(x[2]), "+v"(x[3]), "+v"(x[4]), "+v"(x[5]), "+v"(x[6]), "+v"(x[7]),
                     "+v"(x[8]), "+v"(x[9]), "+v"(x[10]), "+v"(x[11]), "+v"(x[12]), "+v"(x[13]), "+v"(x[14]), "+v"(x[15]) :: "memory");
#pragma unroll
        for (int t = 0; t < 4; ++t) { u32x4 o;
#pragma unroll
            for (int q = 0; q < 4; ++q) { const f32x4 y = x[t * 4 + q]; o[q] = pk4_fp8(y[0] * W8_SCALE, y[1] * W8_SCALE, y[2] * W8_SCALE, y[3] * W8_SCALE); }
            *(u32x4*)(base + (size_t)t * 16 * d.Kd + voff) = o; }
    } else {
        const int nl = lane >> 3, kc = lane & 7;
        unsigned char* base = d.WT + ((size_t)d.drow0 * d.Kd + d.kofs + d.k0) * 2;
        unsigned voff = (unsigned)(nl * d.Kd + 8 * kc) * 2u; asm volatile("" : "+v"(voff));
        f32x4 x[16];
#pragma unroll
        for (int t = 0; t < 8; ++t) { const int n = nl + 8 * t; const int sw = 4 * (((n >> 2) & 15) ^ (n & 3));
#pragma unroll
            for (int q = 0; q < 2; ++q) { const int kq = 8 * kc + 4 * q; x[t * 2 + q] = *(const LAS f32x4*)(scr + n * 64 + (kq ^ sw)); } }
        asm volatile("s_waitcnt lgkmcnt(0)" : "+v"(x[0]), "+v"(x[1]), "+v"(x[2]), "+v"(x[3]), "+v"(x[4]), "+v"(x[5]), "+v"(x[6]), "+v"(x[7]),
                     "+v"(x[8]), "+v"(x[9]), "+v"(x[10]), "+v"(x[11]), "+v"(x[12]), "+v"(x[13]), "+v"(x[14]), "+v"(x[15]) :: "memory");
#pragma unroll
        for (int t = 0; t < 8; ++t) { u32x4 o;
#pragma unroll
            for (int q = 0; q < 2; ++q) { const f32x4 y = x[t * 2 + q]; o[2 * q] = pk2(y[0], y[1]); o[2 * q + 1] = pk2(y[2], y[3]); }
            *(u32x4*)(base + (size_t)t * 8 * d.Kd * 2 + voff) = o; }
    }
    LDS_WAIT(); asm volatile("" ::: "memory");
}
DI int imap(int n, int H) { return ((n % H) / 128) * 256 + (n / H) * 128 + (n % 128); }
constexpr int IT_IN = 16 * 64, IT_GLU = 8 * 16, IT_ATT = 8 * 16, IT_SSMO = 8 * 16, IT_OUT = 16 * 16, IT_W1 = 16 * 32, IT_W2 = 16 * 16;
constexpr int IT_LAYER = IT_IN + IT_GLU + IT_ATT + IT_SSMO + IT_OUT + NE * (IT_W1 + IT_W2);
constexpr int IT_SMALL = IT_IN + IT_GLU + IT_ATT + IT_SSMO + IT_OUT, IT_EXP = NE * (IT_W1 + IT_W2);
DI TItem decode_item(kptr_t KA, unsigned char* ws, int kind, int it) {
    TItem d; d.valid = it < (kind == 0 ? DEPTH * IT_SMALL : IT_EXP); if (!d.valid) it = 0;
    const int l = kind == 0 ? it / IT_SMALL : kind - 1; int r = kind == 0 ? it % IT_SMALL : IT_SMALL + it;
    const float* W; unsigned char* WT; int K, N, H = 0; bool f8 = false;
    int nsub = 0, Kd = 0, kofs = 0;
    if (r < IT_IN) { W = inp(KA, I_WIN) + (size_t)l * D * INW; K = D; N = INW;
        WT = ws + WS_WIN + (size_t)l * INW * D; f8 = true; }
    else if ((r -= IT_IN) < IT_GLU) { W = inp(KA, I_WGLU) + (size_t)l * SW * 1024; WT = ws + WS_WGLU + (size_t)l * 1024 * SW * 2; K = SW; N = 1024; H = 512; }
    else if ((r -= IT_GLU) < IT_ATT) { W = inp(KA, I_WATTO) + (size_t)l * AW * D; WT = ws + WS_WCAT + (size_t)l * D * D; K = AW; N = D; Kd = D; f8 = true; }
    else if ((r -= IT_ATT) < IT_SSMO) { W = inp(KA, I_WSSMO) + (size_t)l * SW * D; WT = ws + WS_WCAT + (size_t)l * D * D; K = SW; N = D; Kd = D; kofs = AW; f8 = true; }
    else if ((r -= IT_SSMO) < IT_OUT) { W = inp(KA, I_WOUT) + (size_t)l * D * D; WT = ws + WS_WOUT + (size_t)l * D * D; K = D; N = D; f8 = true; }
    else if ((r -= IT_OUT) < NE * IT_W1) { const int e = r / IT_W1; r %= IT_W1; W = inp(KA, I_WEXPIN) + ((size_t)l * NE + e) * D * 2048; WT = ws + WS_W1 + ((size_t)l * NE + e) * 2048 * D; K = D; N = 2048; H = 1024; f8 = true; }
    else { r -= NE * IT_W1; const int e = r / IT_W2; r %= IT_W2; W = inp(KA, I_WEXPOUT) + ((size_t)l * NE + e) * DFF * D; WT = ws + WS_W2 + ((size_t)l * NE + e) * D * DFF; K = DFF; N = D; f8 = true; }
    const int nblk = N / 64, kb = r / nblk, nb = r % nblk, n0 = nb * 64;
    d.W = W; d.WT = WT; d.N = N; d.Kd = Kd ? Kd : K; d.kofs = kofs; d.drow0 = (H ? imap(n0, H) : n0) - nsub; d.k0 = kb * 64; d.n0 = n0; d.f8 = f8;
    return d;
}
struct QState { int base, cnt; };
DI void run_items1(Frame& F, int kind, int quota, QState& q) {
    const kptr_t KA = kargs_now();
    LAS float* scr = (LAS float*)(F.lds + F.wave * 16384);
    unsigned* qctr = F.ctl + CW_QUEUE + 64 * kind;
#define RI_NEXT(D_) do { if (q.cnt == 8) { int b_ = 0; if (F.lane == 0) b_ = (int)__hip_atomic_fetch_add(qctr, 8u, __ATOMIC_RELAXED, __HIP_MEMORY_SCOPE_AGENT); q.base = __builtin_amdgcn_readfirstlane(b_); q.cnt = 0; } \
        D_ = decode_item(KA, F.ws, kind, q.base + q.cnt); ++q.cnt; } while (0)
    if (quota == 0) return;
    TItem d; RI_NEXT(d); if (!d.valid) return;
    f32x4 v[16]; item_load(d, v, F.lane);
    for (int n = 1; ; ++n) {
        item_scatter(v, scr, F.lane);
        TItem dn; dn.valid = false;
        if (quota < 0 || n < quota) { RI_NEXT(dn); if (dn.valid) item_load(dn, v, F.lane); }
        if (d.f8) item_gather<true>(d, scr, F.lane); else item_gather<false>(d, scr, F.lane);
        if (!dn.valid) break;
        d = dn;
    }
#undef RI_NEXT
}
DI void p_transposes(Frame& F) { refresh(F); QState q; q.base = 0; q.cnt = 8; run_items1(F, 0, -1, q); }
DI void p_adaln_unit(Frame& F, int unit) {
    refresh(F);
    const kptr_t KA = kargs_now();
    const int l = unit / 96, cb = unit % 96;
    LAS float* condT = (LAS float*)F.lds;
    LAS float* part = (LAS float*)(F.lds + 65536);
    for (int i = F.tid; i < NB * D; i += 512) { const int b = i / D, k = i % D; const float v = inp(KA, I_C)[i]; condT[k * 16 + b] = v / (1.0f + __expf(-v)); }
    __syncthreads();
    float acc[16];
#pragma unroll
    for (int b = 0; b < 16; ++b) acc[b] = 0.f;
    const float* wp = inp(KA, I_WADA) + (size_t)l * D * (NMOD * D) + cb * 64 + F.lane;
    for (int k0 = 0; k0 < 128; k0 += 32) {
        float wv[32];
#pragma unroll
        for (int kk = 0; kk < 32; ++kk) wv[kk] = wp[(size_t)(F.wave * 128 + k0 + kk) * (NMOD * D)];
#pragma unroll
        for (int kk = 0; kk < 32; ++kk) { const int k = F.wave * 128 + k0 + kk; const float w = wv[kk];
            const LAS f32x4* cp = (const LAS f32x4*)(condT + k * 16);
#pragma unroll
            for (int q = 0; q < 4; ++q) { const f32x4 cv = cp[q]; acc[4 * q] += cv[0] * w; acc[4 * q + 1] += cv[1] * w; acc[4 * q + 2] += cv[2] * w; acc[4 * q + 3] += cv[3] * w; } } }
#pragma unroll
    for (int b = 0; b < 16; ++b) part[(F.wave * 16 + b) * 64 + F.lane] = acc[b];
    __syncthreads();
    float* mod = (float*)(F.ws + WS_MOD);
    for (int o = F.tid; o < 1024; o += 512) { const int b = o >> 6, col = o & 63; float s = inp(KA, I_BADA)[(size_t)l * NMOD * D + cb * 64 + col];
#pragma unroll
        for (int w = 0; w < 8; ++w) s += part[(w * 16 + b) * 64 + col];
        mod[((size_t)l * NB + b) * (NMOD * D) + cb * 64 + col] = s; }
    __syncthreads();
}
DI double exp_d(double x) {
    const double kf = __builtin_rint(x * 1.4426950408889634); const double r = x - kf * 0.6931471805599453094;
    double t = 1.0, s = 1.0;
#pragma unroll
    for (int i = 1; i <= 16; ++i) { t *= r * (1.0 / (double)i); s += t; }
    const int k = (int)kf;
    return __builtin_ldexp(s, k);
}
DI void sincos_d(double a, double& sn, double& cs) {
    const double k = __builtin_rint(a * 0.15915494309189535); double r = __builtin_fma(-k, 6.283185307179586, a); r = __builtin_fma(-k, 2.4492935982947064e-16, r);
    const double x = r * 0.0625, x2 = x * x;
    double st = x, ct = 1.0, s = x, c = 1.0;
#pragma unroll
    for (int i = 1; i <= 9; ++i) { ct *= -x2 * (1.0 / (double)((2 * i - 1) * (2 * i))); c += ct; st *= -x2 * (1.0 / (double)((2 * i) * (2 * i + 1))); s += st; }
#pragma unroll
    for (int i = 0; i < 4; ++i) { const double s2 = 2.0 * s * c, c2 = c * c - s * s; s = s2; c = c2; }
    sn = s; cs = c;
}
DI void p_ssm_unit(Frame& F, int unit) {
    refresh(F);
    const kptr_t KA = kargs_now();
    const int l = unit / NG, g = unit % NG;
    LAS double* Lp = (LAS double*)F.lds;
    LAS float* Bb = (LAS float*)(F.lds + 33792);
    LAS float* Cc = (LAS float*)(F.lds + 50176);
    LAS float* Kt = (LAS float*)(F.lds + 66560);
    const int lg = l * NG + g;
    const double dt = exp_d((double)inp(KA, I_LOGDT)[lg]);
    for (int i = F.tid; i < 33 * 64; i += 512) { const int tau = i >> 6, p = i & 63;
        const double lre = fmin((double)inp(KA, I_ARE)[lg * SP + p], -1e-4), lim = (double)inp(KA, I_AIM)[lg * SP + p];
        const double mag = exp_d(lre * dt * (double)tau); double sn, cs; sincos_d(lim * dt * (double)tau, sn, cs);
        Lp[i * 2] = mag * cs; Lp[i * 2 + 1] = mag * sn; }
    __syncthreads();
    for (int i = F.tid; i < SP * SG; i += 512) { const int p = i >> 4, cc = i & 15;
        const double lre = fmin((double)inp(KA, I_ARE)[lg * SP + p], -1e-4), lim = (double)inp(KA, I_AIM)[lg * SP + p];
        const double nre = Lp[(64 + p) * 2] - 1.0, nim = Lp[(64 + p) * 2 + 1], den = lre * lre + lim * lim;
        const double zre = (nre * lre + nim * lim) / den, zim = (nim * lre - nre * lim) / den;
        const double br = (double)inp(KA, I_BRE)[((size_t)lg * SP + p) * SG + cc], bi = (double)inp(KA, I_BIM)[((size_t)lg * SP + p) * SG + cc];
        Bb[i * 2] = (float)(zre * br - zim * bi); Bb[i * 2 + 1] = (float)(zre * bi + zim * br); }
    for (int i = F.tid; i < SG * SP; i += 512) { Cc[i * 2] = inp(KA, I_CRE)[(size_t)lg * SG * SP + i]; Cc[i * 2 + 1] = inp(KA, I_CIM)[(size_t)lg * SG * SP + i]; }
    __syncthreads();
    LAS f32x2* Lf = (LAS f32x2*)(F.lds + 99328);
    for (int i = F.tid; i < 33 * 64; i += 512) Lf[i] = (f32x2){(float)Lp[i * 2], (float)Lp[i * 2 + 1]};
    __syncthreads();
    { const int pair = F.tid & 255, cc = pair >> 4, c2 = pair & 15, t0 = (F.tid >> 8) * 16; float acc[16];
#pragma unroll
      for (int q = 0; q < 16; ++q) acc[q] = 0.f;
      for (int p = 0; p < SP; ++p) { const float cr = Cc[(cc * 64 + p) * 2], ci = Cc[(cc * 64 + p) * 2 + 1], br = Bb[(p * 16 + c2) * 2], bi = Bb[(p * 16 + c2) * 2 + 1];
          const float gr = cr * br - ci * bi, gi = cr * bi + ci * br;
#pragma unroll
          for (int q = 0; q < 16; ++q) { const f32x2 lv = Lf[(t0 + q) * 64 + p]; acc[q] += gr * lv[0] - gi * lv[1]; } }
      if (t0 == 0 && cc == c2) acc[0] += inp(KA, I_DSKIP)[l * SW + g * 16 + cc];
#pragma unroll
      for (int q = 0; q < 16; ++q) Kt[((t0 + q) * 16 + cc) * 16 + c2] = acc[q]; }
    __syncthreads();
    bf16_t* bs = (bf16_t*)(F.ws + WS_BSSM) + (size_t)lg * 512 * UAK;
    for (int o = F.tid; o < 512 * (UAK / 8); o += 512) { const int n = o / (UAK / 8), k8 = (o % (UAK / 8)) * 8; const int j = n >> 4, cc = n & 15; float v[8];
        if (k8 < 512) { const int i = k8 >> 4, c0 = k8 & 15;
#pragma unroll
            for (int q = 0; q < 8; ++q) v[q] = (i <= j) ? Kt[((j - i) * 16 + cc) * 16 + c0 + q] : 0.f; }
        else { const int p0 = (k8 - 512) >> 1;
#pragma unroll
            for (int q = 0; q < 4; ++q) { const int p = p0 + q; const float cr = Cc[(cc * 64 + p) * 2], ci = Cc[(cc * 64 + p) * 2 + 1]; const f32x2 lv = Lf[(j + 1) * 64 + p];
                v[2 * q] = cr * lv[0] - ci * lv[1]; v[2 * q + 1] = -(cr * lv[1] + ci * lv[0]); } }
        u32x4 w; w.x = pk2(v[0], v[1]); w.y = pk2(v[2], v[3]); w.z = pk2(v[4], v[5]); w.w = pk2(v[6], v[7]);
        *(u32x4*)(bs + (size_t)n * UAK + k8) = w; }
    bf16_t* be = (bf16_t*)(F.ws + WS_BE) + (size_t)lg * 256 * 512;
    for (int o = F.tid; o < 256 * 64; o += 512) { const int n = o >> 6, k8 = (o & 63) * 8; float v[8];
        if (n < 128) { const int p = n >> 1, ri = n & 1, i = k8 >> 4, c0 = k8 & 15; const f32x2 lv = Lf[(31 - i) * 64 + p]; const float lr = lv[0], li = lv[1];
#pragma unroll
            for (int q = 0; q < 8; ++q) { const float br = Bb[(p * 16 + c0 + q) * 2], bi = Bb[(p * 16 + c0 + q) * 2 + 1]; v[q] = ri ? (lr * bi + li * br) : (lr * br - li * bi); } }
        else {
#pragma unroll
            for (int q = 0; q < 8; ++q) v[q] = 0.f; }
        u32x4 w; w.x = pk2(v[0], v[1]); w.y = pk2(v[2], v[3]); w.z = pk2(v[4], v[5]); w.w = pk2(v[6], v[7]);
        *(u32x4*)(be + (size_t)n * 512 + k8) = w; }
    float* l32 = (float*)(F.ws + WS_L32) + (size_t)lg * SP * 2;
    if (F.tid < SP) { l32[F.tid * 2] = (float)Lp[(32 * 64 + F.tid) * 2]; l32[F.tid * 2 + 1] = (float)Lp[(32 * 64 + F.tid) * 2 + 1]; }
    __syncthreads();
}

DI void load_row_f32(const float* p, int lane, f32x4 (&v)[4]) {
#pragma unroll
    for (int j = 0; j < 4; ++j) v[j] = *(const f32x4*)(p + 4 * lane + 256 * j);
}
DI float wave_sum_dpp(float v) {
#define DPP_ADD_(ctrl, rmask, bc) v += __int_as_float(__builtin_amdgcn_update_dpp(0, __float_as_int(v), ctrl, rmask, 0xf, bc))
    DPP_ADD_(0x111, 0xf, true); DPP_ADD_(0x112, 0xf, true); DPP_ADD_(0x114, 0xf, true); DPP_ADD_(0x118, 0xf, true);
    DPP_ADD_(0x142, 0xa, false); DPP_ADD_(0x143, 0xc, false);
#undef DPP_ADD_
    return __int_as_float(__builtin_amdgcn_readlane(__float_as_int(v), 63)); }
DI float sumsq(const f32x4 (&v)[4], int lane) { float s = 0.f; (void)lane;
#pragma unroll
    for (int j = 0; j < 4; ++j) s += (v[j][0] * v[j][0] + v[j][1] * v[j][1]) + (v[j][2] * v[j][2] + v[j][3] * v[j][3]);
    return wave_sum_dpp(s); }
struct ModP { f32x4 g[4], sc[4], sh[4]; };
DI void load_modp(ModP& m, const float* g, const float* sc, const float* sh, int lane) {
#pragma unroll
    for (int j = 0; j < 4; ++j) { const int o = 4 * lane + 256 * j; m.g[j] = *(const f32x4*)(g + o); m.sc[j] = *(const f32x4*)(sc + o); m.sh[j] = *(const f32x4*)(sh + o); } }
DI void mod_norm_store(const f32x4 (&xv)[4], float rstd, const ModP& m, bf16_t* orow, unsigned char* orow8, int lane, f32x4 (&hv)[4]) {
#pragma unroll
    for (int j = 0; j < 4; ++j) { const int o = 4 * lane + 256 * j; const f32x4 gv = m.g[j], scv = m.sc[j], shv = m.sh[j];
        hv[j] = xv[j] * rstd * gv * (1.0f + scv) + shv;
        u32x2 w; w.x = pk2(hv[j][0], hv[j][1]); w.y = pk2(hv[j][2], hv[j][3]); *(u32x2*)(orow + o) = w;
        *(unsigned*)(orow8 + o) = pk4_fp8(hv[j][0] * H8_SCALE, hv[j][1] * H8_SCALE, hv[j][2] * H8_SCALE, hv[j][3] * H8_SCALE); }
}
DI void mod_norm_store8(const f32x4 (&xv)[4], float rstd, const ModP& m, unsigned char* orow, int lane, f32x4 (&hv)[4]) {
#pragma unroll
    for (int j = 0; j < 4; ++j) { const int o = 4 * lane + 256 * j; const f32x4 gv = m.g[j], scv = m.sc[j], shv = m.sh[j];
        hv[j] = xv[j] * rstd * gv * (1.0f + scv) + shv;
        *(unsigned*)(orow + o) = pk4_fp8(hv[j][0] * H8_SCALE, hv[j][1] * H8_SCALE, hv[j][2] * H8_SCALE, hv[j][3] * H8_SCALE); }
}
DI void phase_n0(Frame& F, int l) {
    refresh(F);
    const kptr_t KA = kargs_now();
    const float* mod = (const float*)(F.ws + WS_MOD) + (size_t)l * NB * NMOD * D;
    const int gw = F.bid * 8 + F.wave, NGW = F.G * 8;
    for (int r0 = gw * 2; r0 < T; r0 += NGW * 2) {
        f32x4 xa[2][4], hv[4];
#pragma unroll
        for (int rr = 0; rr < 2; ++rr) load_row_f32(inp(KA, I_X) + (size_t)(r0 + rr) * D, F.lane, xa[rr]);
        ModP mp; { const int b = r0 / SEQ; load_modp(mp, inp(KA, I_GPREMIX) + l * D, mod + (size_t)b * NMOD * D + 1 * D, mod + (size_t)b * NMOD * D + 0 * D, F.lane); }
#pragma unroll
        for (int rr = 0; rr < 2; ++rr) { const int r = r0 + rr; const float rstd = rsqrtf(sumsq(xa[rr], F.lane) * (1.0f / D) + RMS_EPS);
            mod_norm_store8(xa[rr], rstd, mp, F.ws + WS_HF8 + (size_t)r * D, F.lane, hv); }
    }
}
DI void load_row_bf16(const bf16_t* p, int lane, f32x4 (&v)[4]) {
#pragma unroll
    for (int j = 0; j < 4; ++j) { const u32x2 w = *(const u32x2*)(p + 4 * lane + 256 * j); v[j][0] = bflo(w.x); v[j][1] = bfhi(w.x); v[j][2] = bflo(w.y); v[j][3] = bfhi(w.y); }
}
DI void phase_n1(Frame& F, int l) {
    refresh(F);
    const kptr_t KA = kargs_now();
    constexpr int RP = 2064;
    LAS unsigned char* WTl = F.lds; LAS unsigned char* HTl = F.lds + 32 * RP; LAS float* PS = (LAS float*)(F.lds + 48 * RP);
    volatile LAS int* hist = (volatile LAS int*)(F.MISC + 64); volatile LAS int* basew = (volatile LAS int*)(F.MISC + 96);
    const float* wr_ = inp(KA, I_WROUTER) + (size_t)l * D * NE;
    for (int idx = F.tid; idx < D * 8; idx += 512) { const int k = idx >> 3, c = idx & 7; const f32x4 v = *(const f32x4*)(wr_ + k * 32 + 4 * c);
#pragma unroll
        for (int q = 0; q < 4; ++q) *(LAS bf16_t*)(WTl + (4 * c + q) * RP + k * 2) = (bf16_t)(pk2(v[q], 0.f) & 0xffffu); }
    __syncthreads();
    const float* mod = (const float*)(F.ws + WS_MOD) + (size_t)l * NB * NMOD * D;
    const bf16_t* ymix = (const bf16_t*)(F.ws + WS_YMIX); unsigned char* h8 = F.ws + WS_H8;
    const float* xin = inp(KA, I_X); bf16_t* xb = (bf16_t*)(F.ws + WS_XB);
    int2* lists = (int2*)(F.ws + WS_LISTS); unsigned* cntg = F.ctl + CW_CNT + l * NE * 64;
    const float brt = inp(KA, I_BROUTER)[l * NE + (F.lane & 31)];
    for (int blk = F.bid; blk < T / 16; blk += F.G) {
        if (F.tid < 32) hist[F.tid] = 0;
        f32x4 hv[2][4], yv2[2][4], xv2[2][4];
#pragma unroll
        for (int rr = 0; rr < 2; ++rr) { const int r = blk * 16 + F.wave * 2 + rr;
            load_row_bf16(ymix + (size_t)r * D, F.lane, yv2[rr]); if (l == 0) load_row_f32(xin + (size_t)r * D, F.lane, xv2[rr]); else load_row_bf16(xb + (size_t)r * D, F.lane, xv2[rr]); }
        const float* mb = mod + (size_t)((blk * 16) / SEQ) * NMOD * D;
        f32x4 gpm[4], gtm[4]; ModP mp;
#pragma unroll
        for (int j = 0; j < 4; ++j) { const int o = 4 * F.lane + 256 * j; gpm[j] = *(const f32x4*)(inp(KA, I_GPOSTMIX) + l * D + o); gtm[j] = *(const f32x4*)(mb + 2 * D + o); }
        load_modp(mp, inp(KA, I_GPREFFN) + l * D, mb + 4 * D, mb + 3 * D, F.lane);
#pragma unroll
        for (int rr = 0; rr < 2; ++rr) { const int r = blk * 16 + F.wave * 2 + rr;
            f32x4 (&yv)[4] = yv2[rr]; f32x4 (&xv)[4] = xv2[rr];
            const float rstd_y = rsqrtf(sumsq(yv, F.lane) * (1.0f / D) + RMS_EPS);
#pragma unroll
            for (int j = 0; j < 4; ++j) { const int o = 4 * F.lane + 256 * j; const f32x4 gv = gpm[j], gt = gtm[j];
                xv[j] = xv[j] + gt * (yv[j] * rstd_y * gv); u32x2 w; w.x = pk2(xv[j][0], xv[j][1]); w.y = pk2(xv[j][2], xv[j][3]); *(u32x2*)(xb + (size_t)r * D + o) = w; }
            const float rstd_x = rsqrtf(sumsq(xv, F.lane) * (1.0f / D) + RMS_EPS);
            mod_norm_store8(xv, rstd_x, mp, h8 + (size_t)r * D, F.lane, hv[rr]); }
#pragma unroll
        for (int rr = 0; rr < 2; ++rr)
#pragma unroll
            for (int j = 0; j < 4; ++j) { u32x2 w; w.x = pk2(hv[rr][j][0], hv[rr][j][1]); w.y = pk2(hv[rr][j][2], hv[rr][j][3]); *(LAS u32x2*)(HTl + (F.wave * 2 + rr) * RP + (4 * F.lane + 256 * j) * 2) = w; }
        __syncthreads();
        { const int r16 = F.lane & 15, kg = F.lane >> 4; f32x4 c0 = (f32x4){0.f, 0.f, 0.f, 0.f}, c1 = c0;
#pragma unroll
          for (int st = 0; st < 4; ++st) { const int kb2 = (128 * F.wave + 32 * st + 8 * kg) * 2;
              const bf16x8 af = *(const LAS bf16x8*)(HTl + r16 * RP + kb2), b0 = *(const LAS bf16x8*)(WTl + r16 * RP + kb2), b1 = *(const LAS bf16x8*)(WTl + (16 + r16) * RP + kb2);
              c0 = __builtin_amdgcn_mfma_f32_16x16x32_bf16(af, b0, c0, 0, 0, 0); c1 = __builtin_amdgcn_mfma_f32_16x16x32_bf16(af, b1, c1, 0, 0, 0); }
#pragma unroll
          for (int i = 0; i < 4; ++i) { PS[(F.wave * 16 + 4 * kg + i) * 32 + r16] = c0[i]; PS[(F.wave * 16 + 4 * kg + i) * 32 + 16 + r16] = c1[i]; } }
        __syncthreads();
        float lgs = 0.f;
#pragma unroll
        for (int w = 0; w < 8; ++w) lgs += PS[(w * 16 + F.wave * 2 + (F.lane >> 5)) * 32 + (F.lane & 31)];
        float lg = lgs + brt; const int e_me = F.lane & 31;
        float topv[4]; int tope[4];
#pragma unroll
        for (int k = 0; k < 4; ++k) { float mv = lg; int mi = e_me;
#pragma unroll
            for (int st = 0; st < 4; ++st) {
                float ov; int oi;
                if (st == 0) { ov = __int_as_float(__builtin_amdgcn_update_dpp(0, __float_as_int(mv), 0x121, 0xf, 0xf, false)); oi = __builtin_amdgcn_update_dpp(0, mi, 0x121, 0xf, 0xf, false); }
                else if (st == 1) { ov = __int_as_float(__builtin_amdgcn_update_dpp(0, __float_as_int(mv), 0x122, 0xf, 0xf, false)); oi = __builtin_amdgcn_update_dpp(0, mi, 0x122, 0xf, 0xf, false); }
                else if (st == 2) { ov = __int_as_float(__builtin_amdgcn_update_dpp(0, __float_as_int(mv), 0x124, 0xf, 0xf, false)); oi = __builtin_amdgcn_update_dpp(0, mi, 0x124, 0xf, 0xf, false); }
                else { ov = __int_as_float(__builtin_amdgcn_update_dpp(0, __float_as_int(mv), 0x128, 0xf, 0xf, false)); oi = __builtin_amdgcn_update_dpp(0, mi, 0x128, 0xf, 0xf, false); }
                if (ov > mv || (ov == mv && oi < mi)) { mv = ov; mi = oi; } }
            { const float ov = shx(mv, 16, F.lane); const int oi = shxi(mi, 16, F.lane); if (ov > mv || (ov == mv && oi < mi)) { mv = ov; mi = oi; } }
            topv[k] = mv; tope[k] = mi; if (e_me == mi) lg = -INFINITY; }
        const float e1 = __expf(topv[1] - topv[0]), e2 = __expf(topv[2] - topv[0]), e3 = __expf(topv[3] - topv[0]); const float inv = 1.0f / (1.0f + e1 + e2 + e3);
        const int ks = F.lane & 31; const bool slot = ks < 4;
        const int my_e = ks == 0 ? tope[0] : (ks == 1 ? tope[1] : (ks == 2 ? tope[2] : tope[3]));
        const float my_g = (ks == 0 ? 1.0f : (ks == 1 ? e1 : (ks == 2 ? e2 : e3))) * inv;
        const int row = blk * 16 + F.wave * 2 + (F.lane >> 5);
        __syncthreads();
        int lrank = 0; if (slot) lrank = atomicAdd((int*)(hist + my_e), 1);
        __syncthreads();
        if (F.tid < 32) { const int n = hist[F.tid]; basew[F.tid] = n ? (int)atomicAdd(cntg + F.tid * 64, (unsigned)n) : 0; }
        __syncthreads();
        if (slot) { const int pos = basew[my_e] + lrank; int2 ent; ent.x = row * 4 + ks; ent.y = __float_as_int(my_g); lists[(size_t)my_e * LIST_CAP + pos] = ent; }
    }
    __syncthreads();
}
DI void load_row_fp8(const unsigned char* p, int lane, f32x4 (&v)[4]) {
#pragma unroll
    for (int j = 0; j < 4; ++j) { const unsigned w = *(const unsigned*)(p + 4 * lane + 256 * j); const f32x2 lo = __builtin_amdgcn_cvt_pk_f32_fp8((int)w, false), hi = __builtin_amdgcn_cvt_pk_f32_fp8((int)w, true); v[j] = (f32x4){lo[0], lo[1], hi[0], hi[1]}; }
}
DI void phase_n2(Frame& F, int l) {
    refresh(F);
    const kptr_t KA = kargs_now();
    const float* mod = (const float*)(F.ws + WS_MOD) + (size_t)l * NB * NMOD * D; const unsigned char* ys = F.ws + WS_YSLOT; bf16_t* xb = (bf16_t*)(F.ws + WS_XB);
    const int gw = F.bid * 8 + F.wave, NGW = F.G * 8;
    for (int r0 = gw * 2; r0 < T; r0 += NGW * 2) {
        f32x4 ya[2][4][4], xa[2][4];
#pragma unroll
        for (int rr = 0; rr < 2; ++rr) { const int r = r0 + rr;
#pragma unroll
            for (int k = 0; k < 4; ++k) load_row_fp8(ys + ((size_t)r * 4 + k) * D, F.lane, ya[rr][k]);
            load_row_bf16(xb + (size_t)r * D, F.lane, xa[rr]); }
        const float* mb = mod + (size_t)(r0 / SEQ) * NMOD * D;
        f32x4 gpf[4], gtf[4]; ModP mp;
#pragma unroll
        for (int j = 0; j < 4; ++j) { const int o = 4 * F.lane + 256 * j; gpf[j] = *(const f32x4*)(inp(KA, I_GPOSTFFN) + l * D + o); gtf[j] = *(const f32x4*)(mb + 5 * D + o); }
        if (l + 1 < DEPTH) { const float* mb2 = mb + (size_t)NB * NMOD * D; load_modp(mp, inp(KA, I_GPREMIX) + (l + 1) * D, mb2 + 1 * D, mb2 + 0 * D, F.lane); }
#pragma unroll
        for (int rr = 0; rr < 2; ++rr) { const int r = r0 + rr;
            f32x4 yv[4], hv[4]; f32x4 (&xv)[4] = xa[rr];
#pragma unroll
            for (int j = 0; j < 4; ++j) yv[j] = ((ya[rr][0][j] + ya[rr][1][j]) + (ya[rr][2][j] + ya[rr][3][j])) * (1.0f / YS8_SCALE);
            const float rstd_y = rsqrtf(sumsq(yv, F.lane) * (1.0f / D) + RMS_EPS);
#pragma unroll
            for (int j = 0; j < 4; ++j) { const int o = 4 * F.lane + 256 * j; const f32x4 gv = gpf[j], gt = gtf[j];
                xv[j] = xv[j] + gt * (yv[j] * rstd_y * gv);
                if (l + 1 < DEPTH) { u32x2 w; w.x = pk2(xv[j][0], xv[j][1]); w.y = pk2(xv[j][2], xv[j][3]); *(u32x2*)(xb + (size_t)r * D + o) = w; } else *(f32x4*)(F.out + (size_t)r * D + o) = xv[j]; }
            if (l + 1 < DEPTH) { const float rstd_x = rsqrtf(sumsq(xv, F.lane) * (1.0f / D) + RMS_EPS);
                mod_norm_store8(xv, rstd_x, mp, F.ws + WS_HF8 + (size_t)r * D, F.lane, hv); } }
    }
}
DI void phase_scan(Frame& F, int l) {
    refresh(F);
    const float* E = (const float*)(F.ws + WS_E); bf16_t* ua = (bf16_t*)(F.ws + WS_UA); const float* l32 = (const float*)(F.ws + WS_L32) + (size_t)l * NG * SP * 2;
    for (int u = F.bid; u < NG * 2; u += F.G) { const int g = u >> 1, b = (u & 1) * 8 + (F.tid >> 6), p = F.tid & 63;
        const float lr = l32[(g * SP + p) * 2], li = l32[(g * SP + p) * 2 + 1];
        const size_t row0 = (size_t)g * CROWS + b * NCH; float sr = 0.f, si = 0.f;
        f32x2 ev[NCH];
#pragma unroll
        for (int k = 0; k < NCH; ++k) ev[k] = *(const f32x2*)(E + (row0 + k) * 128 + 2 * p);
        asm volatile("" ::: "memory");
#pragma unroll
        for (int k = 0; k < NCH; ++k) {
            *(unsigned*)(ua + (row0 + k) * UAK + 512 + 2 * p) = pk2(sr, si);
            const float nr = lr * sr - li * si + ev[k][0], ni = lr * si + li * sr + ev[k][1]; sr = nr; si = ni; }
    }
}
constexpr float LOG2E = 1.4426950408889634f;
DI int t5_bucket(int n) { return n < 16 ? n : 16 + (n >= 19) + (n >= 21) + (n >= 24) + (n >= 27) + (n >= 31) + (n >= 35) + (n >= 40) + (n >= 46) + (n >= 52) + (n >= 59) + (n >= 67) + (n >= 77) + (n >= 87) + (n >= 99) + (n >= 113); }
#define MFMA32(a, b, c) __builtin_amdgcn_mfma_f32_32x32x16_bf16((a), (b), (c), 0, 0, 0)
DI void phase_attn(Frame& F, int l) {
    refresh(F);
    const kptr_t KA = kargs_now();
    const bf16_t* qb = (const bf16_t*)(F.ws + WS_Q); const bf16_t* kb = (const bf16_t*)(F.ws + WS_K); const bf16_t* vb = (const bf16_t*)(F.ws + WS_V);
    const float* kmean = (const float*)(F.ws + WS_KMEAN) + (size_t)l * NB * NBLK * AW; unsigned char* att = F.ws + WS_AZ;
    constexpr int ATT_BUF = 9216;
    LAS unsigned char* KS = F.lds; LAS unsigned char* VS = F.lds + 2 * ATT_BUF; LAS float* BIAS = (LAS float*)(F.lds + 4 * ATT_BUF); LAS float* KM = (LAS float*)(F.lds + 4 * ATT_BUF + 512); LAS int* OVF = (LAS int*)(F.lds + 4 * ATT_BUF + 512 + 2048);
    constexpr int ATT_RC = 208, ATT_RN = 280; LAS float* RT = (LAS float*)(F.lds + 4 * ATT_BUF + 512 + 2048 + 64);
    QState cq; cq.base = 0; cq.cnt = 8;
    constexpr int SLOT_ITEMS = 3;
    if (F.bid & 1) { __syncthreads(); run_items1(F, 1 + l, SLOT_ITEMS, cq); }
    for (int U = F.bid; U < NB * NH * NBLK; U += F.G) {
        refresh(F);
        const int lane = F.lane, wave = F.wave, qi = lane & 31, hh = lane >> 5;
        const int srow = F.tid >> 3, sch = F.tid & 7;
        const int c = U & 255, it = U >> 8, bh = c >> 1, set = c & 1;
        const int qblk = set ? (it == 0 ? 6 : (it == 1 ? 1 : (it == 2 ? 5 : 2))) : (it == 0 ? 7 : (it == 1 ? 0 : (it == 2 ? 4 : 3)));
        const int b = bh >> 3, h = bh & 7;
        const size_t qtok = (size_t)b * SEQ + qblk * 256 + 32 * wave + qi;
        bf16x8 qf[4];
#pragma unroll
        for (int s = 0; s < 4; ++s) qf[s] = *(const bf16x8*)(qb + qtok * AW + h * HD + 16 * s + 8 * hh);
        u32x4 kreg, vreg;
        { const size_t tok = (size_t)b * SEQ + qblk * 256 + srow; kreg = *(const u32x4*)(kb + tok * AW + h * HD + sch * 8); vreg = *(const u32x4*)(vb + tok * AW + h * HD + sch * 8); }
        const float km_v = kmean[((size_t)(b * NBLK + (F.tid >> 6))) * AW + h * HD + (F.tid & 63)] * (1.0f / 256.0f);
        const float bias_v = inp(KA, I_RELB)[t5_bucket(F.tid & 127) * NH + h] * LOG2E;
        __syncthreads();
        if (F.tid < 128) BIAS[F.tid] = bias_v;
        if (F.tid == 0) OVF[0] = 0;
        KM[F.tid] = km_v;
        *(LAS u32x4*)(KS + srow * 144 + sch * 16) = kreg; *(LAS u32x4*)(VS + srow * 144 + sch * 16) = vreg;
        { const size_t tok = (size_t)b * SEQ + qblk * 256 + 64 + srow; kreg = *(const u32x4*)(kb + tok * AW + h * HD + sch * 8); vreg = *(const u32x4*)(vb + tok * AW + h * HD + sch * 8); }
        __syncthreads();
        for (int e = F.tid; e < 4 * ATT_RN; e += 512) { const int cpy = e / ATT_RN, dist = ATT_RC - (e - cpy * ATT_RN + cpy); RT[e] = dist < 0 ? -1.0e30f : BIAS[dist > 127 ? 127 : dist]; }
        const float bfar = BIAS[127];
        unsigned selmask = 0;
        {
            float gsc[8];
#pragma unroll
            for (int j = 0; j < 8; ++j) { float a = 0.f;
#pragma unroll
                for (int s = 0; s < 4; ++s)
#pragma unroll
                    for (int e = 0; e < 8; ++e) a += __uint_as_float(((unsigned)(unsigned short)qf[s][e]) << 16) * KM[j * 64 + 16 * s + 8 * hh + e];
                a = half_sum(a); gsc[j] = (j < qblk) ? a : -INFINITY; }
#pragma unroll
            for (int rnd = 0; rnd < 3; ++rnd) { float bv = -INFINITY; int bi = -1;
#pragma unroll
                for (int j = 0; j < 8; ++j) if (gsc[j] > bv) { bv = gsc[j]; bi = j; }
                if (bi >= 0) selmask |= 1u << bi;
#pragma unroll
                for (int j = 0; j < 8; ++j) if (j == bi) gsc[j] = -INFINITY; }
        }
        f32x16 o[2], lacc; float l_run; const bf16x8 ones8 = {(short)0x3F80, (short)0x3F80, (short)0x3F80, (short)0x3F80, (short)0x3F80, (short)0x3F80, (short)0x3F80, (short)0x3F80};
        const int n_tiles = 4 * (qblk + 1);
        const int pv_q = (lane & 15) >> 2, pv_p = lane & 3, pv_c = (lane >> 4) & 1;
#define ATT_JB(T) ((T) < 4 ? qblk : qblk - 1 - (((T) - 4) >> 2))
#define ATT_KT(T) ((T) < 4 ? (T) : ((T) < 6 ? 7 - (T) : ((T) < 8 ? (T) - 6 : ((T) & 3))))
#define ATT_TOK(T) ((size_t)b * SEQ + ATT_JB(T) * 256 + ATT_KT(T) * 64 + srow)
#define ATT_PV_STEP(S_) do { const int ks_ = (S_) >> 1, r0_ = 8 * ((S_) & 1); u32x4 w_; \
            w_.x = pk2(st[ks_][r0_], st[ks_][r0_ + 1]); w_.y = pk2(st[ks_][r0_ + 2], st[ks_][r0_ + 3]); w_.z = pk2(st[ks_][r0_ + 4], st[ks_][r0_ + 5]); w_.w = pk2(st[ks_][r0_ + 6], st[ks_][r0_ + 7]); \
            const bf16x8 pfs_ = __builtin_bit_cast(bf16x8, w_); \
            _Pragma("unroll") for (int ds_ = 0; ds_ < 2; ++ds_) { const LAS unsigned char* base_ = VSb + (16 * (S_) + 4 * hh + pv_q) * 144 + (32 * ds_ + 16 * pv_c + 4 * pv_p) * 2; \
                const s16x4 lo_ = __builtin_amdgcn_ds_read_tr16_b64_v4i16((LAS s16x4*)base_), hi_ = __builtin_amdgcn_ds_read_tr16_b64_v4i16((LAS s16x4*)(base_ + 8 * 144)); \
                bf16x8 vf_; vf_[0] = lo_[0]; vf_[1] = lo_[1]; vf_[2] = lo_[2]; vf_[3] = lo_[3]; vf_[4] = hi_[0]; vf_[5] = hi_[1]; vf_[6] = hi_[2]; vf_[7] = hi_[3]; \
                o[ds_] = MFMA32(vf_, pfs_, o[ds_]); } } while (0)
#define ATT_BODY(NEAR_, RP_) do { \
            bf16x8 kf[8]; f32x16 st[2];                                                  \
            _Pragma("unroll") for (int ks_ = 0; ks_ < 2; ++ks_) _Pragma("unroll") for (int s_ = 0; s_ < 4; ++s_) kf[ks_ * 4 + s_] = *(const LAS bf16x8*)(KSb + (32 * ks_ + qi) * 144 + 32 * s_ + 16 * hh); \
            if (NEAR_) { \
                _Pragma("unroll") for (int ks_ = 0; ks_ < 2; ++ks_) _Pragma("unroll") for (int g_ = 0; g_ < 4; ++g_) { const f32x4 t_ = *(const LAS f32x4*)((RP_) + (32 * ks_ + 8 * g_) * 4); \
                    st[ks_][4 * g_] = t_[0]; st[ks_][4 * g_ + 1] = t_[1]; st[ks_][4 * g_ + 2] = t_[2]; st[ks_][4 * g_ + 3] = t_[3]; } \
                asm volatile("s_waitcnt lgkmcnt(0)" : "+v"(kf[0]), "+v"(kf[1]), "+v"(kf[2]), "+v"(kf[3]), "+v"(kf[4]), "+v"(kf[5]), "+v"(kf[6]), "+v"(kf[7]), "+v"(st[0]), "+v"(st[1]) :: "memory"); \
                _Pragma("unroll") for (int s_ = 0; s_ < 4; ++s_) _Pragma("unroll") for (int ks_ = 0; ks_ < 2; ++ks_) st[ks_] = MFMA32(kf[ks_ * 4 + s_], qf[s_], st[ks_]); \
            } else { \
                const float cbm = lane_sel ? bfar : -1.0e30f;                             \
                f32x16 negm; _Pragma("unroll") for (int i_ = 0; i_ < 16; ++i_) negm[i_] = cbm; \
                asm volatile("s_waitcnt lgkmcnt(0)" : "+v"(kf[0]), "+v"(kf[1]), "+v"(kf[2]), "+v"(kf[3]), "+v"(kf[4]), "+v"(kf[5]), "+v"(kf[6]), "+v"(kf[7]) :: "memory"); \
                _Pragma("unroll") for (int s_ = 0; s_ < 4; ++s_) _Pragma("unroll") for (int ks_ = 0; ks_ < 2; ++ks_) st[ks_] = MFMA32(kf[ks_ * 4 + s_], qf[s_], s_ == 0 ? negm : st[ks_]); } \
            s16x4 vlo[8], vhi[8];                                                        \
            _Pragma("unroll") for (int s_ = 0; s_ < 4; ++s_) _Pragma("unroll") for (int ds_ = 0; ds_ < 2; ++ds_) { const LAS unsigned char* base_ = VSb + (16 * s_ + 4 * hh + pv_q) * 144 + (32 * ds_ + 16 * pv_c + 4 * pv_p) * 2; \
                vlo[s_ * 2 + ds_] = __builtin_amdgcn_ds_read_tr16_b64_v4i16((LAS s16x4*)base_); vhi[s_ * 2 + ds_] = __builtin_amdgcn_ds_read_tr16_b64_v4i16((LAS s16x4*)(base_ + 8 * 144)); } \
            asm volatile("" ::: "memory"); \
            _Pragma("unroll") for (int s4_ = 0; s4_ < 4; ++s4_) { const int ks_ = s4_ >> 1, r0_ = 8 * (s4_ & 1);        \
                _Pragma("unroll") for (int j_ = 0; j_ < 8; j_ += 2) { const float p0_ = __builtin_amdgcn_exp2f(st[ks_][r0_ + j_]), p1_ = __builtin_amdgcn_exp2f(st[ks_][r0_ + j_ + 1]); st[ks_][r0_ + j_] = p0_; st[ks_][r0_ + j_ + 1] = p1_; } \
                if (s4_ == 0) asm volatile("s_waitcnt lgkmcnt(0)" : "+v"(vlo[0]), "+v"(vlo[1]), "+v"(vlo[2]), "+v"(vlo[3]), "+v"(vlo[4]), "+v"(vlo[5]), "+v"(vlo[6]), "+v"(vlo[7]), \
                         "+v"(vhi[0]), "+v"(vhi[1]), "+v"(vhi[2]), "+v"(vhi[3]), "+v"(vhi[4]), "+v"(vhi[5]), "+v"(vhi[6]), "+v"(vhi[7]) :: "memory"); \
                u32x4 w_; w_.x = pk2(st[ks_][r0_], st[ks_][r0_ + 1]); w_.y = pk2(st[ks_][r0_ + 2], st[ks_][r0_ + 3]); w_.z = pk2(st[ks_][r0_ + 4], st[ks_][r0_ + 5]); w_.w = pk2(st[ks_][r0_ + 6], st[ks_][r0_ + 7]); \
                const bf16x8 pfs_ = __builtin_bit_cast(bf16x8, w_); \
                _Pragma("unroll") for (int ds_ = 0; ds_ < 2; ++ds_) { const s16x4 lo_ = vlo[s4_ * 2 + ds_], hi_ = vhi[s4_ * 2 + ds_]; \
                    bf16x8 vf_; vf_[0] = lo_[0]; vf_[1] = lo_[1]; vf_[2] = lo_[2]; vf_[3] = lo_[3]; vf_[4] = hi_[0]; vf_[5] = hi_[1]; vf_[6] = hi_[2]; vf_[7] = hi_[3]; \
                    o[ds_] = MFMA32(vf_, pfs_, o[ds_]); } \
                lacc = MFMA32(ones8, pfs_, lacc); }        \
            } while (0)
#define ATT_ADVANCE(T) do { if ((T) + 1 < n_tiles) { \
                LAS unsigned char* KSn = KS + (((T) + 1) & 1) * ATT_BUF; LAS unsigned char* VSn = VS + (((T) + 1) & 1) * ATT_BUF; \
                *(LAS u32x4*)(KSn + srow * 144 + sch * 16) = kreg; *(LAS u32x4*)(VSn + srow * 144 + sch * 16) = vreg; \
                if ((T) + 2 < n_tiles) { const int t2_ = (T) + 2; const size_t tok_ = ATT_TOK(t2_); \
                    kreg = *(const u32x4*)(kb + tok_ * AW + h * HD + sch * 8); vreg = *(const u32x4*)(vb + tok_ * AW + h * HD + sch * 8); } } \
            __syncthreads(); } while (0)
#define ATT_PRIME() \
            u32x4 kreg, vreg; \
            { const size_t tok = ATT_TOK(0); kreg = *(const u32x4*)(kb + tok * AW + h * HD + sch * 8); vreg = *(const u32x4*)(vb + tok * AW + h * HD + sch * 8); } \
            *(LAS u32x4*)(KS + srow * 144 + sch * 16) = kreg; *(LAS u32x4*)(VS + srow * 144 + sch * 16) = vreg; \
            { const size_t tok = ATT_TOK(1); kreg = *(const u32x4*)(kb + tok * AW + h * HD + sch * 8); vreg = *(const u32x4*)(vb + tok * AW + h * HD + sch * 8); } \
            __syncthreads();
        {
#pragma unroll
            for (int i = 0; i < 16; ++i) { o[0][i] = 0.f; o[1][i] = 0.f; }
            l_run = 0.f;
#pragma unroll
            for (int i = 0; i < 16; ++i) lacc[i] = 0.f;
            __syncthreads();
            const int nA = n_tiles < 6 ? n_tiles : 6;
            int ti = 0;
            for (; ti < nA; ++ti) {
                LAS unsigned char* KSb = KS + (ti & 1) * ATT_BUF; LAS unsigned char* VSb = VS + (ti & 1) * ATT_BUF;
                const bool own = ti < 4; const int jb = ATT_JB(ti), kt = ATT_KT(ti);
                const bool lane_sel = own || (((selmask >> jb) & 1u) != 0u);
                const bool active = own ? (kt <= (wave >> 1)) : (__ballot(lane_sel) != 0ull);
                if (active) {
                    const int toff = (qblk - jb) * 256 + 32 * wave - 64 * kt;
                    if (toff - 63 < 113) {
                        const int y0 = ATT_RC - toff - qi + 4 * hh;
                        const LAS unsigned char* rp = (const LAS unsigned char*)RT + (lane_sel ? (y0 & 3) * (ATT_RN * 4) + (y0 & ~3) * 4 : (ATT_RC + 4) * 4);
                        ATT_BODY(1, rp);
                    } else { ATT_BODY(0, (const LAS unsigned char*)RT); }
                }
                ATT_ADVANCE(ti);
            }
            for (; ti < n_tiles; ++ti) {
                LAS unsigned char* KSb = KS + (ti & 1) * ATT_BUF; LAS unsigned char* VSb = VS + (ti & 1) * ATT_BUF;
                const int jb = ATT_JB(ti);
                const bool lane_sel = ((selmask >> jb) & 1u) != 0u;
                if (__ballot(lane_sel) != 0ull) ATT_BODY(0, (const LAS unsigned char*)RT);
                ATT_ADVANCE(ti);
            }
            l_run = 0.5f * lacc[0];
            { const float lchk = half_sum(l_run);
              if (__ballot(!(lchk > 5.5e-20f && lchk < 1.8e19f)) != 0ull && lane == 0) *(volatile LAS int*)OVF = 1; }
            __syncthreads();
        }
        if (*(volatile LAS int*)OVF != 0) {
            __syncthreads();
#pragma unroll
            for (int i = 0; i < 16; ++i) { o[0][i] = 0.f; o[1][i] = 0.f; }
            l_run = 0.f; float m_run = -INFINITY;
            ATT_PRIME()
            for (int ti = 0; ti < n_tiles; ++ti) {
                LAS unsigned char* KSb = KS + (ti & 1) * ATT_BUF; LAS unsigned char* VSb = VS + (ti & 1) * ATT_BUF;
                const bool own = ti < 4; const int jb = ATT_JB(ti), kt = ATT_KT(ti);
                const bool lane_sel = own || (((selmask >> jb) & 1u) != 0u);
                const bool active = own ? (kt <= (wave >> 1)) : (__ballot(lane_sel) != 0ull);
                if (active) {
                    f32x16 st[2]; float ls = 0.f;
#pragma unroll
                    for (int ks = 0; ks < 2; ++ks) {
#pragma unroll
                        for (int i = 0; i < 16; ++i) st[ks][i] = 0.f;
#pragma unroll
                        for (int s = 0; s < 4; ++s) { const bf16x8 a = *(const LAS bf16x8*)(KSb + (32 * ks + qi) * 144 + 32 * s + 16 * hh); st[ks] = MFMA32(a, qf[s], st[ks]); } }
                    const int dbase = (qblk - jb) * 256 + 32 * wave + qi - 64 * kt - 4 * hh;
                    float mx = -INFINITY;
#pragma unroll
                    for (int ks = 0; ks < 2; ++ks)
#pragma unroll
                        for (int i = 0; i < 16; ++i) { const int dist = dbase - (32 * ks + (i & 3) + 8 * (i >> 2));
                            const float bias = ((volatile LAS float*)BIAS)[dist < 0 ? 0 : (dist > 127 ? 127 : dist)];
                            const bool valid = lane_sel && (!own || dist >= 0);
                            const float sv = valid ? st[ks][i] + bias : -INFINITY; st[ks][i] = sv; mx = fmaxf(mx, sv); }
                    mx = half_max(mx);
                    const float m_new = fmaxf(m_run, mx);
                    const float m_use = (m_new > -1.0e37f) ? m_new : 0.f;
                    const float alpha = __builtin_amdgcn_exp2f(m_run - m_use); m_run = m_new;
#pragma unroll
                    for (int ks = 0; ks < 2; ++ks)
#pragma unroll
                        for (int i = 0; i < 16; ++i) { const float p = __builtin_amdgcn_exp2f(st[ks][i] - m_use); st[ks][i] = p; ls += p; }
                    l_run = l_run * alpha + ls;
#pragma unroll
                    for (int i = 0; i < 16; ++i) { o[0][i] *= alpha; o[1][i] *= alpha; }
#pragma unroll
                    for (int s4 = 0; s4 < 4; ++s4) ATT_PV_STEP(s4);
                }
                ATT_ADVANCE(ti);
            }
        }
#undef ATT_PV_STEP
#undef ATT_BODY
#undef ATT_ADVANCE
#undef ATT_PRIME
#undef ATT_JB
#undef ATT_KT
#undef ATT_TOK
        const float ltot = half_sum(l_run); const float inv = AZ8_SCALE / ltot;
#pragma unroll
        for (int ds = 0; ds < 2; ++ds)
#pragma unroll
            for (int g4 = 0; g4 < 4; g4 += 2) {
                const unsigned wa = pk4_fp8(o[ds][4 * g4] * inv, o[ds][4 * g4 + 1] * inv, o[ds][4 * g4 + 2] * inv, o[ds][4 * g4 + 3] * inv), wb = pk4_fp8(o[ds][4 * g4 + 4] * inv, o[ds][4 * g4 + 5] * inv, o[ds][4 * g4 + 6] * inv, o[ds][4 * g4 + 7] * inv);
                const auto rr = __builtin_amdgcn_permlane32_swap(wa, wb, false, false);
                u32x2 w; w.x = rr[0]; w.y = rr[1];
                *(u32x2*)(att + qtok * D + h * HD + 32 * ds + 8 * (g4 + hh)) = w; }
        if (!((F.bid & 1) && it == 3)) { __syncthreads(); run_items1(F, 1 + l, SLOT_ITEMS, cq); }
    }
    __syncthreads();
    run_items1(F, 1 + l, -1, cq);
    __syncthreads();
}

#define DUP_PHASE 0
#define REP(k) for (int _r = 0; _r < ((DUP_PHASE == (k)) ? 2 : 1); ++_r)
struct Args { const float* in[28]; float* out; unsigned char* ws; };
__global__ void __launch_bounds__(512, 2) fwd_kernel(Args args) {
    extern __shared__ __attribute__((aligned(16))) unsigned char lds_raw[];
    Frame F;
    F.lds = (LAS unsigned char*)lds_raw; F.MISC = (volatile LAS unsigned*)(F.lds + LDS_MISC);
    F.tid = threadIdx.x; F.lane = F.tid & 63; F.wave = __builtin_amdgcn_readfirstlane(F.tid >> 6); F.G = gridDim.x; F.bid = blockIdx.x;
    F.ws = (unsigned char*)(GAS unsigned char*)args.ws; F.ctl = (unsigned*)(GAS unsigned*)(args.ws + WS_CTL); F.out = (float*)(GAS float*)args.out;
    for (int u = F.tid; u < (LDS_BYTES - LDS_MISC) / 4; u += 512) F.MISC[u] = 0u;
    __syncthreads();
    XcdBarrier bar = xcd_barrier_post(F.ctl + CW_BAR, F.MISC + 0, F.tid == 0);
#define GRID_BAR() do { XcdBarrier _b = bar; asm volatile("" : "+s"(_b.bar), "+s"(_b.x)); refresh(F); xcd_barrier(_b, F.tid == 0); } while (0)

    REP(1) { for (int u = F.bid; u < 256; u += F.G) { if (u < 64) p_ssm_unit(F, u); else p_adaln_unit(F, u - 64); }
    p_transposes(F); __syncthreads(); }
    GRID_BAR();
    REP(2) phase_n0(F, 0);
    GRID_BAR();

    for (int l = 0; l < DEPTH; ++l) {
        REP(3) { unsigned char* ws = opaque_ws(F); constexpr float dq8 = 1.0f / (W8_SCALE * H8_SCALE);
          { PlainSched S; S.init(ws + WS_HF8, ws + WS_WIN + (size_t)l * INW * D, T, INW, D / 2, D / 2, F.G, F.bid);
            EpiG1 E{EpiQK{(bf16_t*)(ws + WS_Q), (bf16_t*)(ws + WS_K), (float*)(ws + WS_KMEAN) + (size_t)l * NB * NBLK * AW, dq8}, EpiVUG{(bf16_t*)(ws + WS_V), (bf16_t*)(ws + WS_UA), ws + WS_GATT, ws + WS_GSSM, dq8}};
            pg8::gemm_phase<EpiG1, PlainSched, false, true>(F.lds, S, E, D / 128, D / 2, D / 2, F.wave); } }
        GRID_BAR();
        REP(4) { unsigned char* ws = opaque_ws(F); GroupSched S; S.init(ws + WS_UA, (bf16_t*)(ws + WS_BE) + (size_t)l * NG * 256 * 512, 4, 1, UAK, 512, 256, F.G, F.bid, 1);
          EpiState E{(float*)(ws + WS_E)};
          pg8::gemm_phase<EpiState, GroupSched, false>(F.lds, S, E, 512 / 64, UAK, 512, F.wave); }
        GRID_BAR();
        REP(5) { phase_scan(F, l);
        phase_attn(F, l); }
        GRID_BAR();
        REP(6) { unsigned char* ws = opaque_ws(F); GroupSched S; S.init(ws + WS_UA, (bf16_t*)(ws + WS_BSSM) + (size_t)l * NG * 512 * UAK, 4, 2, UAK, UAK, 512, F.G, F.bid);
          EpiSsmOut E{(bf16_t*)(ws + WS_Y)};
          pg8::gemm_phase<EpiSsmOut, GroupSched, false>(F.lds, S, E, UAK / 64, UAK, UAK, F.wave); }
        GRID_BAR();
        REP(7) { unsigned char* ws = opaque_ws(F); PlainSched S; S.init(ws + WS_Y, (bf16_t*)(ws + WS_WGLU) + (size_t)l * 1024 * SW, T, 1024, SW, SW, F.G, F.bid);
          EpiGlu E{ws + WS_AZ};
          pg8::gemm_phase<EpiGlu, PlainSched, false>(F.lds, S, E, SW / 64, SW, SW, F.wave); }
        GRID_BAR();
        REP(8) { unsigned char* ws = opaque_ws(F); PlainSched S; S.init(ws + WS_AZ, ws + WS_WCAT + (size_t)l * D * D, T, D, D / 2, D / 2, F.G, F.bid);
          LAS float* T1 = (LAS float*)(F.lds + LDS_MISC + 1024); LAS float* T2 = T1 + 256;
          refresh(F);
          if (F.tid < 256) { const float x = __builtin_amdgcn_cvt_pk_f32_fp8((int)F.tid, false)[0]; const float e1 = 1.0f + __builtin_amdgcn_exp2f(x * (-1.4426950408889634f / GATE8_SCALE)); T1[F.tid] = __builtin_amdgcn_rcpf(e1); T2[F.tid] = e1; }
          __syncthreads();
          EpiMerge E{ws + WS_MRG, ws + WS_GATT, ws + WS_GSSM, T1, T2};
          pg8::gemm_phase<EpiMerge, PlainSched, false, true>(F.lds, S, E, D / 128, D / 2, D / 2, F.wave); }
        GRID_BAR();
        REP(10) { unsigned char* ws = opaque_ws(F); PlainSched S; S.init(ws + WS_MRG, ws + WS_WOUT + (size_t)l * D * D, T, D, D / 2, D / 2, F.G, F.bid);
          EpiPlain E{(bf16_t*)(ws + WS_YMIX), D, 1.0f / (W8_SCALE * MRG8_SCALE)};
          pg8::gemm_phase<EpiPlain, PlainSched, false, true>(F.lds, S, E, D / 128, D / 2, D / 2, F.wave); }
        GRID_BAR();
        phase_n1(F, l);
        GRID_BAR();
        volatile LAS int* tbw = (volatile LAS int*)(F.MISC + 16); volatile LAS int* cntw = (volatile LAS int*)(F.MISC + 128);
        if (F.tid < 32) cntw[F.tid] = (int)__hip_atomic_load(F.ctl + CW_CNT + (l * NE + F.tid) * 64, __ATOMIC_RELAXED, __HIP_MEMORY_SCOPE_AGENT);
        __syncthreads();
        if (F.tid == 0) { int s = 0; for (int e = 0; e < NE; ++e) { tbw[e] = s; s += (cntw[e] + 255) >> 8; } tbw[32] = s; }
        __syncthreads();
        REP(12) { unsigned char* ws = opaque_ws(F); const kptr_t KA = kargs_now(); MoeSched S; S.A = (const char*)(ws + WS_H8); S.B = (const char*)(ws + WS_W1 + (size_t)l * NE * 2048 * D); S.lists = (const int2*)(ws + WS_LISTS);
          S.tb = (const LAS int*)(F.MISC + 16); S.cnt = (const LAS int*)(F.MISC + 128); S.nN = 8; S.GM = 4; S.G = F.G; S.c = F.bid; S.eB = (size_t)2048 * D; S.tB = (size_t)256 * D; S.tA = 0; S.gather = true; S.ul = (const LAS int*)(F.MISC + 192);
          refresh(F); __syncthreads(); S.build((volatile LAS int*)(F.MISC + 192), F.tid); __syncthreads();
          EpiSwiglu E{ws + WS_ACT, inp(KA, I_BEXPIN) + (size_t)l * NE * 2048, (LAS float*)(F.lds + LDS_MISC + 4096)};
          pg8::gemm_phase<EpiSwiglu, MoeSched, true, true>(F.lds, S, E, (D / 128) * PROBE_KREP, D / 2, D / 2, F.wave, PROBE_KREP > 1 ? D / 128 : 0); }
        GRID_BAR();
        REP(13) { unsigned char* ws = opaque_ws(F); const kptr_t KA = kargs_now(); MoeSched S; S.A = (const char*)(ws + WS_ACT); S.B = (const char*)(ws + WS_W2 + (size_t)l * NE * D * DFF); S.lists = (const int2*)(ws + WS_LISTS);
          S.tb = (const LAS int*)(F.MISC + 16); S.cnt = (const LAS int*)(F.MISC + 128); S.nN = 4; S.GM = 8; S.G = F.G; S.c = F.bid; S.eB = (size_t)D * DFF; S.tB = (size_t)256 * DFF; S.tA = (size_t)256 * DFF; S.gather = false; S.ul = (const LAS int*)(F.MISC + 192);
          refresh(F); __syncthreads(); S.build((volatile LAS int*)(F.MISC + 192), F.tid); __syncthreads();
          EpiMoeOut E{(bf16_t*)(ws + WS_YSLOT), inp(KA, I_BEXPOUT) + (size_t)l * NE * D, (const int2*)(ws + WS_LISTS), (LAS int2*)(F.lds + LDS_MISC + 1792), (LAS float*)(F.lds + LDS_MISC + 4096)};
          pg8::gemm_phase<EpiMoeOut, MoeSched, false, true>(F.lds, S, E, DFF / 128, DFF / 2, DFF / 2, F.wave); }
        GRID_BAR();
        phase_n2(F, l);
        GRID_BAR();
    }
}

extern "C" void kernel_launch(void* const* d_in, const int* in_sizes, int n_in, void* d_out, int out_size, void* d_ws, size_t ws_size, hipStream_t stream) {
    static int grid = 0;
    if (grid == 0) {
        if (n_in != 28 || out_size != T * D || ws_size < WS_END) { fprintf(stderr, "kernel_launch: unexpected shapes (n_in %d, out %d, ws %zu < %zu)\n", n_in, out_size, ws_size, (size_t)WS_END); grid = -1; return; }
        int dev = 0, cus = 0, per_cu = 0;
        if (hipGetDevice(&dev) != hipSuccess || hipDeviceGetAttribute(&cus, hipDeviceAttributeMultiprocessorCount, dev) != hipSuccess) { grid = -1; return; }
        if (hipFuncSetAttribute((const void*)fwd_kernel, hipFuncAttributeMaxDynamicSharedMemorySize, LDS_BYTES) != hipSuccess) { fprintf(stderr, "kernel_launch: hipFuncSetAttribute failed\n"); grid = -1; return; }
        if (hipOccupancyMaxActiveBlocksPerMultiprocessor(&per_cu, (const void*)fwd_kernel, 512, LDS_BYTES) != hipSuccess || per_cu < 1) { fprintf(stderr, "kernel_launch: occupancy query says %d\n", per_cu); }
        (void)hipGetLastError();
        grid = cus;
    }
    if (grid < 0) return;
    if (hipMemsetAsync(d_ws, 0, WS_ZERO_BYTES, stream) != hipSuccess) { fprintf(stderr, "kernel_launch: memset failed\n"); return; }
    Args a{};
    for (int i = 0; i < 28; ++i) a.in[i] = (const float*)d_in[i];
    a.out = (float*)d_out; a.ws = (unsigned char*)d_ws;
    hipLaunchKernelGGL(fwd_kernel, dim3(grid), dim3(512), LDS_BYTES, stream, a);
    const hipError_t le = hipPeekAtLastError();
    if (le != hipSuccess) fprintf(stderr, "kernel_launch: launch failed: %s\n", hipGetErrorName(le));
}
```
